# Optimizing an MI355X kernel written in HIP

```python
import math
import jax, jax.numpy as jnp
from jax import lax
import numpy as np

D_MODEL = 1024
BATCH = 4
SEQ = 8192
DEPTH = 2

CHUNK = 64
D_MIX = D_MODEL
HEAD_DIM = 64
SGU_WIDTH = D_MIX // 4
SGU_HEADS = SGU_WIDTH // HEAD_DIM
SGU_BLOCK = 128
S5_WIDTH = D_MIX // 4
S5_GROUP = 16
S5_N_GROUPS = S5_WIDTH // S5_GROUP
S5_STATE = 64
S5_DT_MIN = 0.001
S5_DT_MAX = 0.1
ATTN_WIDTH = D_MIX // 2
ATTN_HEADS = ATTN_WIDTH // HEAD_DIM
BAND_CHUNKS = 9
BAND = BAND_CHUNKS * CHUNK
MAX_REL = 256
IN_COLS = 2 * SGU_WIDTH + S5_WIDTH + 3 * ATTN_WIDTH
OUT_NORM_GROUP = 64
N_EXPERT_GROUPS = 4
EXPERTS_PER_GROUP = 4
N_EXPERTS = N_EXPERT_GROUPS * EXPERTS_PER_GROUP
TOP_K = 2
D_EXPERT = D_MODEL // 4
EPS = 1e-6
NEG_INF = -1e30

kernel_name = "hybrid_chunk_causal_parallel_heads_hmoe"


def rms_norm(x, g):
    xf = x.astype(jnp.float32)
    y = xf * lax.rsqrt(jnp.mean(xf * xf, axis=-1, keepdims=True) + EPS)
    return (y * g.astype(jnp.float32)).astype(x.dtype)


def sgu_mixer(z, norm_g, w_s, b_s):
    b_, s_, _ = z.shape
    u, v = jnp.split(z, 2, axis=-1)
    v = rms_norm(v, norm_g)
    v = v.reshape(b_, s_ // SGU_BLOCK, SGU_BLOCK, SGU_HEADS, HEAD_DIM)
    chunk_of = jnp.arange(SGU_BLOCK) // CHUNK
    mask = chunk_of[None, :] <= chunk_of[:, None]
    w = jnp.where(mask[None], w_s, 0).astype(v.dtype)
    v = jnp.einsum('hij,bnjhc->bnihc', w, v) + b_s.T[None, None, :, :, None].astype(v.dtype)
    return u * v.reshape(b_, s_, SGU_WIDTH)


def s5_mixer(u, lam_re, lam_im, log_dt, b_re, b_im, c_re, c_im, d, glu_w, glu_b):
    f32 = jnp.float32
    b_, s_, _ = u.shape
    lam = lax.complex(lam_re.astype(f32), lam_im.astype(f32))
    dt = jnp.exp(log_dt.astype(f32))[:, None]
    a_bar = jnp.exp(lam * dt)
    b_mat = lax.complex(b_re.astype(f32), b_im.astype(f32))
    b_bar = ((a_bar - 1) / lam)[..., None] * b_mat
    c_mat = lax.complex(c_re.astype(f32), c_im.astype(f32))
    uf = u.astype(f32)
    ug = uf.reshape(b_, s_, S5_N_GROUPS, S5_GROUP)
    bu = jnp.einsum('gph,blgh->blgp', b_bar, ug.astype(jnp.complex64))
    a = jnp.broadcast_to(a_bar, bu.shape)

    def combine(e1, e2):
        a1, x1 = e1
        a2, x2 = e2
        return a1 * a2, a2 * x1 + x2

    _, states = lax.associative_scan(combine, (a, bu), axis=1)
    y = jnp.einsum('ghp,blgp->blgh', c_mat, states).real.reshape(b_, s_, S5_WIDTH)
    y = jax.nn.gelu(y + d.astype(f32) * uf)
    y = y * jax.nn.sigmoid(y @ glu_w.astype(f32) + glu_b.astype(f32))
    return y.astype(u.dtype)


def band_attention(q, k, v, q_g, k_g, rel_bias):
    f32 = jnp.float32
    b_, s_, n_h, hd = q.shape
    n_c = s_ // CHUNK
    q = rms_norm(q, q_g)
    k = rms_norm(k, k_g)
    q_pos = jnp.arange(CHUNK) + (BAND_CHUNKS - 1) * CHUNK
    k_pos = jnp.arange(BAND)
    rel = jnp.clip(q_pos[:, None] - k_pos[None, :], -MAX_REL, MAX_REL) + MAX_REL
    bias = rel_bias.astype(f32)[:, rel]
    band_idx = jnp.arange(n_c)[:, None] + jnp.arange(BAND_CHUNKS)[None, :]
    valid = jnp.repeat(band_idx >= BAND_CHUNKS - 1, CHUNK, axis=1)
    scale = HEAD_DIM ** -0.5

    def one_seq(args):
        qs, ks, vs = args
        qc = qs.reshape(n_c, CHUNK, n_h, hd)
        pad = jnp.zeros(((BAND_CHUNKS - 1) * CHUNK, n_h, hd), ks.dtype)
        kc = jnp.concatenate([pad, ks], axis=0).reshape(n_c + BAND_CHUNKS - 1, CHUNK, n_h, hd)[band_idx]
        vc = jnp.concatenate([pad, vs], axis=0).reshape(n_c + BAND_CHUNKS - 1, CHUNK, n_h, hd)[band_idx]
        kc = kc.reshape(n_c, BAND, n_h, hd)
        vc = vc.reshape(n_c, BAND, n_h, hd)
        sc = jnp.einsum('cqhd,ckhd->chqk', qc, kc).astype(f32) * scale + bias[None]
        sc = jnp.where(valid[:, None, None, :], sc, NEG_INF)
        p = jax.nn.softmax(sc, axis=-1).astype(vs.dtype)
        o = jnp.einsum('chqk,ckhd->cqhd', p, vc)
        return o.reshape(s_, n_h * hd)

    return lax.map(one_seq, (q, k, v))


def hier_moe(x, wg, bg, we, be, w_gate, w_up, w_down):
    f32 = jnp.float32
    xf = x.astype(f32)
    g_prob = jax.nn.softmax(xf @ wg.astype(f32) + bg.astype(f32), axis=-1)
    g_top = jnp.argmax(g_prob, axis=-1)
    p_g = jnp.max(g_prob, axis=-1)
    e_logits = jnp.einsum('sd,gde->sge', xf, we.astype(f32)) + be.astype(f32)
    e_logits = jnp.take_along_axis(e_logits, g_top[:, None, None], axis=1)[:, 0]
    e_prob = jax.nn.softmax(e_logits, axis=-1)
    w2, i2 = lax.top_k(e_prob, TOP_K)
    w2 = w2 / jnp.sum(w2, axis=-1, keepdims=True)
    expert_id = g_top[:, None] * EXPERTS_PER_GROUP + i2
    gate = jnp.sum(jax.nn.one_hot(expert_id, N_EXPERTS, dtype=f32) * (p_g[:, None] * w2)[..., None], axis=1)
    h = jax.nn.silu(jnp.einsum('sd,edf->sef', x, w_gate)) * jnp.einsum('sd,edf->sef', x, w_up)
    h = h * gate[:, :, None].astype(h.dtype)
    return jnp.einsum('sef,efd->sd', h, w_down)


def setup_inputs(seed: int = 0) -> dict:
    key = jax.random.key(seed)
    ks = jax.random.split(key, 32)
    f32 = jnp.float32
    L = DEPTH
    nrm = lambda k, shape, s: jax.random.normal(k, shape, f32) * s
    lam_im0 = jnp.pi * jnp.arange(S5_STATE, dtype=f32)
    return {
        "x": nrm(ks[0], (BATCH, SEQ, D_MODEL), 1.0),
        "norm_mix": 1.0 + nrm(ks[1], (L, D_MODEL), 0.02),
        "w_in": nrm(ks[2], (L, D_MODEL, IN_COLS), D_MODEL ** -0.5),
        "sgu_norm": 1.0 + nrm(ks[3], (L, SGU_WIDTH), 0.02),
        "sgu_w": nrm(ks[4], (L, SGU_HEADS, SGU_BLOCK, SGU_BLOCK), 0.5 * SGU_BLOCK ** -0.5),
        "sgu_b": 1.0 + nrm(ks[5], (L, SGU_HEADS, SGU_BLOCK), 0.02),
        "s5_lambda_re": -0.5 + nrm(ks[6], (L, S5_N_GROUPS, S5_STATE), 0.01),
        "s5_lambda_im": lam_im0 + nrm(ks[7], (L, S5_N_GROUPS, S5_STATE), 0.01),
        "s5_log_dt": jax.random.uniform(ks[8], (L, S5_N_GROUPS), f32, math.log(S5_DT_MIN), math.log(S5_DT_MAX)),
        "s5_b_re": nrm(ks[9], (L, S5_N_GROUPS, S5_STATE, S5_GROUP), (2.0 * S5_GROUP) ** -0.5),
        "s5_b_im": nrm(ks[10], (L, S5_N_GROUPS, S5_STATE, S5_GROUP), (2.0 * S5_GROUP) ** -0.5),
        "s5_c_re": nrm(ks[11], (L, S5_N_GROUPS, S5_GROUP, S5_STATE), (2.0 * S5_STATE) ** -0.5),
        "s5_c_im": nrm(ks[12], (L, S5_N_GROUPS, S5_GROUP, S5_STATE), (2.0 * S5_STATE) ** -0.5),
        "s5_d": nrm(ks[13], (L, S5_WIDTH), 1.0),
        "s5_glu_w": nrm(ks[14], (L, S5_WIDTH, S5_WIDTH), S5_WIDTH ** -0.5),
        "s5_glu_b": nrm(ks[15], (L, S5_WIDTH), 0.02),
        "q_norm": 1.0 + nrm(ks[16], (L, HEAD_DIM), 0.02),
        "k_norm": 1.0 + nrm(ks[17], (L, HEAD_DIM), 0.02),
        "rel_bias": nrm(ks[18], (L, ATTN_HEADS, 2 * MAX_REL + 1), 0.1),
        "out_norm": 1.0 + nrm(ks[19], (L, D_MIX), 0.02),
        "w_out": nrm(ks[20], (L, D_MIX, D_MODEL), D_MIX ** -0.5),
        "norm_ffn": 1.0 + nrm(ks[21], (L, D_MODEL), 0.02),
        "router_group_w": nrm(ks[22], (L, D_MODEL, N_EXPERT_GROUPS), D_MODEL ** -0.5),
        "router_group_b": nrm(ks[23], (L, N_EXPERT_GROUPS), 0.01),
        "router_expert_w": nrm(ks[24], (L, N_EXPERT_GROUPS, D_MODEL, EXPERTS_PER_GROUP), D_MODEL ** -0.5),
        "router_expert_b": nrm(ks[25], (L, N_EXPERT_GROUPS, EXPERTS_PER_GROUP), 0.01),
        "w_gate": nrm(ks[26], (L, N_EXPERTS, D_MODEL, D_EXPERT), D_MODEL ** -0.5),
        "w_up": nrm(ks[27], (L, N_EXPERTS, D_MODEL, D_EXPERT), D_MODEL ** -0.5),
        "w_down": nrm(ks[28], (L, N_EXPERTS, D_EXPERT, D_MODEL), D_EXPERT ** -0.5),
    }


def reference(x, norm_mix, w_in, sgu_norm, sgu_w, sgu_b, s5_lambda_re, s5_lambda_im, s5_log_dt,
              s5_b_re, s5_b_im, s5_c_re, s5_c_im, s5_d, s5_glu_w, s5_glu_b, q_norm, k_norm, rel_bias,
              out_norm, w_out, norm_ffn, router_group_w, router_group_b, router_expert_w,
              router_expert_b, w_gate, w_up, w_down):
    b_, s_, _ = x.shape
    for l in range(DEPTH):
        h = rms_norm(x, norm_mix[l])
        proj = h @ w_in[l]
        z_sgu, z_s5, z_qkv = jnp.split(proj, [2 * SGU_WIDTH, 2 * SGU_WIDTH + S5_WIDTH], axis=-1)
        o_a = sgu_mixer(jax.nn.gelu(z_sgu), sgu_norm[l], sgu_w[l], sgu_b[l])
        o_b = s5_mixer(z_s5, s5_lambda_re[l], s5_lambda_im[l], s5_log_dt[l], s5_b_re[l], s5_b_im[l],
                       s5_c_re[l], s5_c_im[l], s5_d[l], s5_glu_w[l], s5_glu_b[l])
        q, k, v = jnp.split(z_qkv.reshape(b_, s_, 3, ATTN_HEADS, HEAD_DIM), 3, axis=2)
        o_c = band_attention(q[:, :, 0], k[:, :, 0], v[:, :, 0], q_norm[l], k_norm[l], rel_bias[l])
        o = jnp.concatenate([o_a, o_b, o_c], axis=-1)
        o = rms_norm(o.reshape(b_, s_, D_MIX // OUT_NORM_GROUP, OUT_NORM_GROUP),
                     out_norm[l].reshape(D_MIX // OUT_NORM_GROUP, OUT_NORM_GROUP)).reshape(b_, s_, D_MIX)
        x = x + o @ w_out[l]
        h = rms_norm(x, norm_ffn[l])
        moe = lambda hs, l=l: hier_moe(hs, router_group_w[l], router_group_b[l], router_expert_w[l],
                                       router_expert_b[l], w_gate[l], w_up[l], w_down[l])
        x = x + lax.map(moe, h)
    return x
```

```cpp
#include <hip/hip_runtime.h>
#include <cstdint>
#include <cstdio>

typedef unsigned short bf16_t;
typedef unsigned u32x4 __attribute__((ext_vector_type(4)));
typedef float f32x4 __attribute__((ext_vector_type(4)));

constexpr int BATCH = 4, SEQ = 8192, T = BATCH * SEQ, D = 1024, NIN = 2304, DEPTH = 2;
constexpr int NH = 8, HD = 64;
constexpr int NBUCKET = 24, MAXTILES = 152, MAXROWS = MAXTILES * 256;
constexpr float EPS = 1e-6f;
constexpr float LOG2E = 1.4426950408889634f;

constexpr size_t MiB = 1u << 20;
constexpr size_t WS_CTL = 0;
constexpr size_t WS_WIN = 1 * MiB;
constexpr size_t WS_WOUT = 10 * MiB;
constexpr size_t WS_WGU = 14 * MiB;
constexpr size_t WS_WDN = 46 * MiB;
constexpr size_t WS_GLU = 94 * MiB;
constexpr size_t WS_XB = 106 * MiB;
constexpr size_t WS_META = 170 * MiB;
constexpr size_t WS_PROJ = 172 * MiB;
constexpr size_t WS_U = WS_PROJ, WS_V = WS_PROJ + 16 * MiB, WS_ZS = WS_PROJ + 32 * MiB;
constexpr size_t WS_QH = WS_PROJ + 48 * MiB, WS_KH = WS_PROJ + 80 * MiB, WS_VH = WS_PROJ + 112 * MiB;
constexpr size_t WS_XS = WS_PROJ;
constexpr size_t WS_H = WS_PROJ + 76 * MiB;
constexpr size_t WS_O = 316 * MiB;
constexpr size_t WS_YG = 380 * MiB;
constexpr size_t WS_END = 412 * MiB;

constexpr size_t MT_RSTD = 0;
constexpr size_t MT_VR = 128 * 1024;
constexpr size_t MT_BUCKET = 256 * 1024;
constexpr size_t MT_POS = 384 * 1024;
constexpr size_t MT_GW0 = 512 * 1024;
constexpr size_t MT_GW1 = 640 * 1024;
constexpr size_t MT_RS2 = 768 * 1024;
constexpr size_t MT_STOK = 896 * 1024;
constexpr size_t MT_SGW0 = 1088 * 1024;
constexpr size_t MT_SGW1 = 1280 * 1024;
constexpr size_t MT_SRS = 1472 * 1024;
constexpr int CW_CNT = 64;
constexpr int CW_TILEB = 256;

__device__ __forceinline__ float bf2f(bf16_t v) { return __uint_as_float(((unsigned)v) << 16); }
__device__ __forceinline__ bf16_t f2bf(float f) { unsigned u = __float_as_uint(f); return (bf16_t)((u + 0x7fffu + ((u >> 16) & 1u)) >> 16); }
__device__ __forceinline__ unsigned pk2(float lo, float hi) { return (unsigned)f2bf(lo) | ((unsigned)f2bf(hi) << 16); }
__device__ __forceinline__ float gelu_tanh(float x) { const float u = 0.7978845608028654f * (x + 0.044715f * x * x * x); return x / (1.f + __expf(-2.f * u)); }
__device__ __forceinline__ float wave_sum(float v) {
#pragma unroll
    for (int o = 1; o < 64; o <<= 1) v += __shfl_xor(v, o);
    return v;
}
__device__ __forceinline__ float wave_max(float v) {
#pragma unroll
    for (int o = 1; o < 64; o <<= 1) v = fmaxf(v, __shfl_xor(v, o));
    return v;
}
__constant__ int PAIR0[6] = {0, 0, 0, 1, 1, 2};
__constant__ int PAIR1[6] = {1, 2, 3, 2, 3, 3};

struct Params {
    const float* in[29];
    float* out;
    unsigned char* ws;
};

__host__ __device__ __forceinline__ int inproj_row_of_col(int n) {
    if (n < 768) return n;
    const int pn = n >> 8, r = n & 255, wc = r >> 6, bj = (r >> 5) & 1, i = r & 31;
    return pn * 256 + bj * 128 + wc * 32 + i;
}
__device__ __forceinline__ void transpose_item(const float* W, int N, const float* scale, bf16_t* WT, int ldk, int koff, int k0, int n0, int rowmode, float* scr, int lane) {
#pragma unroll 8
    for (int i = 0; i < 32; ++i) {
        const int kk = 2 * i + (lane >> 5);
        float v = W[(size_t)(k0 + kk) * N + n0 + (lane & 31)];
        if (scale) v *= scale[k0 + kk];
        scr[kk * 33 + (lane & 31)] = v;
    }
    asm volatile("s_waitcnt lgkmcnt(0)" ::: "memory");
    const int c = lane & 7;
#pragma unroll
    for (int j = 0; j < 4; ++j) {
        const int nl = (lane >> 3) + 8 * j; const float* s = scr + (8 * c) * 33 + nl;
        u32x4 o; o.x = pk2(s[0 * 33], s[1 * 33]); o.y = pk2(s[2 * 33], s[3 * 33]); o.z = pk2(s[4 * 33], s[5 * 33]); o.w = pk2(s[6 * 33], s[7 * 33]);
        const int n = n0 + nl; int row;
        if (rowmode == 0) row = n;
        else if (rowmode == 1) row = inproj_row_of_col(n);
        else if (rowmode == 2) row = 256 * (n >> 7) + (n & 127);
        else row = 256 * (n >> 7) + 128 + (n & 127);
        *(u32x4*)(WT + (size_t)row * ldk + koff + k0 + 8 * c) = o;
    }
    asm volatile("s_waitcnt lgkmcnt(0)" ::: "memory");
}
constexpr int IT_WIN = 16 * 72, IT_WOUT = 16 * 32, IT_WGU1 = 16 * 8, IT_WDN1 = 4 * 32, IT_GLU = 4 * 8;
constexpr int IT_L = IT_WIN + IT_WOUT + 16 * 2 * IT_WGU1 + NBUCKET * 2 * IT_WDN1 + IT_GLU;
constexpr int IT_TOTAL = DEPTH * IT_L;
__device__ __forceinline__ void prep_item(const Params& P, int it, float* scr, int lane) {
    const int l = it / IT_L; int r = it % IT_L;
    unsigned char* ws = P.ws;
    if (r < IT_WIN) { const int kb = r / 72, nb = r % 72;
        transpose_item(P.in[2] + (size_t)l * D * NIN, NIN, P.in[1] + l * D, (bf16_t*)(ws + WS_WIN) + (size_t)l * NIN * D, D, 0, kb * 64, nb * 32, 1, scr, lane); return; }
    r -= IT_WIN;
    if (r < IT_WOUT) { const int kb = r / 32, nb = r % 32;
        transpose_item(P.in[20] + (size_t)l * D * D, D, P.in[19] + l * D, (bf16_t*)(ws + WS_WOUT) + (size_t)l * D * D, D, 0, kb * 64, nb * 32, 0, scr, lane); return; }
    r -= IT_WOUT;
    if (r < 16 * 2 * IT_WGU1) { const int e = r / (2 * IT_WGU1), q = r % (2 * IT_WGU1), isup = q / IT_WGU1, t = q % IT_WGU1, kb = t / 8, nb = t % 8;
        const float* W = P.in[isup ? 27 : 26] + ((size_t)l * 16 + e) * D * 256;
        transpose_item(W, 256, P.in[21] + l * D, (bf16_t*)(ws + WS_WGU) + ((size_t)l * 16 + e) * 512 * D, D, 0, kb * 64, nb * 32, isup ? 3 : 2, scr, lane); return; }
    r -= 16 * 2 * IT_WGU1;
    if (r < NBUCKET * 2 * IT_WDN1) { const int bk = r / (2 * IT_WDN1), q = r % (2 * IT_WDN1), slot = q / IT_WDN1, t = q % IT_WDN1, kb = t / 32, nb = t % 32;
        const int g = bk / 6, pi = bk % 6, e = 4 * g + (slot ? PAIR1[pi] : PAIR0[pi]);
        const float* W = P.in[28] + ((size_t)l * 16 + e) * 256 * D;
        transpose_item(W, D, nullptr, (bf16_t*)(ws + WS_WDN) + ((size_t)l * NBUCKET + bk) * D * 512, 512, slot * 256, kb * 64, nb * 32, 0, scr, lane); return; }
    r -= NBUCKET * 2 * IT_WDN1;
    { const int kb = r / 8, nb = r % 8;
        transpose_item(P.in[14] + (size_t)l * 256 * 256, 256, nullptr, (bf16_t*)(ws + WS_GLU) + (size_t)l * 256 * 256, 256, 0, kb * 64, nb * 32, 0, scr, lane); }
}
__global__ __launch_bounds__(256) void k_prep(Params P) {
    __shared__ float scr_all[4][64 * 33];
    const int wave = threadIdx.x >> 6, lane = threadIdx.x & 63;
    const int gw = blockIdx.x * 4 + wave, ngw = gridDim.x * 4;
    for (int it = gw; it < IT_TOTAL; it += ngw) prep_item(P, it, scr_all[wave], lane);
}

__device__ __forceinline__ void conv_row(const float* xrow, bf16_t* orow, float* rstd_out, int lane) {
    const f32x4* xr = (const f32x4*)xrow + lane;
    f32x4 v[4]; float s = 0.f;
#pragma unroll
    for (int j = 0; j < 4; ++j) { v[j] = xr[64 * j]; s += (v[j].x * v[j].x + v[j].y * v[j].y) + (v[j].z * v[j].z + v[j].w * v[j].w); }
    s = wave_sum(s);
    if (lane == 0) *rstd_out = 1.0f / sqrtf(s * (1.f / D) + EPS);
    unsigned long long* o8 = (unsigned long long*)orow + lane;
#pragma unroll
    for (int j = 0; j < 4; ++j) o8[64 * j] = (unsigned long long)pk2(v[j].x, v[j].y) | ((unsigned long long)pk2(v[j].z, v[j].w) << 32);
}
__global__ __launch_bounds__(256) void k_conv(const float* x, bf16_t* xb, float* rstd) {
    const int wave = threadIdx.x >> 6, lane = threadIdx.x & 63;
    for (int m = blockIdx.x * 4 + wave; m < T; m += gridDim.x * 4) conv_row(x + (size_t)m * D, xb + (size_t)m * D, rstd + m, lane);
}

struct EpiIn {
    const float* rstd; bf16_t *U, *V, *ZS, *QH, *KH, *VH; const float *qg, *kg;
    __device__ __forceinline__ const bf16_t* a_ptr(const bf16_t* A, int K, int rt) const { return A + (size_t)rt * 128 * K; }
    __device__ __forceinline__ const bf16_t* b_ptr(const bf16_t* Bt, int K, int rt, int pn) const { return Bt + (size_t)pn * 256 * K; }
    __device__ __forceinline__ void operator()(int rt, int pn, int wc, int rl, int q4, float (&acc)[16]) const {
        const int row = rt * 128 + rl; const float rs = rstd[row];
        const int bj = q4 >> 1, i0 = 16 * (q4 & 1);
        float v[16];
#pragma unroll
        for (int e = 0; e < 16; ++e) v[e] = acc[e] * rs;
        if (pn < 3) {
            bf16_t* dst = (pn == 0 ? U : pn == 1 ? V : ZS) + (size_t)row * 256 + bj * 128 + wc * 32 + i0;
            if (pn < 2) {
#pragma unroll
                for (int e = 0; e < 16; ++e) v[e] = gelu_tanh(v[e]);
            }
            u32x4 o0, o1; o0.x = pk2(v[0], v[1]); o0.y = pk2(v[2], v[3]); o0.z = pk2(v[4], v[5]); o0.w = pk2(v[6], v[7]);
            o1.x = pk2(v[8], v[9]); o1.y = pk2(v[10], v[11]); o1.z = pk2(v[12], v[13]); o1.w = pk2(v[14], v[15]);
            *(u32x4*)dst = o0; *(u32x4*)(dst + 8) = o1;
        } else {
            const int typ = (pn - 3) >> 1, head = 4 * ((pn - 3) & 1) + wc, d0 = 32 * bj + i0;
            if (typ < 2) {
                float ss = 0.f;
#pragma unroll
                for (int e = 0; e < 16; ++e) ss += v[e] * v[e];
                ss += __shfl_xor(ss, 1); ss += __shfl_xor(ss, 2);
                const float r = 1.0f / sqrtf(ss * (1.f / 64.f) + EPS);
                const float* g = (typ == 0 ? qg : kg) + d0; const float sc = (typ == 0) ? 0.125f * LOG2E : 1.f;
#pragma unroll
                for (int e = 0; e < 16; ++e) v[e] = v[e] * r * g[e] * sc;
            }
            const int b = row / SEQ, s = row % SEQ;
            bf16_t* dst = (typ == 0 ? QH : typ == 1 ? KH : VH) + (((size_t)(b * NH + head) * SEQ + s) * 64 + d0);
            u32x4 o0, o1; o0.x = pk2(v[0], v[1]); o0.y = pk2(v[2], v[3]); o0.z = pk2(v[4], v[5]); o0.w = pk2(v[6], v[7]);
            o1.x = pk2(v[8], v[9]); o1.y = pk2(v[10], v[11]); o1.z = pk2(v[12], v[13]); o1.w = pk2(v[14], v[15]);
            *(u32x4*)dst = o0; *(u32x4*)(dst + 8) = o1;
        }
    }
};
struct EpiOut {
    const float* xres; float* out;
    __device__ __forceinline__ const bf16_t* a_ptr(const bf16_t* A, int K, int rt) const { return A + (size_t)rt * 128 * K; }
    __device__ __forceinline__ const bf16_t* b_ptr(const bf16_t* Bt, int K, int rt, int pn) const { return Bt + (size_t)pn * 256 * K; }
    __device__ __forceinline__ void operator()(int rt, int pn, int wc, int rl, int q4, float (&acc)[16]) const {
        const int row = rt * 128 + rl, col = pn * 256 + (q4 >> 1) * 128 + wc * 32 + 16 * (q4 & 1);
        const float* xr = xres + (size_t)row * D + col; float* o = out + (size_t)row * D + col;
#pragma unroll
        for (int e = 0; e < 16; ++e) o[e] = xr[e] + acc[e];
    }
};
struct EpiG1 {
    const unsigned* tileb; const float *sgw0, *sgw1, *srs; bf16_t* H; const bf16_t* Wgu;
    __device__ __forceinline__ const bf16_t* a_ptr(const bf16_t* A, int K, int rt) const { return ((int)tileb[rt >> 1] < 0) ? nullptr : A + (size_t)rt * 128 * K; }
    __device__ __forceinline__ const bf16_t* b_ptr(const bf16_t* Bt, int K, int rt, int pn) const {
        const int bk = (int)tileb[rt >> 1], g = bk / 6, pi = bk % 6, e = 4 * g + ((pn >> 1) ? PAIR1[pi] : PAIR0[pi]);
        return Wgu + ((size_t)e * 512 + (pn & 1) * 256) * D; }
    __device__ __forceinline__ void operator()(int rt, int pn, int wc, int rl, int q4, float (&acc)[16]) const {
        const int row = rt * 128 + rl; const float rs = srs[row]; const float gw = (pn >> 1) ? sgw1[row] : sgw0[row];
        float up[16];
#pragma unroll
        for (int e = 0; e < 16; ++e) up[e] = __shfl_xor(acc[e], 2);
        if ((q4 >> 1) == 0) {
            float h[16];
#pragma unroll
            for (int e = 0; e < 16; ++e) { const float g = acc[e] * rs, u = up[e] * rs; h[e] = g / (1.f + __expf(-g)) * u * gw; }
            bf16_t* dst = H + (size_t)row * 512 + (pn >> 1) * 256 + (pn & 1) * 128 + wc * 32 + 16 * (q4 & 1);
            u32x4 o0, o1; o0.x = pk2(h[0], h[1]); o0.y = pk2(h[2], h[3]); o0.z = pk2(h[4], h[5]); o0.w = pk2(h[6], h[7]);
            o1.x = pk2(h[8], h[9]); o1.y = pk2(h[10], h[11]); o1.z = pk2(h[12], h[13]); o1.w = pk2(h[14], h[15]);
            *(u32x4*)dst = o0; *(u32x4*)(dst + 8) = o1;
        }
    }
};
struct EpiG2 {
    const unsigned* tileb; const int* stok; float* out; const bf16_t* Wdn;
    __device__ __forceinline__ const bf16_t* a_ptr(const bf16_t* A, int K, int rt) const { return ((int)tileb[rt >> 1] < 0) ? nullptr : A + (size_t)rt * 128 * K; }
    __device__ __forceinline__ const bf16_t* b_ptr(const bf16_t* Bt, int K, int rt, int pn) const { return Wdn + ((size_t)tileb[rt >> 1] * D + pn * 256) * 512; }
    __device__ __forceinline__ void operator()(int rt, int pn, int wc, int rl, int q4, float (&acc)[16]) const {
        const int row = rt * 128 + rl; const int tok = stok[row]; if (tok < 0) return;
        float* o = out + (size_t)tok * D + pn * 256 + (q4 >> 1) * 128 + wc * 32 + 16 * (q4 & 1);
#pragma unroll
        for (int e = 0; e < 16; ++e) o[e] += acc[e];
    }
};
template <class Epi> __global__ __launch_bounds__(256) void k_ngemm(const bf16_t* A0, const bf16_t* Bt0, int K, int nseg, Epi E) {
    __shared__ float As[128][33];
    __shared__ float Bs[64][33];
    const int rt = blockIdx.x / nseg, seg = blockIdx.x % nseg, pn = seg >> 2, wc = seg & 3;
    const bf16_t* A = E.a_ptr(A0, K, rt);
    if (!A) return;
    const bf16_t* B = E.b_ptr(Bt0, K, rt, pn);
    const int tid = threadIdx.x, r = tid >> 2, q4 = tid & 3;
    float acc0[16], acc1[16];
#pragma unroll
    for (int e = 0; e < 16; ++e) { acc0[e] = 0.f; acc1[e] = 0.f; }
    const int cb = 32 * (q4 >> 1) + 16 * (q4 & 1);
    for (int k0 = 0; k0 < K; k0 += 32) {
#pragma unroll
        for (int i = 0; i < 2; ++i) { const int p = tid + 256 * i, row = p >> 2, ks = (p & 3) * 8;
            const u32x4 w = *(const u32x4*)(A + (size_t)row * K + k0 + ks);
            float* d = &As[row][ks];
            d[0] = __uint_as_float(w.x << 16); d[1] = __uint_as_float(w.x & 0xffff0000u); d[2] = __uint_as_float(w.y << 16); d[3] = __uint_as_float(w.y & 0xffff0000u);
            d[4] = __uint_as_float(w.z << 16); d[5] = __uint_as_float(w.z & 0xffff0000u); d[6] = __uint_as_float(w.w << 16); d[7] = __uint_as_float(w.w & 0xffff0000u); }
        { const int c = tid >> 2, ks = (tid & 3) * 8, brow = 128 * (c >> 5) + 32 * wc + (c & 31);
            const u32x4 w = *(const u32x4*)(B + (size_t)brow * K + k0 + ks);
            float* d = &Bs[c][ks];
            d[0] = __uint_as_float(w.x << 16); d[1] = __uint_as_float(w.x & 0xffff0000u); d[2] = __uint_as_float(w.y << 16); d[3] = __uint_as_float(w.y & 0xffff0000u);
            d[4] = __uint_as_float(w.z << 16); d[5] = __uint_as_float(w.z & 0xffff0000u); d[6] = __uint_as_float(w.w << 16); d[7] = __uint_as_float(w.w & 0xffff0000u); }
        __syncthreads();
#pragma unroll 4
        for (int kk = 0; kk < 32; ++kk) {
            const float a0 = As[r][kk], a1 = As[r + 64][kk];
#pragma unroll
            for (int e = 0; e < 16; ++e) { const float b = Bs[cb + e][kk]; acc0[e] += a0 * b; acc1[e] += a1 * b; }
        }
        __syncthreads();
    }
    E(rt, pn, wc, r, q4, acc0);
    E(rt, pn, wc, r + 64, q4, acc1);
}

__global__ __launch_bounds__(256) void k_vrstd(const bf16_t* V, float* vr) {
    const int wave = threadIdx.x >> 6, lane = threadIdx.x & 63;
    for (int m = blockIdx.x * 4 + wave; m < T; m += gridDim.x * 4) {
        const unsigned long long w = ((const unsigned long long*)(V + (size_t)m * 256))[lane];
        const float a = __uint_as_float((unsigned)(w << 16)), b = __uint_as_float((unsigned)w & 0xffff0000u), c = __uint_as_float((unsigned)(w >> 32) << 16), d = __uint_as_float((unsigned)(w >> 32) & 0xffff0000u);
        const float s = wave_sum(a * a + b * b + c * c + d * d);
        if (lane == 0) vr[m] = 1.0f / sqrtf(s * (1.f / 256.f) + EPS);
    }
}
__global__ __launch_bounds__(256) void k_nsgu(const bf16_t* U, const bf16_t* V, const float* vr, const float* sgu_norm, const float* sgu_w, const float* sgu_b, bf16_t* O) {
    const int t = blockIdx.x, s = t % SEQ, i = s & 127, t0 = t - i, ch = threadIdx.x, h = ch >> 6;
    const int jmax = (i < 64) ? 64 : 128;
    const float* w = sgu_w + ((size_t)h * 128 + i) * 128;
    const float gn = sgu_norm[ch];
    float acc = 0.f;
    for (int j = 0; j < jmax; ++j) acc += w[j] * (bf2f(V[(size_t)(t0 + j) * 256 + ch]) * vr[t0 + j] * gn);
    acc += sgu_b[h * 128 + i];
    const float oa = bf2f(U[(size_t)t * 256 + ch]) * acc;
    const float ss = wave_sum(oa * oa);
    O[(size_t)t * D + ch] = f2bf(oa * (1.0f / sqrtf(ss * (1.f / 64.f) + EPS)));
}
__global__ __launch_bounds__(64) void k_ns5scan(const bf16_t* ZS, const float* lre, const float* lim, const float* logdt, const float* bre, const float* bim, const float* cre, const float* cim, const float* dd, float* YG) {
    const int b = blockIdx.x / 16, g = blockIdx.x % 16, p = threadIdx.x;
    const double lr = lre[g * 64 + p], li = lim[g * 64 + p], dt = exp((double)logdt[g]);
    const double er = exp(lr * dt), ar_d = er * cos(li * dt), ai_d = er * sin(li * dt);
    const double nr = ar_d - 1.0, ni = ai_d, den = lr * lr + li * li;
    const double fr = (nr * lr + ni * li) / den, fi = (ni * lr - nr * li) / den;
    const float ar = (float)ar_d, ai = (float)ai_d;
    float Br[16], Bi[16], Cr[16], Ci[16];
#pragma unroll
    for (int h = 0; h < 16; ++h) {
        const double x = bre[(g * 64 + p) * 16 + h], y = bim[(g * 64 + p) * 16 + h];
        Br[h] = (float)(fr * x - fi * y); Bi[h] = (float)(fr * y + fi * x);
        Cr[h] = cre[(g * 16 + h) * 64 + p]; Ci[h] = cim[(g * 16 + h) * 64 + p];
    }
    const float dmy = (p < 16) ? dd[g * 16 + p] : 0.f;
    float sr = 0.f, si = 0.f;
    const bf16_t* z = ZS + (size_t)b * SEQ * 256 + g * 16;
    float* yo = YG + (size_t)b * SEQ * 256 + g * 16;
    for (int t = 0; t < SEQ; ++t) {
        const u32x4 w0 = *(const u32x4*)(z + (size_t)t * 256), w1 = *(const u32x4*)(z + (size_t)t * 256 + 8);
        float u[16];
        u[0] = __uint_as_float(w0.x << 16); u[1] = __uint_as_float(w0.x & 0xffff0000u); u[2] = __uint_as_float(w0.y << 16); u[3] = __uint_as_float(w0.y & 0xffff0000u);
        u[4] = __uint_as_float(w0.z << 16); u[5] = __uint_as_float(w0.z & 0xffff0000u); u[6] = __uint_as_float(w0.w << 16); u[7] = __uint_as_float(w0.w & 0xffff0000u);
        u[8] = __uint_as_float(w1.x << 16); u[9] = __uint_as_float(w1.x & 0xffff0000u); u[10] = __uint_as_float(w1.y << 16); u[11] = __uint_as_float(w1.y & 0xffff0000u);
        u[12] = __uint_as_float(w1.z << 16); u[13] = __uint_as_float(w1.z & 0xffff0000u); u[14] = __uint_as_float(w1.w << 16); u[15] = __uint_as_float(w1.w & 0xffff0000u);
        float br = 0.f, bi = 0.f;
#pragma unroll
        for (int h = 0; h < 16; ++h) { br += Br[h] * u[h]; bi += Bi[h] * u[h]; }
        const float nsr = ar * sr - ai * si + br, nsi = ar * si + ai * sr + bi; sr = nsr; si = nsi;
        float mine = 0.f, myu = 0.f;
#pragma unroll
        for (int h = 0; h < 16; ++h) { const float v = wave_sum(Cr[h] * sr - Ci[h] * si); if (p == h) { mine = v; myu = u[h]; } }
        if (p < 16) yo[(size_t)t * 256 + p] = gelu_tanh(mine + dmy * myu);
    }
}
__global__ __launch_bounds__(256) void k_nglu(const float* YG, const bf16_t* GLUT, const float* glu_b, bf16_t* O) {
    __shared__ float ys[256];
    const int t = blockIdx.x, n = threadIdx.x;
    const float y = bf2f(f2bf(YG[(size_t)t * 256 + n]));
    ys[n] = y; __syncthreads();
    const bf16_t* w = GLUT + (size_t)n * 256;
    float z = 0.f;
    for (int k = 0; k < 256; k += 8) { const u32x4 q = *(const u32x4*)(w + k);
        z += ys[k] * __uint_as_float(q.x << 16) + ys[k + 1] * __uint_as_float(q.x & 0xffff0000u) + ys[k + 2] * __uint_as_float(q.y << 16) + ys[k + 3] * __uint_as_float(q.y & 0xffff0000u)
           + ys[k + 4] * __uint_as_float(q.z << 16) + ys[k + 5] * __uint_as_float(q.z & 0xffff0000u) + ys[k + 6] * __uint_as_float(q.w << 16) + ys[k + 7] * __uint_as_float(q.w & 0xffff0000u); }
    z += glu_b[n];
    const float ob = y / (1.f + __expf(-z));
    const float ss = wave_sum(ob * ob);
    O[(size_t)t * D + 256 + n] = f2bf(ob * (1.0f / sqrtf(ss * (1.f / 64.f) + EPS)));
}
__global__ __launch_bounds__(256) void k_nattn(const bf16_t* QH, const bf16_t* KH, const bf16_t* VH, const float* relb, bf16_t* O) {
    __shared__ float ps[4][576];
    __shared__ float qs[4][64];
    const int wave = threadIdx.x >> 6, lane = threadIdx.x & 63;
    const int w = blockIdx.x * 4 + wave;
    const int bh = w / SEQ, s = w % SEQ, b = bh / NH, h = bh % NH, qc = s >> 6, qi = s & 63;
    qs[wave][lane] = bf2f(QH[(size_t)w * 64 + lane]);
    asm volatile("s_waitcnt lgkmcnt(0)" ::: "memory");
    const bf16_t* Kb = KH + (size_t)bh * SEQ * 64; const bf16_t* Vb = VH + (size_t)bh * SEQ * 64;
    const float* rb = relb + h * 513;
    float mx = -3.0e38f;
    for (int kb = lane; kb < 576; kb += 64) {
        const int key = (qc - 8) * 64 + kb;
        float sc = -3.0e38f;
        if (key >= 0) {
            const u32x4* kr = (const u32x4*)(Kb + (size_t)key * 64);
            float dot = 0.f;
#pragma unroll
            for (int d8 = 0; d8 < 8; ++d8) { const u32x4 q = kr[d8]; const float* qq = &qs[wave][d8 * 8];
                dot += qq[0] * __uint_as_float(q.x << 16) + qq[1] * __uint_as_float(q.x & 0xffff0000u) + qq[2] * __uint_as_float(q.y << 16) + qq[3] * __uint_as_float(q.y & 0xffff0000u)
                     + qq[4] * __uint_as_float(q.z << 16) + qq[5] * __uint_as_float(q.z & 0xffff0000u) + qq[6] * __uint_as_float(q.w << 16) + qq[7] * __uint_as_float(q.w & 0xffff0000u); }
            int rel = 512 + qi - kb; rel = rel > 256 ? 256 : rel; rel = rel < -256 ? -256 : rel;
            sc = dot + rb[rel + 256] * LOG2E;
        }
        ps[wave][kb] = sc; mx = fmaxf(mx, sc);
    }
    mx = wave_max(mx);
    float sum = 0.f;
    for (int kb = lane; kb < 576; kb += 64) { const float sc = ps[wave][kb]; const float p = (sc < -1.0e38f) ? 0.f : exp2f(sc - mx); ps[wave][kb] = p; sum += p; }
    sum = wave_sum(sum);
    asm volatile("s_waitcnt lgkmcnt(0)" ::: "memory");
    float o = 0.f;
    const int kb0 = (qc >= 8) ? 0 : (8 - qc) * 64;
    for (int kb = kb0; kb < 576; ++kb) { const int key = (qc - 8) * 64 + kb; o += ps[wave][kb] * bf2f(Vb[(size_t)key * 64 + lane]); }
    o /= sum;
    const float ss = wave_sum(o * o);
    O[(size_t)(b * SEQ + s) * D + 512 + h * 64 + lane] = f2bf(o * (1.0f / sqrtf(ss * (1.f / 64.f) + EPS)));
}
__global__ __launch_bounds__(256) void k_nroute(const float* x, const float* nffn, const float* wg, const float* bg, const float* we, const float* be,
                                                 unsigned* cnt, int* m_bucket, int* m_pos, float* m_gw0, float* m_gw1, float* m_rs) {
    const int wave = threadIdx.x >> 6, lane = threadIdx.x & 63;
    const int t = blockIdx.x * 4 + wave;
    const float* xr = x + (size_t)t * D;
    float xv[16]; float ss = 0.f;
#pragma unroll
    for (int j = 0; j < 4; ++j) { const f32x4 v = ((const f32x4*)xr)[lane + 64 * j]; xv[4 * j] = v.x; xv[4 * j + 1] = v.y; xv[4 * j + 2] = v.z; xv[4 * j + 3] = v.w; ss += v.x * v.x + v.y * v.y + v.z * v.z + v.w * v.w; }
    ss = wave_sum(ss);
    const float rs = 1.0f / sqrtf(ss * (1.f / D) + EPS);
    float lg[20];
#pragma unroll
    for (int o = 0; o < 20; ++o) lg[o] = 0.f;
#pragma unroll
    for (int j = 0; j < 4; ++j)
#pragma unroll
        for (int e = 0; e < 4; ++e) { const int k = 4 * (lane + 64 * j) + e; const float hn = xv[4 * j + e] * rs * nffn[k];
            const f32x4 g4 = *(const f32x4*)(wg + (size_t)k * 4);
            lg[0] += hn * g4.x; lg[1] += hn * g4.y; lg[2] += hn * g4.z; lg[3] += hn * g4.w;
#pragma unroll
            for (int gi = 0; gi < 4; ++gi) { const f32x4 e4 = *(const f32x4*)(we + ((size_t)gi * D + k) * 4);
                lg[4 + 4 * gi] += hn * e4.x; lg[5 + 4 * gi] += hn * e4.y; lg[6 + 4 * gi] += hn * e4.z; lg[7 + 4 * gi] += hn * e4.w; } }
#pragma unroll
    for (int o = 0; o < 20; ++o) lg[o] = wave_sum(lg[o]);
    if (lane == 0) {
        float gl[4]; int gt = 0;
#pragma unroll
        for (int i = 0; i < 4; ++i) gl[i] = lg[i] + bg[i];
        float gm = gl[0];
#pragma unroll
        for (int i = 1; i < 4; ++i) if (gl[i] > gm) { gm = gl[i]; gt = i; }
        float gs = 0.f;
#pragma unroll
        for (int i = 0; i < 4; ++i) gs += __expf(gl[i] - gm);
        const float pg = 1.f / gs;
        float el[4];
#pragma unroll
        for (int i = 0; i < 4; ++i) { float v = 0.f;
#pragma unroll
            for (int gi = 0; gi < 4; ++gi) v = (gi == gt) ? lg[4 + 4 * gi + i] + be[gi * 4 + i] : v;
            el[i] = v; }
        int i1 = 0; float m1 = el[0];
#pragma unroll
        for (int i = 1; i < 4; ++i) if (el[i] > m1) { m1 = el[i]; i1 = i; }
        int i2 = -1; float m2 = -3.0e38f;
#pragma unroll
        for (int i = 0; i < 4; ++i) if (i != i1 && el[i] > m2) { m2 = el[i]; i2 = i; }
        const float e2 = __expf(m2 - m1); const float w1 = 1.f / (1.f + e2), w2 = e2 / (1.f + e2);
        const int lo = i1 < i2 ? i1 : i2, hi = i1 < i2 ? i2 : i1;
        const int pi = (lo == 0) ? (hi - 1) : (lo == 1 ? hi + 1 : 5);
        const int bk = gt * 6 + pi;
        const float glo = pg * (i1 < i2 ? w1 : w2), ghi = pg * (i1 < i2 ? w2 : w1);
        const unsigned pos = atomicAdd(cnt + bk, 1u);
        m_bucket[t] = bk; m_pos[t] = (int)pos; m_gw0[t] = glo; m_gw1[t] = ghi; m_rs[t] = rs;
    }
}
__global__ __launch_bounds__(256) void k_nperm(const float* x, const unsigned* cnt, unsigned* tileb, const int* m_bucket, const int* m_pos, const float* m_gw0, const float* m_gw1, const float* m_rs,
                                               bf16_t* XS, int* stok, float* sgw0, float* sgw1, float* srs) {
    const int wave = threadIdx.x >> 6, lane = threadIdx.x & 63;
    const int t = blockIdx.x * 4 + wave;
    const int bk = m_bucket[t];
    int base = 0, ntile = 0;
    for (int b2 = 0; b2 < NBUCKET; ++b2) { const int nt = ((int)cnt[b2] + 255) >> 8; if (b2 < bk) base += nt; ntile += nt; }
    if (t == 0 && lane == 0) { int ti = 0; for (int b2 = 0; b2 < NBUCKET; ++b2) { const int nt = ((int)cnt[b2] + 255) >> 8; for (int i = 0; i < nt; ++i) tileb[ti++] = (unsigned)b2; } for (; ti < 160; ++ti) tileb[ti] = 0xffffffffu; }
    const int dst = base * 256 + m_pos[t];
    const f32x4* xr = (const f32x4*)(x + (size_t)t * D) + lane;
    unsigned long long* o8 = (unsigned long long*)(XS + (size_t)dst * D) + lane;
#pragma unroll
    for (int j = 0; j < 4; ++j) { const f32x4 v = xr[64 * j]; o8[64 * j] = (unsigned long long)pk2(v.x, v.y) | ((unsigned long long)pk2(v.z, v.w) << 32); }
    if (lane == 0) { stok[dst] = t; sgw0[dst] = m_gw0[t]; sgw1[dst] = m_gw1[t]; srs[dst] = m_rs[t]; }
}

extern "C" void kernel_launch(void* const* d_in, const int* in_sizes, int n_in, void* d_out, int out_size, void* d_ws, size_t ws_size, hipStream_t stream) {
    if (n_in != 29 || ws_size < WS_END) { fprintf(stderr, "kernel_launch: unexpected inputs (n_in %d, ws %zu)\n", n_in, ws_size); return; }
    Params P{};
    for (int i = 0; i < 29; ++i) P.in[i] = (const float*)d_in[i];
    P.out = (float*)d_out; P.ws = (unsigned char*)d_ws;
    unsigned char* ws = (unsigned char*)d_ws;
    hipMemsetAsync(ws + WS_CTL, 0, 1 * MiB, stream);
    hipMemsetAsync(ws + WS_META + MT_STOK, 0xFF, (size_t)MAXROWS * 4, stream);
    k_prep<<<1024, 256, 0, stream>>>(P);
    float* out = (float*)d_out;
    bf16_t* XB = (bf16_t*)(ws + WS_XB); float* RSTD = (float*)(ws + WS_META + MT_RSTD); float* VR = (float*)(ws + WS_META + MT_VR);
    bf16_t *U = (bf16_t*)(ws + WS_U), *V = (bf16_t*)(ws + WS_V), *ZS = (bf16_t*)(ws + WS_ZS), *QH = (bf16_t*)(ws + WS_QH), *KH = (bf16_t*)(ws + WS_KH), *VH = (bf16_t*)(ws + WS_VH);
    bf16_t *O = (bf16_t*)(ws + WS_O), *XS = (bf16_t*)(ws + WS_XS), *H = (bf16_t*)(ws + WS_H);
    float* YG = (float*)(ws + WS_YG);
    unsigned* ctl = (unsigned*)(ws + WS_CTL);
    int* m_bucket = (int*)(ws + WS_META + MT_BUCKET); int* m_pos = (int*)(ws + WS_META + MT_POS);
    float* m_gw0 = (float*)(ws + WS_META + MT_GW0); float* m_gw1 = (float*)(ws + WS_META + MT_GW1); float* m_rs = (float*)(ws + WS_META + MT_RS2);
    int* stok = (int*)(ws + WS_META + MT_STOK); float* sgw0 = (float*)(ws + WS_META + MT_SGW0); float* sgw1 = (float*)(ws + WS_META + MT_SGW1); float* srs = (float*)(ws + WS_META + MT_SRS);
    for (int l = 0; l < DEPTH; ++l) {
        const float* xin = (l == 0) ? P.in[0] : out;
        k_conv<<<2048, 256, 0, stream>>>(xin, XB, RSTD);
        { EpiIn E{RSTD, U, V, ZS, QH, KH, VH, P.in[16] + l * 64, P.in[17] + l * 64};
          k_ngemm<EpiIn><<<(T / 128) * 36, 256, 0, stream>>>(XB, (const bf16_t*)(ws + WS_WIN) + (size_t)l * NIN * D, D, 36, E); }
        k_vrstd<<<2048, 256, 0, stream>>>(V, VR);
        k_nsgu<<<T, 256, 0, stream>>>(U, V, VR, P.in[3] + l * 256, P.in[4] + (size_t)l * 4 * 128 * 128, P.in[5] + l * 512, O);
        k_ns5scan<<<64, 64, 0, stream>>>(ZS, P.in[6] + l * 1024, P.in[7] + l * 1024, P.in[8] + l * 16, P.in[9] + l * 16384, P.in[10] + l * 16384, P.in[11] + l * 16384, P.in[12] + l * 16384, P.in[13] + l * 256, YG);
        k_nglu<<<T, 256, 0, stream>>>(YG, (const bf16_t*)(ws + WS_GLU) + (size_t)l * 65536, P.in[15] + l * 256, O);
        k_nattn<<<T * NH / 4, 256, 0, stream>>>(QH, KH, VH, P.in[18] + (size_t)l * NH * 513, O);
        { EpiOut E{xin, out};
          k_ngemm<EpiOut><<<(T / 128) * 16, 256, 0, stream>>>(O, (const bf16_t*)(ws + WS_WOUT) + (size_t)l * D * D, D, 16, E); }
        unsigned* cnt = ctl + CW_CNT + l * 32; unsigned* tileb = ctl + CW_TILEB + l * 160;
        k_nroute<<<T / 4, 256, 0, stream>>>(out, P.in[21] + l * D, P.in[22] + (size_t)l * D * 4, P.in[23] + l * 4, P.in[24] + (size_t)l * 4 * D * 4, P.in[25] + l * 16, cnt, m_bucket, m_pos, m_gw0, m_gw1, m_rs);
        if (l == 1) hipMemsetAsync(ws + WS_META + MT_STOK, 0xFF, (size_t)MAXROWS * 4, stream);
        k_nperm<<<T / 4, 256, 0, stream>>>(out, cnt, tileb, m_bucket, m_pos, m_gw0, m_gw1, m_rs, XS, stok, sgw0, sgw1, srs);
        { EpiG1 E{tileb, sgw0, sgw1, srs, H, (const bf16_t*)(ws + WS_WGU) + (size_t)l * 16 * 512 * D};
          k_ngemm<EpiG1><<<(MAXROWS / 128) * 16, 256, 0, stream>>>(XS, nullptr, D, 16, E); }
        { EpiG2 E{tileb, stok, out, (const bf16_t*)(ws + WS_WDN) + (size_t)l * NBUCKET * D * 512};
          k_ngemm<EpiG2><<<(MAXROWS / 128) * 16, 256, 0, stream>>>(H, nullptr, 512, 16, E); }
    }
}
```

```cpp
#include <hip/hip_runtime.h>
#include <hip/hip_cooperative_groups.h>
#include <cstdint>
#include <cstdio>
namespace cg = cooperative_groups;

#ifndef MK_ONE_LAUNCH
#define MK_ONE_LAUNCH 1
#endif

namespace pg8 {
#define PG8_LAS __attribute__((address_space(3)))
typedef unsigned short bf16_t;
typedef short bf16x8 __attribute__((ext_vector_type(8)));
typedef float f32x4 __attribute__((ext_vector_type(4)));
typedef unsigned u32x4 __attribute__((ext_vector_type(4)));
constexpr int BM = 256, BK = 64, HALF = 128, HTB = HALF * BK * 2  , STAGE_BYTES = 8 * HTB, NXCD = 8, WGM = 8;
__host__ __device__ __forceinline__ int lds_byte(int r, int c) { const int st = (r >> 4) * 2 + (c >> 5), rr = r & 15, cc = c & 31, ob = rr * 64 + cc * 2; return st * 1024 + (ob ^ (((ob >> 9) & 1) << 5)); }
__host__ __device__ __forceinline__ void stage_rc(int b, int& R, int& C) { const int st = b / 1024, sb = b % 1024, swz = sb ^ (((sb >> 9) & 1) << 5); R = (st >> 1) * 16 + swz / 64; C = (st & 1) * 32 + (swz % 64) / 2; }
__host__ __device__ __forceinline__ int perm32(int rho) { const int n = rho >> 4, i = rho & 15; return 8 * (i >> 2) + 4 * n + (i & 3); }
struct Unit { int pm, pn, hf; };
__device__ __forceinline__ unsigned cvt_pk_bf16(float lo, float hi) { unsigned r; asm volatile("v_cvt_pk_bf16_f32 %0, %1, %2" : "=v"(r) : "v"(lo), "v"(hi)); return r; }
template <class Epi, class Sched, bool ALIGN_EPI = false, bool SP2 = false, bool GATHER = false>
__device__ __forceinline__ void gemm_phase(PG8_LAS unsigned char* lds, const int gK, const Sched& S, const Epi& E, const int tid) {
    const int wid = __builtin_amdgcn_readfirstlane(tid >> 6), lane = tid & 63, wr = wid >> 2, wc = wid & 3, fr = lane & 15, fq = lane >> 4;
    const int K = gK, nt = K / BK;
    unsigned voffA[2], voffB[2];
#pragma unroll
    for (int i = 0; i < 2; ++i) { int R, C; stage_rc(tid * 16 + i * 8192, R, C); const int Rb = Epi::PERM ? ((R & ~31) + perm32(R & 31)) : R;
        voffA[i] = (unsigned)(R * K + C) * 2u; voffB[i] = (unsigned)(Rb * K + C) * 2u; }
    unsigned gA[2], gN[2], gcol[2];
    if constexpr (GATHER) { _Pragma("unroll") for (int i = 0; i < 2; ++i) { int R_, C_; stage_rc(tid * 16 + i * 8192, R_, C_); gcol[i] = (unsigned)C_ * 2u; } }
#define PG8_GLOAD(dst, unit) do { _Pragma("unroll") for (int _h = 0; _h < 2; ++_h) { int R0_, R1_, C_; stage_rc(tid * 16, R0_, C_); stage_rc(tid * 16 + 8192, R1_, C_); \
        dst[_h] = (unsigned)S.a_row(unit, R0_ + 128 * _h) | ((unsigned)S.a_row(unit, R1_ + 128 * _h) << 16); } } while (0)
#define PG8_STAGE_A(bufoff, gbase, half, isnext) do { if constexpr (GATHER) { const unsigned g_ = (isnext) ? gN[half] : gA[half]; \
            unsigned vv_[2] = {(g_ & 0xffffu) * (unsigned)(K * 2) + gcol[0], (g_ >> 16) * (unsigned)(K * 2) + gcol[1]}; PG8_STAGE(bufoff, gbase, vv_); } \
        else { PG8_STAGE(bufoff, (gbase) + (half) * hstep, voffA); } } while (0)
    const size_t kstep = (size_t)(BK * 2);
    const size_t hstep = (size_t)HALF * K * 2;
    const unsigned ldsw = (unsigned)wid * 1024u;
    const int aoff = lds_byte(wr * 64 + fr, fq * 8), boff = lds_byte(wc * 32 + fr, fq * 8);
#define PG8_SA(b, h) (((b) * 2 + (h)) * HTB)
#define PG8_SB(b, h) ((4 + (b) * 2 + (h)) * HTB)
#define PG8_STAGE(bufoff, gbase, voff) do { _Pragma("unroll") for (int _i = 0; _i < 2; ++_i) \
        __builtin_amdgcn_global_load_lds((const unsigned*)((const char*)(gbase) + (voff)[_i]), (PG8_LAS unsigned*)(lds + (bufoff) + ldsw + _i * 8192), 16, 0, 0); } while (0)
#define PG8_LDA(dst, b, h) do { _Pragma("unroll") for (int m = 0; m < 4; ++m) _Pragma("unroll") for (int k = 0; k < 2; ++k) dst[m][k] = *(const PG8_LAS bf16x8*)(lds + PG8_SA(b, h) + aoff + m * 2048 + k * 1024); } while (0)
#define PG8_LDB(dst, b, h) do { _Pragma("unroll") for (int n = 0; n < 2; ++n) _Pragma("unroll") for (int k = 0; k < 2; ++k) dst[n][k] = *(const PG8_LAS bf16x8*)(lds + PG8_SB(b, h) + boff + n * 2048 + k * 1024); } while (0)
#define PG8_MMA(ai, bj, At, Bt) do { __builtin_amdgcn_s_setprio(1); _Pragma("unroll") for (int m = 0; m < 4; ++m) _Pragma("unroll") for (int n = 0; n < 2; ++n) _Pragma("unroll") for (int k = 0; k < 2; ++k) \
        acc[ai][bj][m][n] = __builtin_amdgcn_mfma_f32_16x16x32_bf16(Bt[n][k], At[m][k], acc[ai][bj][m][n], 0, 0, 0); __builtin_amdgcn_s_setprio(0); } while (0)
#define PG8_WAIT_V(n) asm volatile("s_waitcnt vmcnt(" #n ")" ::: "memory")
#define PG8_WAIT_L(n) asm volatile("s_waitcnt lgkmcnt(" #n ")" ::: "memory")
#define PG8_BAR __builtin_amdgcn_s_barrier()
#define PG8_SCHED __builtin_amdgcn_sched_barrier(0)
    Unit cur, nxt; int ui = 0;
    if (!S.next(0, cur)) return;
    f32x4 acc[2][2][4][2];
#pragma unroll
    for (int a = 0; a < 2; ++a)
#pragma unroll
        for (int b = 0; b < 2; ++b)
#pragma unroll
            for (int m = 0; m < 4; ++m)
#pragma unroll
                for (int n = 0; n < 2; ++n) acc[a][b][m][n] = (f32x4){0.f, 0.f, 0.f, 0.f};
    bf16x8 At[4][2], B0[2][2], B1[2][2];
    const char* cA = S.a_base(cur); const char* cB = S.b_base(cur);
    S.a_ready(cur);
    if constexpr (GATHER) PG8_GLOAD(gA, cur);
    if constexpr (SP2) {
        PG8_STAGE(PG8_SB(0, 0), cB, voffB); PG8_STAGE(PG8_SB(0, 1), cB + hstep, voffB); PG8_STAGE_A(PG8_SA(0, 0), cA, 0, false); PG8_STAGE_A(PG8_SA(0, 1), cA, 1, false);
        if (wr == 1) PG8_BAR;
        PG8_WAIT_V(2); PG8_BAR;
        PG8_STAGE(PG8_SB(1, 0), cB + kstep, voffB); PG8_STAGE_A(PG8_SA(1, 0), cA + kstep, 0, false); PG8_STAGE(PG8_SB(1, 1), cB + hstep + kstep, voffB);
        PG8_WAIT_V(6); PG8_BAR;
    } else {
        PG8_STAGE(PG8_SB(0, 0), cB, voffB); PG8_STAGE(PG8_SA(0, 0), cA, voffA); PG8_STAGE(PG8_SB(0, 1), cB + hstep, voffB); PG8_STAGE(PG8_SA(0, 1), cA + hstep, voffA);
        if (wr == 1) PG8_BAR;
        PG8_WAIT_V(4); PG8_BAR;
        PG8_STAGE(PG8_SB(1, 0), cB + kstep, voffB); PG8_STAGE(PG8_SA(1, 0), cA + kstep, voffA); PG8_STAGE(PG8_SB(1, 1), cB + hstep + kstep, voffB);
        PG8_WAIT_V(6); PG8_BAR;
    }
    for (;;) {
        const bool has_next = S.next(ui + 1, nxt);
        if constexpr (GATHER) { if (has_next) { PG8_GLOAD(gN, nxt); asm volatile("s_waitcnt vmcnt(0)" ::: "memory");
            asm volatile("" : "+v"(gN[0]), "+v"(gN[1])); } }
        const char* nA = has_next ? S.a_base(nxt) : cA; const char* nB = has_next ? S.b_base(nxt) : cB;
        for (int t = 0; t < nt; t += 2) {
            const bool last = (t == nt - 2); const bool lastnext = last && has_next; (void)lastnext; const bool fullu = (cur.hf == 0);
            const char* a1 = cA + (size_t)(t + 1) * kstep;
            const char* a2 = last ? nA : cA + (size_t)(t + 2) * kstep; const char* b2 = last ? nB : cB + (size_t)(t + 2) * kstep;
            const char* a3 = a2 + kstep; const char* b3 = b2 + kstep;
            if (last && has_next) S.a_ready(nxt);
            if constexpr (SP2) {
            PG8_LDB(B0, 0, 0); PG8_LDB(B1, 0, 1); PG8_SCHED; PG8_LDA(At, 0, 0); PG8_STAGE_A(PG8_SA(1, 1), a1, 1, false);
            PG8_WAIT_V(8); PG8_WAIT_L(0); PG8_BAR; PG8_MMA(0, 0, At, B0); PG8_MMA(0, 1, At, B1); PG8_BAR; PG8_SCHED;
            PG8_LDA(At, 0, 1); PG8_STAGE(PG8_SB(0, 0), b2, voffB); PG8_STAGE(PG8_SB(0, 1), b2 + hstep, voffB); PG8_STAGE_A(PG8_SA(0, 0), a2, 0, lastnext);
            PG8_WAIT_V(8); PG8_WAIT_L(0); PG8_BAR; if (fullu) { PG8_MMA(1, 0, At, B0); PG8_MMA(1, 1, At, B1); } PG8_BAR; PG8_SCHED;
            PG8_LDB(B0, 1, 0); PG8_LDB(B1, 1, 1); PG8_SCHED; PG8_LDA(At, 1, 0); PG8_STAGE_A(PG8_SA(0, 1), a2, 1, lastnext);
            PG8_WAIT_V(8); PG8_WAIT_L(0); PG8_BAR; PG8_MMA(0, 0, At, B0); PG8_MMA(0, 1, At, B1); PG8_BAR; PG8_SCHED;
            PG8_LDA(At, 1, 1); PG8_STAGE(PG8_SB(1, 0), b3, voffB); PG8_STAGE(PG8_SB(1, 1), b3 + hstep, voffB); PG8_STAGE_A(PG8_SA(1, 0), a3, 0, lastnext);
            PG8_WAIT_V(8); PG8_WAIT_L(0); PG8_BAR; if (fullu) { PG8_MMA(1, 0, At, B0); PG8_MMA(1, 1, At, B1); } PG8_BAR; PG8_SCHED;
            } else {
            PG8_LDB(B0, 0, 0); PG8_SCHED; PG8_LDA(At, 0, 0); PG8_STAGE(PG8_SA(1, 1), a1 + hstep, voffA);
            PG8_WAIT_L(8); PG8_BAR; PG8_WAIT_L(0); PG8_MMA(0, 0, At, B0); PG8_BAR; PG8_SCHED;
            PG8_LDB(B1, 0, 1); PG8_STAGE(PG8_SB(0, 0), b2, voffB);
            PG8_BAR; PG8_WAIT_L(0); PG8_MMA(0, 1, At, B1); PG8_BAR;
            PG8_LDA(At, 0, 1); PG8_STAGE(PG8_SA(0, 0), a2, voffA);
            PG8_BAR; PG8_WAIT_L(0); PG8_MMA(1, 0, At, B0); PG8_BAR; PG8_SCHED;
            PG8_STAGE(PG8_SB(0, 1), b2 + hstep, voffB);
            PG8_WAIT_V(6); PG8_BAR; PG8_MMA(1, 1, At, B1); PG8_BAR;
            PG8_LDB(B0, 1, 0); PG8_SCHED; PG8_LDA(At, 1, 0); PG8_STAGE(PG8_SA(0, 1), a2 + hstep, voffA);
            PG8_WAIT_L(8); PG8_BAR; PG8_WAIT_L(0); PG8_MMA(0, 0, At, B0); PG8_BAR; PG8_SCHED;
            PG8_LDB(B1, 1, 1); PG8_STAGE(PG8_SB(1, 0), b3, voffB);
            PG8_BAR; PG8_WAIT_L(0); PG8_MMA(0, 1, At, B1); PG8_BAR;
            PG8_LDA(At, 1, 1); PG8_STAGE(PG8_SA(1, 0), a3, voffA);
            PG8_BAR; PG8_WAIT_L(0); PG8_MMA(1, 0, At, B0); PG8_BAR; PG8_SCHED;
            PG8_STAGE(PG8_SB(1, 1), b3 + hstep, voffB);
            PG8_WAIT_V(6); PG8_BAR; PG8_MMA(1, 1, At, B1); PG8_BAR;
            }
        }
        if constexpr (ALIGN_EPI) { if (wr == 0) PG8_BAR; }
        if constexpr (!Epi::AFTER_DRAIN) { E(acc, cur, wr, wc, fr, fq); S.done(cur); }
        if (!has_next) break;
#pragma unroll
        for (int a = 0; a < 2; ++a)
#pragma unroll
            for (int b = 0; b < 2; ++b)
#pragma unroll
                for (int m = 0; m < 4; ++m)
#pragma unroll
                    for (int n = 0; n < 2; ++n) acc[a][b][m][n] = (f32x4){0.f, 0.f, 0.f, 0.f};
        cur = nxt; cA = nA; cB = nB; ++ui;
        if constexpr (GATHER) { gA[0] = gN[0]; gA[1] = gN[1]; }
        if constexpr (ALIGN_EPI) { if (wr == 1) PG8_BAR; }
    }
    PG8_WAIT_V(0);
    if constexpr (!ALIGN_EPI) { if (wr == 0) PG8_BAR; }
    PG8_BAR;
    if constexpr (Epi::AFTER_DRAIN) { E.fused(acc, cur, wr, wc, fr, fq, lds, wid, lane); S.done(cur); }
#undef PG8_SA
#undef PG8_GLOAD
#undef PG8_STAGE_A
#undef PG8_SB
#undef PG8_STAGE
#undef PG8_LDA
#undef PG8_LDB
#undef PG8_MMA
#undef PG8_WAIT_V
#undef PG8_WAIT_L
#undef PG8_BAR
#undef PG8_SCHED
}
}

typedef unsigned short bf16_t;
typedef unsigned u32x4 __attribute__((ext_vector_type(4)));
typedef float f32x4 __attribute__((ext_vector_type(4)));
#define LAS __attribute__((address_space(3)))

constexpr int BATCH = 4, SEQ = 8192, T = BATCH * SEQ, D = 1024, NIN = 2304, DEPTH = 2;
constexpr int NH = 8;
constexpr int NBUCKET = 24, MAXTILES = 152, MAXROWS = MAXTILES * 256;
constexpr float EPS = 1e-6f;
constexpr float LOG2E = 1.4426950408889634f;
constexpr int NWAVES = 8, NTHREADS = 512;
constexpr int LDS_BYTES = 155648;
constexpr int LDS_BARW = LDS_BYTES - 64;

constexpr size_t MiB = 1u << 20;
constexpr size_t WS_CTL = 0;
constexpr size_t WS_WIN = 1 * MiB;
constexpr size_t WS_WOUT = 10 * MiB;
constexpr size_t WS_WGU = 14 * MiB;
constexpr size_t WS_WDN = 46 * MiB;
constexpr size_t WS_GLU = 94 * MiB;
constexpr size_t WS_S5 = 95 * MiB;
constexpr size_t S5_M1 = 0, S5_M2P = 1 * MiB, S5_TT = 2 * MiB, S5_AP16 = 2 * MiB + 256 * 1024, S5_AP256 = 2 * MiB + 512 * 1024, S5_LAYER = 4 * MiB;
constexpr size_t WS_S5F = WS_S5 + 8 * MiB;
constexpr size_t WS_SGUW = 94 * MiB + 512 * 1024;
constexpr size_t WS_ROUTEW = 105 * MiB;
constexpr size_t WS_XB = 106 * MiB;
constexpr size_t WS_META = 170 * MiB;
constexpr size_t WS_PROJ = 172 * MiB;
constexpr size_t WS_U = WS_PROJ, WS_V = WS_PROJ + 16 * MiB, WS_ZS = WS_PROJ + 32 * MiB;
constexpr size_t WS_QH = WS_PROJ + 48 * MiB, WS_KH = WS_PROJ + 80 * MiB, WS_VH = WS_PROJ + 112 * MiB;
constexpr size_t WS_XS = WS_PROJ;
constexpr size_t WS_H = WS_PROJ + 76 * MiB;
constexpr size_t WS_O = 316 * MiB;
constexpr size_t WS_YG = 380 * MiB;
constexpr size_t WS_SSQP = 380 * MiB;
constexpr size_t WS_SSQB = 382 * MiB;
constexpr size_t WS_BLIST = 384 * MiB;
constexpr size_t WS_BGW0 = 388 * MiB, WS_BGW1 = 392 * MiB, WS_BRS = 396 * MiB;
constexpr size_t WS_END = 412 * MiB;
constexpr size_t MT_RSTD = 0;
constexpr size_t MT_VR = 128 * 1024;
constexpr size_t MT_BUCKET = 256 * 1024;
constexpr size_t MT_POS = 384 * 1024;
constexpr size_t MT_GW0 = 512 * 1024;
constexpr size_t MT_GW1 = 640 * 1024;
constexpr size_t MT_RS2 = 768 * 1024;
constexpr size_t MT_STOK = 896 * 1024;
constexpr size_t MT_SGW0 = 1216 * 1024;
constexpr size_t MT_SGW1 = 1408 * 1024;
constexpr size_t MT_SRS = 1600 * 1024;
constexpr int CW_CNT = 64;
constexpr int CW_BAR = 4096;
constexpr int CW_TILEB = 256;

__device__ __forceinline__ float bf2f(bf16_t v) { return __uint_as_float(((unsigned)v) << 16); }
__device__ __forceinline__ bf16_t f2bf(float f) { unsigned u = __float_as_uint(f); return (bf16_t)((u + 0x7fffu + ((u >> 16) & 1u)) >> 16); }
__device__ __forceinline__ unsigned pk2(float lo, float hi) { return pg8::cvt_pk_bf16(lo, hi); }
__device__ __forceinline__ float fast_sigmoid_mul(float x, float z) { return x * __builtin_amdgcn_rcpf(1.f + __expf(-z)); }
__device__ __forceinline__ float gelu_tanh(float x) { const float u = 0.7978845608028654f * (x + 0.044715f * x * x * x); return fast_sigmoid_mul(x, 2.f * u); }
__device__ __forceinline__ float wave_sum(float v) {
#pragma unroll
    for (int o = 1; o < 64; o <<= 1) v += __shfl_xor(v, o);
    return v;
}
__device__ __forceinline__ float wave_max(float v) {
#pragma unroll
    for (int o = 1; o < 64; o <<= 1) v = fmaxf(v, __shfl_xor(v, o));
    return v;
}
#define GAS __attribute__((address_space(1)))
template <class Tp> __device__ __forceinline__ Tp* opaque(Tp* q) { GAS Tp* g = (GAS Tp*)q; asm volatile("" : "+v"(g)); return (Tp*)g; }
__device__ __forceinline__ const float* gptr(const float* q) { const GAS float* g = (const GAS float*)q; asm("" : "+s"(g)); return (const float*)g; }
__device__ __forceinline__ int pair_lo(int pi) { return pi < 3 ? 0 : (pi < 5 ? 1 : 2); }
__device__ __forceinline__ int pair_hi(int pi) { return pi < 3 ? pi + 1 : (pi < 5 ? pi - 1 : 3); }

#ifndef REP_ID
#define REP_ID -1
#endif
#ifndef REP_N
#define REP_N 4
#endif
#ifndef REP_PH
#define REP_PH -1
#endif
#define REPEAT(id, body) do { const int nrep_ = (REP_ID == (id) && l == 0) ? REP_N : 1; for (int rep_ = 0; rep_ < nrep_; ++rep_) { body; } } while (0)

struct KArgs { const float* in[29]; float* out; unsigned char* ws; int ph_lo, ph_hi; };

struct Ctx {
    LAS unsigned char* lds;
    const float* const* in; float* out; unsigned char* ws;
    int tid, lane, wave, gw, ngw, G;
    bool dry;
};

__host__ __device__ __forceinline__ int inproj_row_of_col(int n) {
    if (n < 768) return n;
    const int pn = n >> 8, r = n & 255, wc = r >> 6, bj = (r >> 5) & 1, i = r & 31;
    return pn * 256 + bj * 128 + wc * 32 + i;
}
struct TDesc { const float* W; const float* scale; bf16_t* WT; int N, ldk, koff, k0, n0, rowmode; };
struct TRegs { f32x4 v[16]; float s[16]; };
__device__ __forceinline__ void tr_load(const TDesc& d, TRegs& r, int lane) {
    const int kr = lane >> 4, c4 = (lane & 15) * 4;
#pragma unroll
    for (int i = 0; i < 16; ++i) { r.v[i] = *(const f32x4*)(d.W + (size_t)(d.k0 + 4 * i + kr) * d.N + d.n0 + c4); r.s[i] = d.scale ? d.scale[d.k0 + 4 * i + kr] : 1.f; }
}
__device__ __forceinline__ void tr_finish(const TDesc& d, const TRegs& r, LAS float* scr, int lane) {
    const int kr = lane >> 4, c4 = (lane & 15) * 4;
#pragma unroll
    for (int i = 0; i < 16; ++i) { const int kk = 4 * i + kr; const float s = r.s[i];
        LAS float* q = scr + kk * 65 + c4; q[0] = r.v[i].x * s; q[1] = r.v[i].y * s; q[2] = r.v[i].z * s; q[3] = r.v[i].w * s; }
    asm volatile("s_waitcnt lgkmcnt(0)" ::: "memory");
    const int c = lane & 7;
#pragma unroll
    for (int j = 0; j < 8; ++j) {
        const int nl = (lane >> 3) + 8 * j; const LAS float* s = scr + (8 * c) * 65 + nl;
        u32x4 o; o.x = pk2(s[0 * 65], s[1 * 65]); o.y = pk2(s[2 * 65], s[3 * 65]); o.z = pk2(s[4 * 65], s[5 * 65]); o.w = pk2(s[6 * 65], s[7 * 65]);
        const int n = d.n0 + nl; int row;
        if (d.rowmode == 0) row = n;
        else if (d.rowmode == 1) row = inproj_row_of_col(n);
        else if (d.rowmode == 2) row = 256 * (n >> 7) + (n & 127);
        else row = 256 * (n >> 7) + 128 + (n & 127);
        if (d.rowmode == 4) { const int k8 = (d.k0 >> 3) + c;
            *(u32x4*)(d.WT + ((size_t)(((n >> 5) * 16 + (k8 >> 1)) * 64 + (k8 & 1) * 32 + (n & 31))) * 8) = o; }
        else *(u32x4*)(d.WT + (size_t)row * d.ldk + d.koff + d.k0 + 8 * c) = o;
    }
    asm volatile("s_waitcnt lgkmcnt(0)" ::: "memory");
}
constexpr int IT_WIN = 16 * 36, IT_WOUT = 16 * 16, IT_WGU1 = 16 * 4, IT_WDN1 = 4 * 16, IT_GLU = 4 * 4;
constexpr int IT_L = IT_WIN + IT_WOUT + 16 * 2 * IT_WGU1 + NBUCKET * 2 * IT_WDN1 + IT_GLU;
constexpr int IT_TOTAL = DEPTH * IT_L;
__device__ __forceinline__ TDesc prep_desc(const Ctx& C, int it) {
    const int l = it / IT_L; int r = it % IT_L;
    unsigned char* ws = C.ws; TDesc d;
    if (r < IT_WIN) { const int kb = r / 36, nb = r % 36;
        d = TDesc{gptr(C.in[2]) + (size_t)l * D * NIN, gptr(C.in[1]) + l * D, (bf16_t*)(ws + WS_WIN) + (size_t)l * NIN * D, NIN, D, 0, kb * 64, nb * 64, 1}; return d; }
    r -= IT_WIN;
    if (r < IT_WOUT) { const int kb = r / 16, nb = r % 16;
        d = TDesc{gptr(C.in[20]) + (size_t)l * D * D, gptr(C.in[19]) + l * D, (bf16_t*)(ws + WS_WOUT) + (size_t)l * D * D, D, D, 0, kb * 64, nb * 64, 0}; return d; }
    r -= IT_WOUT;
    if (r < 16 * 2 * IT_WGU1) { const int e = r / (2 * IT_WGU1), q = r % (2 * IT_WGU1), isup = q / IT_WGU1, t = q % IT_WGU1, kb = t / 4, nb = t % 4;
        const float* W = (isup ? gptr(C.in[27]) : gptr(C.in[26])) + ((size_t)l * 16 + e) * D * 256;
        d = TDesc{W, gptr(C.in[21]) + l * D, (bf16_t*)(ws + WS_WGU) + ((size_t)l * 16 + e) * 512 * D, 256, D, 0, kb * 64, nb * 64, isup ? 3 : 2}; return d; }
    r -= 16 * 2 * IT_WGU1;
    if (r < NBUCKET * 2 * IT_WDN1) { const int bk = r / (2 * IT_WDN1), q = r % (2 * IT_WDN1), slot = q / IT_WDN1, t = q % IT_WDN1, kb = t / 16, nb = t % 16;
        const int g = bk / 6, pi = bk % 6, e = 4 * g + (slot ? pair_hi(pi) : pair_lo(pi));
        d = TDesc{gptr(C.in[28]) + ((size_t)l * 16 + e) * 256 * D, nullptr, (bf16_t*)(ws + WS_WDN) + ((size_t)l * NBUCKET + bk) * D * 512, D, 512, slot * 256, kb * 64, nb * 64, 0}; return d; }
    r -= NBUCKET * 2 * IT_WDN1;
    { const int kb = r / 4, nb = r % 4;
        d = TDesc{gptr(C.in[14]) + (size_t)l * 256 * 256, nullptr, (bf16_t*)(ws + WS_GLU) + (size_t)l * 256 * 256, 256, 256, 0, kb * 64, nb * 64, 4}; return d; }
}
__device__ __forceinline__ void phase_prep_weights(const Ctx& C, LAS float* scr) {
    TDesc d0, d1; TRegs r0, r1;
    int it = C.gw; bool h0 = it < IT_TOTAL;
    if (h0) { d0 = prep_desc(C, it); tr_load(d0, r0, C.lane); }
    while (h0) {
        const int it1 = it + C.ngw; const bool h1 = it1 < IT_TOTAL;
        if (h1) { d1 = prep_desc(C, it1); tr_load(d1, r1, C.lane); }
        tr_finish(d0, r0, scr, C.lane);
        if (!h1) break;
        const int it2 = it1 + C.ngw; h0 = it2 < IT_TOTAL;
        if (h0) { d0 = prep_desc(C, it2); tr_load(d0, r0, C.lane); }
        tr_finish(d1, r1, scr, C.lane);
        it = it2;
    }
}
__device__ __forceinline__ void conv_row(const float* xrow, bf16_t* orow, float* rstd_out, int lane) {
    const f32x4* xr = (const f32x4*)xrow + lane;
    f32x4 v[4]; float s = 0.f;
#pragma unroll
    for (int j = 0; j < 4; ++j) { v[j] = xr[64 * j]; s += (v[j].x * v[j].x + v[j].y * v[j].y) + (v[j].z * v[j].z + v[j].w * v[j].w); }
    s = wave_sum(s);
    if (lane == 0) *rstd_out = 1.0f / sqrtf(s * (1.f / D) + EPS);
    unsigned long long* o8 = (unsigned long long*)orow + lane;
#pragma unroll
    for (int j = 0; j < 4; ++j) o8[64 * j] = (unsigned long long)pk2(v[j].x, v[j].y) | ((unsigned long long)pk2(v[j].z, v[j].w) << 32);
}
__device__ __forceinline__ void phase_conv(const Ctx& C, const float* x) {
    bf16_t* XB = (bf16_t*)(C.ws + WS_XB); float* RSTD = (float*)(C.ws + WS_META + MT_RSTD);
    for (int m = C.gw * 4; m < T; m += C.ngw * 4) {
        f32x4 v[4][4]; float s[4];
#pragma unroll
        for (int r = 0; r < 4; ++r) { const f32x4* xr = (const f32x4*)(x + (size_t)(m + r) * D) + C.lane;
#pragma unroll
            for (int j = 0; j < 4; ++j) v[r][j] = xr[64 * j]; }
#pragma unroll
        for (int r = 0; r < 4; ++r) { float a = 0.f;
#pragma unroll
            for (int j = 0; j < 4; ++j) a += (v[r][j].x * v[r][j].x + v[r][j].y * v[r][j].y) + (v[r][j].z * v[r][j].z + v[r][j].w * v[r][j].w);
            s[r] = wave_sum(a);
            unsigned long long* o8 = (unsigned long long*)(XB + (size_t)(m + r) * D) + C.lane;
#pragma unroll
            for (int j = 0; j < 4; ++j) o8[64 * j] = (unsigned long long)pk2(v[r][j].x, v[r][j].y) | ((unsigned long long)pk2(v[r][j].z, v[r][j].w) << 32); }
        if (C.lane < 4) RSTD[m + C.lane] = 1.0f / sqrtf((C.lane == 0 ? s[0] : C.lane == 1 ? s[1] : C.lane == 2 ? s[2] : s[3]) * (1.f / D) + EPS);
    }
}
struct DenseSched {
    const char* A; const char* Bt; int nM, nN, nwg, G, c; size_t tstep;
    __device__ __forceinline__ void init(const void* A_, const void* Bt_, int M, int N, int K, int G_, int c_) { A = (const char*)A_; Bt = (const char*)Bt_; nM = M / 256; nN = N / 256; nwg = nM * nN; G = G_; c = c_; tstep = (size_t)256 * K * 2; }
    __device__ __forceinline__ bool next(int i, pg8::Unit& u) const {
        const int R = nwg / G, r = nwg - R * G; long L; u.hf = 0;
        if (i < R) L = (long)i * G + c;
        else if (i == R && r > 0) { if (2 * r <= G) { if (c >= 2 * r) return false; L = (long)R * G + (c % r); u.hf = 1 + c / r; } else { if (c >= r) return false; L = (long)R * G + c; } }
        else return false;
        int wgid = (int)L; { const int q = nwg / 8, rr = nwg % 8, xcd = wgid % 8, off = wgid / 8; wgid = (xcd < rr ? xcd * (q + 1) : rr * (q + 1) + (xcd - rr) * q) + off; }
        const int nig = 8 * nN, gid = wgid / nig, fm = gid * 8, gsz = (nM - fm) < 8 ? (nM - fm) : 8;
        u.pm = fm + ((wgid % nig) % gsz); u.pn = (wgid % nig) / gsz; return true;
    }
    __device__ __forceinline__ const char* a_base(const pg8::Unit& u) const { return A + (size_t)u.pm * tstep + (u.hf == 2 ? tstep / 2 : 0); }
    __device__ __forceinline__ const char* b_base(const pg8::Unit& u) const { return Bt + (size_t)u.pn * tstep; }
    __device__ __forceinline__ int a_row(const pg8::Unit&, int) const { return 0; }
    __device__ __forceinline__ void a_ready(const pg8::Unit&) const {}
    __device__ __forceinline__ void done(const pg8::Unit&) const {}
};
constexpr int TB_OFF = 131072;
struct TileTab { const LAS int* t;
    __device__ __forceinline__ int bucket(int pm) const { return t[pm]; }
    __device__ __forceinline__ int row0(int pm, int bk) const { return (pm - t[160 + bk]) * 256; }
    __device__ __forceinline__ int count(int bk) const { return t[192 + bk]; }
    __device__ __forceinline__ int ntiles() const { return t[224]; } };
__device__ __forceinline__ void build_tile_table(const Ctx& C, int l) {
    LAS int* t = (LAS int*)(C.lds + TB_OFF); const unsigned* cnt = (const unsigned*)(C.ws + WS_CTL) + CW_CNT + l * 32;
    if (C.tid < 64) { const int lane = C.tid; const int c = (lane < NBUCKET) ? (int)cnt[lane] : 0; const int nt = (c + 255) >> 8; int incl = nt;
#pragma unroll
        for (int o = 1; o < 32; o <<= 1) { const int v = __shfl_up(incl, o); if (lane >= o) incl += v; }
        const int excl = incl - nt;
        if (lane < 32) { t[160 + lane] = excl; t[192 + lane] = c; }
        if (lane < NBUCKET) for (int i = 0; i < nt; ++i) t[excl + i] = lane;
        if (lane == NBUCKET - 1) t[224] = incl; }
    __syncthreads();
}
struct GroupSched {
    const char* A; const char* B; TileTab tt; const int* blist; int ntiles, G, c, mode; size_t a_tile_bytes;
    __device__ __forceinline__ bool next(int i, pg8::Unit& u) const {
        const int NU = ntiles * 4, R = NU / G, r = NU - R * G; int L; u.hf = 0;
        const int cv = ((G & 7) == 0) ? (c & 7) * (G >> 3) + (c >> 3) : c;
        if (i < R) L = i * G + cv;
        else if (i == R && r > 0) { if (2 * r <= G) { if (cv >= 2 * r) return false; L = R * G + (cv % r); u.hf = 1 + cv / r; } else { if (cv >= r) return false; L = R * G + cv; } }
        else return false;
        u.pm = L >> 2; u.pn = L & 3; return true; }
    __device__ __forceinline__ const char* a_base(const pg8::Unit& u) const { return mode == 1 ? A : A + (size_t)u.pm * a_tile_bytes + (u.hf == 2 ? a_tile_bytes / 2 : 0); }
    __device__ __forceinline__ int a_row(const pg8::Unit& u, int row) const {
        const int bk = tt.bucket(u.pm), r = tt.row0(u.pm, bk) + row + (u.hf == 2 ? 128 : 0); return blist[bk * T + (r < tt.count(bk) ? r : 0)]; }
    __device__ __forceinline__ const char* b_base(const pg8::Unit& u) const {
        const int bk = tt.bucket(u.pm);
        if (mode == 1) { const int g = bk / 6, pi = bk % 6, e = 4 * g + ((u.pn >> 1) ? pair_hi(pi) : pair_lo(pi)); return B + ((size_t)e * 512 + (u.pn & 1) * 256) * (size_t)(D * 2); }
        return B + ((size_t)bk * D + u.pn * 256) * (size_t)(512 * 2);
    }
    __device__ __forceinline__ void a_ready(const pg8::Unit&) const {}
    __device__ __forceinline__ void done(const pg8::Unit&) const {}
};

__device__ __forceinline__ float row_rstd(const float* ssqp, int row) {
    const f32x4* q = (const f32x4*)(ssqp + (size_t)row * 16); const f32x4 a = q[0], b = q[1], c = q[2], d = q[3];
    const float s = (((a.x + a.y) + (a.z + a.w)) + ((b.x + b.y) + (b.z + b.w))) + (((c.x + c.y) + (c.z + c.w)) + ((d.x + d.y) + (d.z + d.w)));
    return 1.0f / sqrtf(s * (1.f / D) + EPS);
}
struct EpiIn {
    static constexpr bool PERM = true, AFTER_DRAIN = false;
    const float* rstd; bf16_t *U, *QH; const float *qg, *kg;
    __device__ __forceinline__ void operator()(const f32x4 (&acc)[2][2][4][2], const pg8::Unit& u, int wr, int wc, int fr, int fq) const {
        const int pn = u.pn; const int row0 = u.pm * 256 + (u.hf == 2 ? 128 : 0) + wr * 64 + fr; const bool halfu = u.hf != 0;
        if (pn < 3) {
            bf16_t* base = U + (size_t)pn * (8u << 20) + wc * 32 + 8 * fq;
#pragma unroll
            for (int ai = 0; ai < 2; ++ai)
#pragma unroll
                for (int m = 0; m < 4; ++m) { if (ai == 1 && halfu) continue; const int row = row0 + ai * 128 + m * 16; const float rs = rstd[row];
#pragma unroll
                    for (int bj = 0; bj < 2; ++bj) { f32x4 v0 = acc[ai][bj][m][0] * rs, v1 = acc[ai][bj][m][1] * rs;
                        if (pn < 2) { v0.x = gelu_tanh(v0.x); v0.y = gelu_tanh(v0.y); v0.z = gelu_tanh(v0.z); v0.w = gelu_tanh(v0.w); v1.x = gelu_tanh(v1.x); v1.y = gelu_tanh(v1.y); v1.z = gelu_tanh(v1.z); v1.w = gelu_tanh(v1.w); }
                        u32x4 w; w.x = pk2(v0.x, v0.y); w.y = pk2(v0.z, v0.w); w.z = pk2(v1.x, v1.y); w.w = pk2(v1.z, v1.w);
                        *(u32x4*)(base + (size_t)row * 256 + bj * 128) = w; } }
        } else {
            const int typ = (pn - 3) >> 1, head = 4 * ((pn - 3) & 1) + wc;
            bf16_t* dstb = QH + (size_t)typ * (16u << 20) + 8 * fq;
            f32x4 gv[2][2];
            const float* gsrc = qg + (kg - qg) * (typ == 1 ? 1 : 0) + 8 * fq; const float sc = (typ == 0) ? 0.125f * LOG2E : 1.f;
#pragma unroll
            for (int bj = 0; bj < 2; ++bj)
#pragma unroll
                for (int n = 0; n < 2; ++n) gv[bj][n] = (typ < 2) ? *(const f32x4*)(gsrc + 32 * bj + 4 * n) * sc : (f32x4){1.f, 1.f, 1.f, 1.f};
#pragma unroll
            for (int ai = 0; ai < 2; ++ai)
#pragma unroll
                for (int m = 0; m < 4; ++m) { if (ai == 1 && halfu) continue; const int row = row0 + ai * 128 + m * 16; const float rs = rstd[row];
                    f32x4 v[2][2]; float ss = 0.f;
#pragma unroll
                    for (int bj = 0; bj < 2; ++bj)
#pragma unroll
                        for (int n = 0; n < 2; ++n) { v[bj][n] = acc[ai][bj][m][n] * rs; ss += (v[bj][n].x * v[bj][n].x + v[bj][n].y * v[bj][n].y) + (v[bj][n].z * v[bj][n].z + v[bj][n].w * v[bj][n].w); }
                    ss += __shfl_xor(ss, 16); ss += __shfl_xor(ss, 32);
                    const float r = (typ < 2) ? 1.0f / sqrtf(ss * (1.f / 64.f) + EPS) : 1.f;
                    const int b = row >> 13, s = row & (SEQ - 1);
                    bf16_t* dst = dstb + ((size_t)(b * NH + head) * SEQ + s) * 64;
#pragma unroll
                    for (int bj = 0; bj < 2; ++bj) { const f32x4 v0 = v[bj][0] * r * gv[bj][0], v1 = v[bj][1] * r * gv[bj][1];
                        u32x4 w; w.x = pk2(v0.x, v0.y); w.y = pk2(v0.z, v0.w); w.z = pk2(v1.x, v1.y); w.w = pk2(v1.z, v1.w);
                        *(u32x4*)(dst + 32 * bj) = w; } }
        }
    }
};
__device__ __forceinline__ f32x4 bf_lo4(unsigned a, unsigned b) { return (f32x4){__uint_as_float(a << 16), __uint_as_float(a & 0xffff0000u), __uint_as_float(b << 16), __uint_as_float(b & 0xffff0000u)}; }
struct EpiOut {
    static constexpr bool PERM = true, AFTER_DRAIN = false;
    bf16_t* xb; float* ssq; size_t wofs;
    __device__ __forceinline__ void operator()(const f32x4 (&acc)[2][2][4][2], const pg8::Unit& u, int wr, int wc, int fr, int fq) const {
        const int row0 = u.pm * 256 + wr * 64 + fr, col0 = u.pn * 256 + wc * 32 + 8 * fq;
#pragma unroll
        for (int ai = 0; ai < 2; ++ai)
#pragma unroll
            for (int m = 0; m < 4; ++m) { const int row = row0 + ai * 128 + m * 16; bf16_t* xp = xb + (size_t)row * D + col0; float ss = 0.f;
#pragma unroll
                for (int bj = 0; bj < 2; ++bj) { const u32x4 w = *(const u32x4*)(xp + bj * 128);
                    const f32x4 v0 = bf_lo4(w.x, w.y) + acc[ai][bj][m][0], v1 = bf_lo4(w.z, w.w) + acc[ai][bj][m][1];
                    u32x4 o; o.x = pk2(v0.x, v0.y); o.y = pk2(v0.z, v0.w); o.z = pk2(v1.x, v1.y); o.w = pk2(v1.z, v1.w); *(u32x4*)(xp + wofs + bj * 128) = o;
                    const f32x4 r0 = bf_lo4(o.x, o.y), r1 = bf_lo4(o.z, o.w);
                    ss += (r0.x * r0.x + r0.y * r0.y) + (r0.z * r0.z + r0.w * r0.w) + (r1.x * r1.x + r1.y * r1.y) + (r1.z * r1.z + r1.w * r1.w); }
                ss += __shfl_xor(ss, 16); ss += __shfl_xor(ss, 32); if (fq == 0) ssq[(size_t)row * 16 + u.pn * 4 + wc] = ss; }
    }
};
struct EpiG1 {
    static constexpr bool PERM = true, AFTER_DRAIN = false;
    TileTab tt; const float *bgw0, *bgw1, *brs; bf16_t* H;
    __device__ __forceinline__ void operator()(const f32x4 (&acc)[2][2][4][2], const pg8::Unit& u, int wr, int wc, int fr, int fq) const {
        const int rl0 = (u.hf == 2 ? 128 : 0) + wr * 64 + fr; const int slot = u.pn >> 1, hh = u.pn & 1; const bool halfu = u.hf != 0;
        const int bk = tt.bucket(u.pm); const size_t lbase = (size_t)bk * T + tt.row0(u.pm, bk);
        const float* bgw = slot ? bgw1 : bgw0;
        bf16_t* hb = H + (size_t)u.pm * 256 * 512 + slot * 256 + hh * 128 + wc * 32 + 8 * fq;
#pragma unroll
        for (int ai = 0; ai < 2; ++ai)
#pragma unroll
            for (int m = 0; m < 4; ++m) { if (ai == 1 && halfu) continue; const int rl = rl0 + ai * 128 + m * 16; const float rs = brs[lbase + rl], gw = bgw[lbase + rl];
                float h[8];
#pragma unroll
                for (int n = 0; n < 2; ++n) { const f32x4 g = acc[ai][0][m][n] * rs, up = acc[ai][1][m][n] * (rs * gw);
                    h[4 * n] = fast_sigmoid_mul(g.x, g.x) * up.x; h[4 * n + 1] = fast_sigmoid_mul(g.y, g.y) * up.y; h[4 * n + 2] = fast_sigmoid_mul(g.z, g.z) * up.z; h[4 * n + 3] = fast_sigmoid_mul(g.w, g.w) * up.w; }
                u32x4 w; w.x = pk2(h[0], h[1]); w.y = pk2(h[2], h[3]); w.z = pk2(h[4], h[5]); w.w = pk2(h[6], h[7]);
                *(u32x4*)(hb + (size_t)rl * 512) = w; }
    }
};
template <bool NEXT> struct EpiG2 {
    static constexpr bool PERM = true, AFTER_DRAIN = false;
    TileTab tt; const int* blist; float* out; bf16_t* xb; float* ssq; size_t wofs;
    __device__ __forceinline__ void operator()(const f32x4 (&acc)[2][2][4][2], const pg8::Unit& u, int wr, int wc, int fr, int fq) const {
        const int rl0 = (u.hf == 2 ? 128 : 0) + wr * 64 + fr, col0 = u.pn * 256 + wc * 32 + 8 * fq; const bool halfu = u.hf != 0;
        const int bk = tt.bucket(u.pm), r0 = tt.row0(u.pm, bk), bc = tt.count(bk); const int* bl = blist + (size_t)bk * T;
#pragma unroll
        for (int ai = 0; ai < 2; ++ai)
#pragma unroll
            for (int m = 0; m < 4; ++m) { if (ai == 1 && halfu) continue; const int r = r0 + rl0 + ai * 128 + m * 16; const int tok = (r < bc) ? bl[r] : -1;
                float ss = 0.f;
                if (tok >= 0) { bf16_t* xp = xb + (size_t)tok * D + col0;
#pragma unroll
                    for (int bj = 0; bj < 2; ++bj) { const u32x4 w = *(const u32x4*)(xp + bj * 128);
                        const f32x4 v0 = bf_lo4(w.x, w.y) + acc[ai][bj][m][0], v1 = bf_lo4(w.z, w.w) + acc[ai][bj][m][1];
                        if (NEXT) { u32x4 o; o.x = pk2(v0.x, v0.y); o.y = pk2(v0.z, v0.w); o.z = pk2(v1.x, v1.y); o.w = pk2(v1.z, v1.w); *(u32x4*)(xp + wofs + bj * 128) = o;
                            const f32x4 r0 = bf_lo4(o.x, o.y), r1 = bf_lo4(o.z, o.w);
                            ss += (r0.x * r0.x + r0.y * r0.y) + (r0.z * r0.z + r0.w * r0.w) + (r1.x * r1.x + r1.y * r1.y) + (r1.z * r1.z + r1.w * r1.w); }
                        else { f32x4* op = (f32x4*)(out + (size_t)tok * D + col0 + bj * 128); __builtin_nontemporal_store(v0, op); __builtin_nontemporal_store(v1, op + 1); } } }
                if (NEXT) { ss += __shfl_xor(ss, 16); ss += __shfl_xor(ss, 32); if (fq == 0 && tok >= 0) ssq[(size_t)tok * 16 + u.pn * 4 + wc] = ss; } }
    }
};

__device__ __forceinline__ void phase_vrstd(const Ctx& C) {
    const bf16_t* V = (const bf16_t*)(C.ws + WS_V); float* vr = (float*)(C.ws + WS_META + MT_VR);
    for (int m = C.gw; m < T; m += C.ngw) {
        const unsigned long long w = ((const unsigned long long*)(V + (size_t)m * 256))[C.lane];
        const float a = __uint_as_float((unsigned)(w << 16)), b = __uint_as_float((unsigned)w & 0xffff0000u), c = __uint_as_float((unsigned)(w >> 32) << 16), d = __uint_as_float((unsigned)(w >> 32) & 0xffff0000u);
        const float s = wave_sum(a * a + b * b + c * c + d * d);
        if (C.lane == 0) vr[m] = 1.0f / sqrtf(s * (1.f / 256.f) + EPS);
    }
}
__device__ __forceinline__ void phase_sgu_naive(const Ctx& C, int l) {
    const bf16_t* U = (const bf16_t*)(C.ws + WS_U); const bf16_t* V = (const bf16_t*)(C.ws + WS_V); const float* vr = (const float*)(C.ws + WS_META + MT_VR);
    const float* sgu_norm = gptr(C.in[3]) + l * 256; const float* sgu_w = gptr(C.in[4]) + (size_t)l * 4 * 128 * 128; const float* sgu_b = gptr(C.in[5]) + l * 512;
    bf16_t* O = (bf16_t*)(C.ws + WS_O);
    const int half = C.tid >> 8, ch = C.tid & 255, h = ch >> 6;
    const float gn = sgu_norm[ch];
    for (int t = blockIdx.x * 2 + half; t < T; t += C.G * 2) {
        const int s = t & (SEQ - 1), i = s & 127, t0 = t - i;
        const int jmax = (i < 64) ? 64 : 128;
        const float* w = sgu_w + ((size_t)h * 128 + i) * 128;
        float acc = 0.f;
        for (int j = 0; j < jmax; ++j) acc += w[j] * (bf2f(V[(size_t)(t0 + j) * 256 + ch]) * vr[t0 + j] * gn);
        acc += sgu_b[h * 128 + i];
        const float oa = bf2f(U[(size_t)t * 256 + ch]) * acc;
        const float ss = wave_sum(oa * oa);
        O[(size_t)t * D + ch] = f2bf(oa * (1.0f / sqrtf(ss * (1.f / 64.f) + EPS)));
    }
}

typedef short bf16x8 __attribute__((ext_vector_type(8)));
typedef short s16x4 __attribute__((ext_vector_type(4)));
typedef float f32x16 __attribute__((ext_vector_type(16)));
constexpr int ATT_BX = 640;
constexpr int ATT_VBUF = 16384;
constexpr int ATT_BX_OFF = NWAVES * ATT_VBUF;
__device__ __forceinline__ void glds16(const void* gsrc, unsigned lds_dst) { unsigned keep;
    asm volatile("s_mov_b32 %0, m0\n\ts_mov_b32 m0, %2\n\ts_nop 0\n\tglobal_load_lds_dwordx4 %1, off\n\ts_mov_b32 m0, %0" : "=&s"(keep) : "v"(gsrc), "s"(lds_dst) : "memory"); }
__device__ __forceinline__ float max3f(float a, float b, float c) { float r; asm("v_max3_f32 %0, %1, %2, %3" : "=v"(r) : "v"(a), "v"(b), "v"(c)); return r; }
__device__ __forceinline__ s16x4 ds_tr(const LAS unsigned char* p) { return __builtin_bit_cast(s16x4, __builtin_amdgcn_ds_read_tr16_b64_v4i16((LAS s16x4*)p)); }
__device__ __forceinline__ void attn_load_bias(const Ctx& C, int l) {
    LAS float* Bx = (LAS float*)(C.lds + ATT_BX_OFF);
    const float* rb = gptr(C.in[18]) + (size_t)l * NH * 513;
    for (int i = C.tid; i < NH * ATT_BX; i += NTHREADS) { const int h = i / ATT_BX, j = i % ATT_BX; int rel = j - 64; rel = rel > 256 ? 256 : rel; Bx[i] = rb[h * 513 + rel + 256] * LOG2E; }
}
constexpr int ATT_KOFF = 0, ATT_VOFF = 16384;
struct AttnState { float m_run, l_run; f32x16 o0, o1; };
__device__ __forceinline__ void attn_step(const Ctx& C, AttnState& S, const bf16x8 (&qf)[4], const LAS unsigned char* kb, const LAS unsigned char* vbt, const LAS float* Bx, int jbase) {
    const int lane = C.lane, r32 = lane & 31, hi = lane >> 5;
    typedef float f32x2 __attribute__((ext_vector_type(2)));
    f32x16 p0, p1;
#pragma unroll
    for (int r = 0; r < 16; ++r) { const int kk = (r & 3) + 8 * (r >> 2); p0[r] = Bx[jbase - kk]; p1[r] = Bx[jbase - kk - 32]; }
    bf16x8 kf[8];
#pragma unroll
    for (int t = 0; t < 2; ++t)
#pragma unroll
        for (int ks = 0; ks < 4; ++ks) kf[t * 4 + ks] = *(const LAS bf16x8*)(kb + (32 * t + r32) * 128 + 16 * ((2 * ks + hi) ^ (r32 & 7)));
#pragma unroll
    for (int ks = 0; ks < 4; ++ks) { p0 = __builtin_amdgcn_mfma_f32_32x32x16_bf16(kf[ks], qf[ks], p0, 0, 0, 0); p1 = __builtin_amdgcn_mfma_f32_32x32x16_bf16(kf[4 + ks], qf[ks], p1, 0, 0, 0); }
    asm volatile("s_nop 15\n\ts_nop 7" : "+v"(p0), "+v"(p1));
    float mx = max3f(p0[0], p1[0], p0[1]), my = max3f(p1[1], p0[2], p1[2]);
#pragma unroll
    for (int r = 3; r < 15; r += 2) { mx = max3f(mx, p0[r], p1[r]); my = max3f(my, p0[r + 1], p1[r + 1]); }
    mx = max3f(mx, p0[15], p1[15]); mx = max3f(mx, my, __shfl_xor(max3f(mx, my, my), 32));
    const float m_new = max3f(S.m_run, mx, mx);
    const float alpha = __builtin_amdgcn_exp2f(S.m_run - m_new);
    S.m_run = m_new;
    const f32x2 m2 = {m_new, m_new}; f32x2 ps2 = {0.f, 0.f};
#pragma unroll
    for (int r = 0; r < 16; r += 2) {
        f32x2 x = (f32x2){p0[r], p0[r + 1]} - m2, y = (f32x2){p1[r], p1[r + 1]} - m2;
        x.x = __builtin_amdgcn_exp2f(x.x); x.y = __builtin_amdgcn_exp2f(x.y); y.x = __builtin_amdgcn_exp2f(y.x); y.y = __builtin_amdgcn_exp2f(y.y);
        p0[r] = x.x; p0[r + 1] = x.y; p1[r] = y.x; p1[r + 1] = y.y; ps2 += x + y; }
    S.l_run = S.l_run * alpha + (ps2.x + ps2.y);
#pragma unroll
    for (int r = 0; r < 16; ++r) { S.o0[r] *= alpha; S.o1[r] *= alpha; }
    bf16x8 pf[4];
#pragma unroll
    for (int s = 0; s < 2; ++s) { u32x4 w0, w1;
        w0.x = pk2(p0[8 * s], p0[8 * s + 1]); w0.y = pk2(p0[8 * s + 2], p0[8 * s + 3]); w0.z = pk2(p0[8 * s + 4], p0[8 * s + 5]); w0.w = pk2(p0[8 * s + 6], p0[8 * s + 7]);
        w1.x = pk2(p1[8 * s], p1[8 * s + 1]); w1.y = pk2(p1[8 * s + 2], p1[8 * s + 3]); w1.z = pk2(p1[8 * s + 4], p1[8 * s + 5]); w1.w = pk2(p1[8 * s + 6], p1[8 * s + 7]);
        pf[s] = __builtin_bit_cast(bf16x8, w0); pf[2 + s] = __builtin_bit_cast(bf16x8, w1); }
    bf16x8 vf[8];
#pragma unroll
    for (int ts = 0; ts < 4; ++ts)
#pragma unroll
        for (int dt = 0; dt < 2; ++dt) { const s16x4 lo = ds_tr(vbt + ((2 * ts) * 2 + dt) * 512), hi4 = ds_tr(vbt + ((2 * ts + 1) * 2 + dt) * 512);
            vf[2 * ts + dt] = (bf16x8){lo[0], lo[1], lo[2], lo[3], hi4[0], hi4[1], hi4[2], hi4[3]}; }
#pragma unroll
    for (int ts = 0; ts < 4; ++ts) { S.o0 = __builtin_amdgcn_mfma_f32_32x32x16_bf16(vf[2 * ts], pf[ts], S.o0, 0, 0, 0); S.o1 = __builtin_amdgcn_mfma_f32_32x32x16_bf16(vf[2 * ts + 1], pf[ts], S.o1, 0, 0, 0); }
}
__device__ __forceinline__ void attn_block_item(const Ctx& C, int b, int h, int c0) {
    const bf16_t* QH = (const bf16_t*)(C.ws + WS_QH); const bf16_t* KH = (const bf16_t*)(C.ws + WS_KH); const bf16_t* VH = (const bf16_t*)(C.ws + WS_VH);
    bf16_t* O = (bf16_t*)(C.ws + WS_O);
    const int lane = C.lane, r32 = lane & 31, hi = lane >> 5, tid = C.tid, j = C.wave >> 1, half = C.wave & 1, qc = c0 + j;
    const unsigned lds0 = (unsigned)(uintptr_t)C.lds;
    const LAS float* Bx = (const LAS float*)(C.lds + ATT_BX_OFF) + h * ATT_BX;
    const size_t bh = (size_t)(b * NH + h) * SEQ;
    bf16x8 qf[4];
    { const bf16_t* Qp = QH + (bh + qc * 64 + half * 32 + r32) * 64 + 8 * hi;
#pragma unroll
      for (int ks = 0; ks < 4; ++ks) qf[ks] = *(const bf16x8*)(Qp + 16 * ks); }
    const bf16_t* Ksrc = KH + (bh + (tid >> 3)) * 64 + 8 * ((tid & 7) ^ ((tid >> 3) & 7));
    const bf16_t* Vsrc = VH + (bh + 8 * C.wave + ((lane & 31) >> 2)) * 64 + (4 * (lane >> 5) + (lane & 3)) * 8;
    const unsigned kdst = lds0 + ATT_KOFF + C.wave * 1024, vdst = lds0 + ATT_VOFF + C.wave * 1024;
    const int i16 = lane & 15;
    const int trbase = (4 * hi + (i16 >> 2)) * 64 + (16 * ((lane >> 4) & 1) + 4 * (i16 & 3)) * 2;
    const int qi = 32 * half + r32;
    AttnState S; S.m_run = -INFINITY; S.l_run = 0.f;
#pragma unroll
    for (int r = 0; r < 16; ++r) { S.o0[r] = 0.f; S.o1[r] = 0.f; }
    const int s0 = c0 >= 8 ? 0 : 8 - c0;
    { const size_t ko = (size_t)(c0 - 8 + s0) * 64 * 64;
      glds16(Ksrc + ko, (unsigned)__builtin_amdgcn_readfirstlane((int)(kdst + (s0 & 1) * 8192))); glds16(Vsrc + ko, (unsigned)__builtin_amdgcn_readfirstlane((int)(vdst + (s0 & 1) * 8192))); }
    asm volatile("s_waitcnt vmcnt(0) lgkmcnt(0)\n\ts_barrier" ::: "memory");
    for (int s = s0; s < 12; ++s) {
        if (s + 1 < 12) { const size_t ko = (size_t)(c0 - 8 + s + 1) * 64 * 64; const int nb = (s + 1) & 1;
            glds16(Ksrc + ko, (unsigned)__builtin_amdgcn_readfirstlane((int)(kdst + nb * 8192))); glds16(Vsrc + ko, (unsigned)__builtin_amdgcn_readfirstlane((int)(vdst + nb * 8192))); }
        const int jb = s - j;
        if (jb >= 0 && jb < 9) attn_step(C, S, qf, C.lds + ATT_KOFF + (s & 1) * 8192, C.lds + ATT_VOFF + (s & 1) * 8192 + trbase, Bx, 512 - 64 * jb + qi + 64 - 4 * hi);
        asm volatile("s_waitcnt vmcnt(0) lgkmcnt(0)\n\ts_barrier" ::: "memory");
    }
    float lt = S.l_run + __shfl_xor(S.l_run, 32);
    const float inv = 1.0f / lt;
    float ss = 0.f;
#pragma unroll
    for (int r = 0; r < 16; ++r) { S.o0[r] *= inv; S.o1[r] *= inv; ss += S.o0[r] * S.o0[r] + S.o1[r] * S.o1[r]; }
    ss += __shfl_xor(ss, 32);
    const float rn = 1.0f / sqrtf(ss * (1.f / 64.f) + EPS);
    bf16_t* op = O + (size_t)(b * SEQ + qc * 64 + half * 32 + r32) * D + 512 + h * 64 + 4 * hi;
#pragma unroll
    for (int g = 0; g < 4; ++g) {
        *(unsigned long long*)(op + 8 * g) = (unsigned long long)pk2(S.o0[4 * g] * rn, S.o0[4 * g + 1] * rn) | ((unsigned long long)pk2(S.o0[4 * g + 2] * rn, S.o0[4 * g + 3] * rn) << 32);
        *(unsigned long long*)(op + 32 + 8 * g) = (unsigned long long)pk2(S.o1[4 * g] * rn, S.o1[4 * g + 1] * rn) | ((unsigned long long)pk2(S.o1[4 * g + 2] * rn, S.o1[4 * g + 3] * rn) << 32);
    }
}
__device__ __forceinline__ void phase_attn(const Ctx& C, int l, int first, int stride, int count) {
    attn_load_bias(C, l);
    __syncthreads();
    for (int j = 0; j < count; ++j) { const int it = first + j * stride;
        if (it < BATCH * NH * (SEQ / 256)) { const int qq = it % (SEQ / 256), bh = it / (SEQ / 256), b = bh / NH, h = bh % NH;
            attn_block_item(C, b, h, qq * 4); } }
    __syncthreads();
}

struct S5C { float x; double y; float fr, fi; };
__device__ __forceinline__ void s5_sincos_d(double ang, float& sn, float& cs) {
    ang -= 6.283185307179586476925 * rint(ang * 0.15915494309189533577);
    const float a = (float)ang; sn = __sinf(a); cs = __cosf(a);
}
__device__ __forceinline__ S5C s5_consts(const Ctx& C, int l, int g, int p) {
    const float lr = gptr(C.in[6])[l * 1024 + g * 64 + p], li = gptr(C.in[7])[l * 1024 + g * 64 + p], dt = __expf(gptr(C.in[8])[l * 16 + g]);
    S5C c; c.x = lr * dt; c.y = (double)li * (double)dt;
    float sn, cs, sh, ch; s5_sincos_d(c.y, sn, cs); s5_sincos_d(0.5 * c.y, sh, ch);
    const float x = c.x;
    const float ex1 = x * (1.f + x * (0.5f + x * (0.16666667f + x * (0.041666668f + x * (0.0083333338f + x * 0.0013888889f))))), er = ex1 + 1.f;
    const float nr = ex1 * cs - 2.f * sh * sh, ni = er * sn, den = lr * lr + li * li;
    c.fr = (nr * lr + ni * li) / den; c.fi = (ni * lr - nr * li) / den;
    return c;
}
__device__ __forceinline__ void s5_cpow(const S5C& c, int n, float& re, float& im) {
    const float e = __expf(c.x * (float)n);
    float sn, cs; s5_sincos_d(c.y * (double)n, sn, cs); re = e * cs; im = e * sn;
}
__device__ __forceinline__ int s5_m2col(int sg) { const int ks = sg >> 5, rem = sg & 31; return 32 * ks + 8 * ((rem >> 2) & 3) + 4 * (rem >> 4) + (rem & 3); }
constexpr int S5_ITEMS_LG = 19, S5_ITEMS = DEPTH * 16 * S5_ITEMS_LG;
constexpr int S5_APS = 19 * 128;
__device__ __forceinline__ void s5_prep_item(const Ctx& C, int it, LAS float* scr) {
    const int lg = it / S5_ITEMS_LG, r = it % S5_ITEMS_LG, l = lg >> 4, g = lg & 15, lane = C.lane;
    unsigned char* base = C.ws + WS_S5 + (size_t)l * S5_LAYER;
    const float* bre = gptr(C.in[9]) + l * 16384 + g * 1024; const float* bim = gptr(C.in[10]) + l * 16384 + g * 1024;
    const float* cre = gptr(C.in[11]) + l * 16384 + g * 1024; const float* cim = gptr(C.in[12]) + l * 16384 + g * 1024;
    if (r < 16) {
        const int delta = r;
        { const int p = lane; const S5C c = s5_consts(C, l, g, p);
#pragma unroll
          for (int ts = 0; ts < 2; ++ts) { float pr = 0.f, pi = 0.f; if (delta - ts >= 0) s5_cpow(c, delta - ts, pr, pi);
              scr[(ts * 64 + p) * 2] = (delta - ts >= 0) ? pr * c.fr - pi * c.fi : 0.f; scr[(ts * 64 + p) * 2 + 1] = (delta - ts >= 0) ? pr * c.fi + pi * c.fr : 0.f; } }
        { LAS f32x4* sb = (LAS f32x4*)(scr + 256);
#pragma unroll
          for (int q = 0; q < 4; ++q) { sb[lane + 64 * q] = ((const f32x4*)bre)[lane + 64 * q]; sb[256 + lane + 64 * q] = ((const f32x4*)bim)[lane + 64 * q]; } }
        asm volatile("s_waitcnt lgkmcnt(0)" ::: "memory");
        const int h = lane & 15, kq = lane >> 4, ts = kq >> 1, tau = delta - ts;
        float acc[8];
#pragma unroll
        for (int j = 0; j < 8; ++j) acc[j] = 0.f;
        const LAS f32x4* sbr = (const LAS f32x4*)(scr + 256) + 2 * (kq & 1); const LAS f32x4* sbi = sbr + 256;
        float cr[64 / 16], ci[64 / 16];
#pragma unroll 1
        for (int p0 = 0; p0 < 64; p0 += 4) {
#pragma unroll
            for (int q = 0; q < 4; ++q) { cr[q] = cre[h * 64 + p0 + q]; ci[q] = cim[h * 64 + p0 + q]; }
#pragma unroll
            for (int q = 0; q < 4; ++q) { const int p = p0 + q;
                const float pr = scr[(ts * 64 + p) * 2], pi = scr[(ts * 64 + p) * 2 + 1];
                const float wr = cr[q] * pr - ci[q] * pi, wi = cr[q] * pi + ci[q] * pr;
                const f32x4 b0 = sbr[4 * p], b1 = sbr[4 * p + 1], c0 = sbi[4 * p], c1 = sbi[4 * p + 1];
                acc[0] += wr * b0.x - wi * c0.x; acc[1] += wr * b0.y - wi * c0.y; acc[2] += wr * b0.z - wi * c0.z; acc[3] += wr * b0.w - wi * c0.w;
                acc[4] += wr * b1.x - wi * c1.x; acc[5] += wr * b1.y - wi * c1.y; acc[6] += wr * b1.z - wi * c1.z; acc[7] += wr * b1.w - wi * c1.w; }
        }
        if (tau == 0) {
#pragma unroll
            for (int j = 0; j < 8; ++j) if (8 * (kq & 1) + j == h) acc[j] += gptr(C.in[13])[l * 256 + g * 16 + h];
        }
        u32x4 o; o.x = pk2(acc[0], acc[1]); o.y = pk2(acc[2], acc[3]); o.z = pk2(acc[4], acc[5]); o.w = pk2(acc[6], acc[7]);
        *(u32x4*)((bf16_t*)(base + S5_TT) + ((size_t)(g * 16 + delta) * 64 + lane) * 8) = o;
        asm volatile("s_waitcnt lgkmcnt(0)" ::: "memory");
    } else if (r == 16) {
        const int p = lane; const S5C c = s5_consts(C, l, g, p);
        float ar, ai; s5_cpow(c, 1, ar, ai);
        const float w1r = ar * c.fr - ai * c.fi, w1i = ar * c.fi + ai * c.fr;
        bf16_t* BB = (bf16_t*)(base + S5_M1) + (size_t)g * 128 * 32;
        unsigned re[16], im[16];
#pragma unroll
        for (int h2 = 0; h2 < 8; ++h2) {
            const float x0 = bre[p * 16 + 2 * h2], y0 = bim[p * 16 + 2 * h2], x1 = bre[p * 16 + 2 * h2 + 1], y1 = bim[p * 16 + 2 * h2 + 1];
            re[h2] = pk2(w1r * x0 - w1i * y0, w1r * x1 - w1i * y1); im[h2] = pk2(w1r * y0 + w1i * x0, w1r * y1 + w1i * x1);
            re[8 + h2] = pk2(c.fr * x0 - c.fi * y0, c.fr * x1 - c.fi * y1); im[8 + h2] = pk2(c.fr * y0 + c.fi * x0, c.fr * y1 + c.fi * x1);
        }
        u32x4* d0 = (u32x4*)(BB + (size_t)p * 32); u32x4* d1 = (u32x4*)(BB + (size_t)(64 + p) * 32);
#pragma unroll
        for (int q = 0; q < 4; ++q) { d0[q] = (u32x4){re[4 * q], re[4 * q + 1], re[4 * q + 2], re[4 * q + 3]}; d1[q] = (u32x4){im[4 * q], im[4 * q + 1], im[4 * q + 2], im[4 * q + 3]}; }
    } else if (r == 17) {
        const int p = lane;
        bf16_t* CMp = (bf16_t*)(base + S5_M2P) + (size_t)g * 16 * 128;
        const int c0 = s5_m2col(p), c1 = s5_m2col(64 + p);
#pragma unroll
        for (int h = 0; h < 16; ++h) { CMp[h * 128 + c0] = f2bf(cre[h * 64 + p]); CMp[h * 128 + c1] = f2bf(-cim[h * 64 + p]); }
    } else {
        const int p = lane; const S5C c = s5_consts(C, l, g, p);
        float* A16 = (float*)(base + S5_AP16) + (size_t)g * S5_APS; float* A256 = (float*)(base + S5_AP256) + (size_t)g * 32 * 128;
        for (int cc = 0; cc <= 18; ++cc) { float pr, pi; s5_cpow(c, cc <= 16 ? 16 * cc : cc - 16, pr, pi); A16[cc * 128 + p] = pr; A16[cc * 128 + 64 + p] = pi; }
        for (int m = 0; m < 32; ++m) { float pr, pi; s5_cpow(c, 256 * m, pr, pi); A256[m * 128 + p] = pr; A256[m * 128 + 64 + p] = pi; }
    }
}

__device__ __forceinline__ float dpp_shr(float v, int d) {
    int r;
    if (d == 1) r = __builtin_amdgcn_update_dpp(0, __float_as_int(v), 0x111, 0xf, 0xf, true);
    else if (d == 2) r = __builtin_amdgcn_update_dpp(0, __float_as_int(v), 0x112, 0xf, 0xf, true);
    else if (d == 4) r = __builtin_amdgcn_update_dpp(0, __float_as_int(v), 0x114, 0xf, 0xf, true);
    else r = __builtin_amdgcn_update_dpp(0, __float_as_int(v), 0x118, 0xf, 0xf, true);
    return __int_as_float(r);
}
struct S5Wave { bf16x8 uf[8]; f32x4 X[8]; f32x4 ar[4], ai[4], wr[4], wi[4]; };
#define S5_CSQR(pr, pi) do { _Pragma("unroll") for (int mt_ = 0; mt_ < 4; ++mt_) { const f32x4 r_ = pr[mt_] * pr[mt_] - pi[mt_] * pi[mt_], i_ = 2.f * (pr[mt_] * pi[mt_]); pr[mt_] = r_; pi[mt_] = i_; } } while (0)
template <bool NEEDW> __device__ __forceinline__ void s5_E_scan(const Ctx& C, int l, int b, int k, int g, S5Wave& W) {
    const int lane = C.lane, cc = lane & 15, kq = lane >> 4;
    const unsigned char* base = C.ws + WS_S5 + (size_t)l * S5_LAYER;
    const bf16_t* ZS = (const bf16_t*)(C.ws + WS_ZS);
    const bf16_t* up = ZS + ((size_t)b * SEQ + 256 * k + 16 * cc + (kq >> 1)) * 256 + 16 * g + 8 * (kq & 1);
#pragma unroll
    for (int ks = 0; ks < 8; ++ks) W.uf[ks] = *(const bf16x8*)(up + (size_t)(2 * ks) * 256);
    const bf16_t* bbp = opaque((const bf16_t*)(base + S5_M1) + (size_t)g * 128 * 32 + (size_t)cc * 32 + 8 * kq);
    bf16x8 bb[8];
#pragma unroll
    for (int mt = 0; mt < 8; ++mt) bb[mt] = *(const bf16x8*)(bbp + (size_t)(16 * mt) * 32);
    const float* A1 = opaque((const float*)(base + S5_AP16) + (size_t)g * S5_APS + 17 * 128 + 4 * kq);
#pragma unroll
    for (int mt = 0; mt < 4; ++mt) { W.ar[mt] = *(const f32x4*)(A1 + 16 * mt); W.ai[mt] = *(const f32x4*)(A1 + 64 + 16 * mt); }
    f32x4 pr[4], pi[4];
#pragma unroll
    for (int mt = 0; mt < 4; ++mt) { pr[mt] = W.ar[mt]; pi[mt] = W.ai[mt]; }
    S5_CSQR(pr, pi);
#pragma unroll
    for (int mt = 0; mt < 8; ++mt) W.X[mt] = (f32x4){0.f, 0.f, 0.f, 0.f};
#pragma unroll
    for (int ks = 0; ks < 8; ++ks) {
        if (ks) {
#pragma unroll
            for (int mt = 0; mt < 4; ++mt) { const f32x4 re = W.X[mt], im = W.X[mt + 4]; W.X[mt] = pr[mt] * re - pi[mt] * im; W.X[mt + 4] = pr[mt] * im + pi[mt] * re; }
        }
#pragma unroll
        for (int mt = 0; mt < 8; ++mt) W.X[mt] = __builtin_amdgcn_mfma_f32_16x16x32_bf16(bb[mt], W.uf[ks], W.X[mt], 0, 0, 0);
    }
    S5_CSQR(pr, pi); S5_CSQR(pr, pi); S5_CSQR(pr, pi);
    if (NEEDW) {
#pragma unroll
        for (int mt = 0; mt < 4; ++mt) { W.wr[mt] = (f32x4){1.f, 1.f, 1.f, 1.f}; W.wi[mt] = (f32x4){0.f, 0.f, 0.f, 0.f}; } }
#pragma unroll
    for (int d = 1; d < 16; d <<= 1) {
#pragma unroll
        for (int mt = 0; mt < 4; ++mt) {
#pragma unroll
            for (int r = 0; r < 4; ++r) { const float sr = dpp_shr(W.X[mt][r], d), si = dpp_shr(W.X[mt + 4][r], d);
                W.X[mt][r] += pr[mt][r] * sr - pi[mt][r] * si; W.X[mt + 4][r] += pr[mt][r] * si + pi[mt][r] * sr; }
        }
        if (NEEDW) { const bool sel = (cc & d) != 0;
#pragma unroll
            for (int mt = 0; mt < 4; ++mt) { const f32x4 nr = W.wr[mt] * pr[mt] - W.wi[mt] * pi[mt], ni = W.wr[mt] * pi[mt] + W.wi[mt] * pr[mt];
#pragma unroll
                for (int r = 0; r < 4; ++r) { W.wr[mt][r] = sel ? nr[r] : W.wr[mt][r]; W.wi[mt][r] = sel ? ni[r] : W.wi[mt][r]; } } }
        if (d < 8) S5_CSQR(pr, pi);
    }
}
__device__ __forceinline__ void s5a_item(const Ctx& C, int l, int it) {
    const int g = it & 15, k = (it >> 4) & 31, b = it >> 9;
    S5Wave W; s5_E_scan<false>(C, l, b, k, g, W);
    if ((C.lane & 15) == 15) { float* F = (float*)(C.ws + WS_S5F) + ((size_t)((b * 32 + k) * 16 + g)) * 128 + 4 * (C.lane >> 4);
#pragma unroll
        for (int mt = 0; mt < 8; ++mt) *(f32x4*)(F + 16 * mt) = W.X[mt]; }
}
constexpr int S5_YSTRIDE = 528;
__device__ __forceinline__ void s5c_group(const Ctx& C0, int l, int b, int k, int g) {
    Ctx C = C0; asm volatile("; S5C_GROUP_BEGIN\n" : "+v"(C.lane));
    const int lane = C.lane, cc = lane & 15, kq = lane >> 4;
    const unsigned char* base = C.ws + WS_S5 + (size_t)l * S5_LAYER;
    f32x4 gr[4], gi[4];
#pragma unroll
    for (int mt = 0; mt < 4; ++mt) { gr[mt] = (f32x4){0.f, 0.f, 0.f, 0.f}; gi[mt] = (f32x4){0.f, 0.f, 0.f, 0.f}; }
    if (k > 0) {
        const float* F = opaque((const float*)(C.ws + WS_S5F) + ((size_t)(b * 32) * 16 + g) * 128 + 4 * kq);
        const float* A256 = opaque((const float*)(base + S5_AP256) + (size_t)g * 32 * 128 + 4 * kq);
#pragma unroll
        for (int rep = 0; rep < 2; ++rep) { const int kp = cc + 16 * rep;
            if (kp < k) { const float* f = opaque(F + (size_t)kp * 16 * 128); const float* w = opaque(A256 + (size_t)(k - 1 - kp) * 128);
#pragma unroll
                for (int mt = 0; mt < 4; ++mt) { const f32x4 fr = *(const f32x4*)(f + 16 * mt), fi = *(const f32x4*)(f + 64 + 16 * mt), wr = *(const f32x4*)(w + 16 * mt), wi = *(const f32x4*)(w + 64 + 16 * mt);
                    gr[mt] += wr * fr - wi * fi; gi[mt] += wr * fi + wi * fr; } } }
#pragma unroll
        for (int mt = 0; mt < 4; ++mt)
#pragma unroll
            for (int r = 0; r < 4; ++r) {
#pragma unroll
                for (int o = 1; o < 16; o <<= 1) { gr[mt][r] += __shfl_xor(gr[mt][r], o); gi[mt][r] += __shfl_xor(gi[mt][r], o); } }
    }
    S5Wave W; s5_E_scan<true>(C, l, b, k, g, W);
#pragma unroll
    for (int mt = 0; mt < 8; ++mt)
#pragma unroll
        for (int r = 0; r < 4; ++r) W.X[mt][r] = dpp_shr(W.X[mt][r], 1);
#pragma unroll
    for (int mt = 0; mt < 4; ++mt) { W.X[mt] += W.wr[mt] * gr[mt] - W.wi[mt] * gi[mt]; W.X[mt + 4] += W.wr[mt] * gi[mt] + W.wi[mt] * gr[mt]; }
    bf16x8 tt[16];
    const bf16_t* ttp = opaque((const bf16_t*)(base + S5_TT) + ((size_t)(g * 16) * 64 + lane) * 8);
#pragma unroll
    for (int d4 = 0; d4 < 4; ++d4) { if (d4) ttp = opaque(ttp + 4 * 64 * 8);
#pragma unroll
        for (int d = 0; d < 4; ++d) tt[4 * d4 + d] = *(const bf16x8*)(ttp + (size_t)d * 64 * 8); }
    bf16x8 cm[4];
    const bf16_t* cmp = opaque((const bf16_t*)(base + S5_M2P) + (size_t)g * 16 * 128 + (size_t)cc * 128 + 8 * kq);
#pragma unroll
    for (int ks = 0; ks < 4; ++ks) cm[ks] = *(const bf16x8*)(cmp + 32 * ks);
    f32x4 a1r[4], a1i[4];
    { const float* A1 = opaque((const float*)(base + S5_AP16) + (size_t)g * S5_APS + 17 * 128 + 4 * kq);
#pragma unroll
      for (int mt = 0; mt < 4; ++mt) { a1r[mt] = *(const f32x4*)(A1 + 16 * mt); a1i[mt] = *(const f32x4*)(A1 + 64 + 16 * mt); } }
    LAS unsigned char* yt = C.lds + (size_t)(16 * cc) * S5_YSTRIDE + (16 * g + 4 * kq) * 2;
#pragma unroll
    for (int jj = 0; jj < 16; jj += 2) {
        bf16x8 sf1[4], sf2[4];
#pragma unroll
        for (int mt = 0; mt < 4; ++mt) { const f32x4 re = W.X[mt], im = W.X[mt + 4]; W.X[mt] = a1r[mt] * re - a1i[mt] * im; W.X[mt + 4] = a1r[mt] * im + a1i[mt] * re; }
#pragma unroll
        for (int ks = 0; ks < 4; ++ks) { u32x4 w; w.x = pk2(W.X[2 * ks][0], W.X[2 * ks][1]); w.y = pk2(W.X[2 * ks][2], W.X[2 * ks][3]); w.z = pk2(W.X[2 * ks + 1][0], W.X[2 * ks + 1][1]); w.w = pk2(W.X[2 * ks + 1][2], W.X[2 * ks + 1][3]); sf1[ks] = __builtin_bit_cast(bf16x8, w); }
#pragma unroll
        for (int mt = 0; mt < 4; ++mt) { const f32x4 re = W.X[mt], im = W.X[mt + 4]; W.X[mt] = a1r[mt] * re - a1i[mt] * im; W.X[mt + 4] = a1r[mt] * im + a1i[mt] * re; }
#pragma unroll
        for (int ks = 0; ks < 4; ++ks) { u32x4 w; w.x = pk2(W.X[2 * ks][0], W.X[2 * ks][1]); w.y = pk2(W.X[2 * ks][2], W.X[2 * ks][3]); w.z = pk2(W.X[2 * ks + 1][0], W.X[2 * ks + 1][1]); w.w = pk2(W.X[2 * ks + 1][2], W.X[2 * ks + 1][3]); sf2[ks] = __builtin_bit_cast(bf16x8, w); }
        f32x4 acc1 = {0.f, 0.f, 0.f, 0.f}, acc2 = {0.f, 0.f, 0.f, 0.f};
#pragma unroll
        for (int ks = 0; ks < 4; ++ks) { acc1 = __builtin_amdgcn_mfma_f32_16x16x32_bf16(cm[ks], sf1[ks], acc1, 0, 0, 0); acc2 = __builtin_amdgcn_mfma_f32_16x16x32_bf16(cm[ks], sf2[ks], acc2, 0, 0, 0); }
#pragma unroll
        for (int ks = 0; ks <= jj / 2; ++ks) { acc1 = __builtin_amdgcn_mfma_f32_16x16x32_bf16(tt[jj - 2 * ks], W.uf[ks], acc1, 0, 0, 0); acc2 = __builtin_amdgcn_mfma_f32_16x16x32_bf16(tt[jj + 1 - 2 * ks], W.uf[ks], acc2, 0, 0, 0); }
        const unsigned long long w1 = (unsigned long long)pk2(gelu_tanh(acc1[0]), gelu_tanh(acc1[1])) | ((unsigned long long)pk2(gelu_tanh(acc1[2]), gelu_tanh(acc1[3])) << 32);
        const unsigned long long w2 = (unsigned long long)pk2(gelu_tanh(acc2[0]), gelu_tanh(acc2[1])) | ((unsigned long long)pk2(gelu_tanh(acc2[2]), gelu_tanh(acc2[3])) << 32);
        *(LAS unsigned long long*)(yt + jj * S5_YSTRIDE) = w1; *(LAS unsigned long long*)(yt + (jj + 1) * S5_YSTRIDE) = w2;
    }
}
__device__ __forceinline__ void s5c_glu(const Ctx& C0, int l, int b, int k) {
    Ctx C = C0; asm volatile("; S5C_GLU_BEGIN\n" : "+v"(C.lane));
    const int lane = C.lane, r32 = lane & 31, hi = lane >> 5, tok = 32 * C.wave + r32;
    const bf16_t* gtp = opaque((const bf16_t*)(C.ws + WS_GLU) + (size_t)l * 65536 + (size_t)lane * 8);
    const float* gb = gptr(C.in[15]) + l * 256;
    const LAS unsigned char* yrow = C.lds + (size_t)tok * S5_YSTRIDE;
    bf16x8 yf[16];
#pragma unroll
    for (int ks = 0; ks < 16; ++ks) yf[ks] = *(const LAS bf16x8*)(yrow + (16 * ks + 8 * hi) * 2);
    bf16_t* op = (bf16_t*)(C.ws + WS_O) + ((size_t)b * SEQ + 256 * k + tok) * D + 256 + 4 * hi;
    bf16x8 wa[16], wb[16];
#pragma unroll
    for (int ks = 0; ks < 16; ++ks) wa[ks] = *(const bf16x8*)(gtp + 512 * ks);
#pragma unroll
    for (int ng = 0; ng < 4; ++ng) {
        f32x16 z[2];
#pragma unroll
        for (int r = 0; r < 16; ++r) { z[0][r] = 0.f; z[1][r] = 0.f; }
        gtp = opaque(gtp + 16 * 512);
#pragma unroll
        for (int ks = 0; ks < 16; ++ks) wb[ks] = *(const bf16x8*)(gtp + 512 * ks);
#pragma unroll
        for (int ks = 0; ks < 16; ++ks) z[0] = __builtin_amdgcn_mfma_f32_32x32x16_bf16(wa[ks], yf[ks], z[0], 0, 0, 0);
        if (ng < 3) { gtp = opaque(gtp + 16 * 512);
#pragma unroll
            for (int ks = 0; ks < 16; ++ks) wa[ks] = *(const bf16x8*)(gtp + 512 * ks); }
#pragma unroll
        for (int ks = 0; ks < 16; ++ks) z[1] = __builtin_amdgcn_mfma_f32_32x32x16_bf16(wb[ks], yf[ks], z[1], 0, 0, 0);
        float ob[2][16]; float ss = 0.f;
#pragma unroll
        for (int m2 = 0; m2 < 2; ++m2)
#pragma unroll
            for (int q4 = 0; q4 < 4; ++q4) { const int ch = 32 * (2 * ng + m2) + 8 * q4 + 4 * hi;
                const unsigned long long yw = *(const LAS unsigned long long*)(yrow + ch * 2); const f32x4 bb = *(const f32x4*)(gb + ch);
                const float y0 = __uint_as_float((unsigned)yw << 16), y1 = __uint_as_float((unsigned)yw & 0xffff0000u), y2 = __uint_as_float((unsigned)(yw >> 32) << 16), y3 = __uint_as_float((unsigned)(yw >> 32) & 0xffff0000u);
                const float o0 = fast_sigmoid_mul(y0, z[m2][4 * q4] + bb[0]), o1 = fast_sigmoid_mul(y1, z[m2][4 * q4 + 1] + bb[1]), o2 = fast_sigmoid_mul(y2, z[m2][4 * q4 + 2] + bb[2]), o3 = fast_sigmoid_mul(y3, z[m2][4 * q4 + 3] + bb[3]);
                ob[m2][4 * q4] = o0; ob[m2][4 * q4 + 1] = o1; ob[m2][4 * q4 + 2] = o2; ob[m2][4 * q4 + 3] = o3; ss += (o0 * o0 + o1 * o1) + (o2 * o2 + o3 * o3); }
        ss += __shfl_xor(ss, 32);
        const float rn = 1.0f / sqrtf(ss * (1.f / 64.f) + EPS);
#pragma unroll
        for (int m2 = 0; m2 < 2; ++m2)
#pragma unroll
            for (int q4 = 0; q4 < 4; ++q4)
                *(unsigned long long*)(op + 64 * ng + 32 * m2 + 8 * q4) = (unsigned long long)pk2(ob[m2][4 * q4] * rn, ob[m2][4 * q4 + 1] * rn) | ((unsigned long long)pk2(ob[m2][4 * q4 + 2] * rn, ob[m2][4 * q4 + 3] * rn) << 32);
    }
}
__device__ __forceinline__ void s5c_item(const Ctx& C, int l, int it) {
    const int b = it >> 5, k = it & 31;
    REPEAT(22, s5c_group(C, l, b, k, 2 * C.wave); s5c_group(C, l, b, k, 2 * C.wave + 1));
    __syncthreads();
    REPEAT(23, s5c_glu(C, l, b, k));
    __syncthreads();
}

constexpr int SGU_VS = 576;
__device__ __forceinline__ void sgu_item(const Ctx& C, int l, int it) {
    const bf16_t* U = (const bf16_t*)(C.ws + WS_U); const bf16_t* V = (const bf16_t*)(C.ws + WS_V); bf16_t* O = (bf16_t*)(C.ws + WS_O);
    const float* gain = gptr(C.in[3]) + l * 256; const float* sgu_b = gptr(C.in[5]) + l * 512;
    const bf16_t* Wb = (const bf16_t*)(C.ws + WS_SGUW) + (size_t)l * 65536;
    const int tid = C.tid, lane = C.lane, r32 = lane & 31, hi = lane >> 5;
    const size_t t0 = (size_t)it * 128;
    {
        const int row = tid >> 2, qt = tid & 3;
        const u32x4* src = (const u32x4*)(V + (t0 + row) * 256 + qt * 64);
        u32x4 w[8]; float ss = 0.f;
#pragma unroll
        for (int i = 0; i < 8; ++i) { w[i] = src[i];
#pragma unroll
            for (int e = 0; e < 4; ++e) { const float a = __uint_as_float(w[i][e] << 16), b = __uint_as_float(w[i][e] & 0xffff0000u); ss += a * a + b * b; } }
        ss += __shfl_xor(ss, 1); ss += __shfl_xor(ss, 2);
        const float rs = 1.0f / sqrtf(ss * (1.f / 256.f) + EPS);
        LAS unsigned char* dst = C.lds + row * SGU_VS + qt * 128;
#pragma unroll
        for (int i = 0; i < 8; ++i) { const f32x4 g0 = *(const f32x4*)(gain + qt * 64 + 8 * i), g1 = *(const f32x4*)(gain + qt * 64 + 8 * i + 4);
            u32x4 o;
            o.x = pk2(__uint_as_float(w[i].x << 16) * rs * g0.x, __uint_as_float(w[i].x & 0xffff0000u) * rs * g0.y); o.y = pk2(__uint_as_float(w[i].y << 16) * rs * g0.z, __uint_as_float(w[i].y & 0xffff0000u) * rs * g0.w);
            o.z = pk2(__uint_as_float(w[i].z << 16) * rs * g1.x, __uint_as_float(w[i].z & 0xffff0000u) * rs * g1.y); o.w = pk2(__uint_as_float(w[i].w << 16) * rs * g1.z, __uint_as_float(w[i].w & 0xffff0000u) * rs * g1.w);
            *(LAS u32x4*)(dst + 16 * i) = o; }
    }
    __syncthreads();
    const int h = C.wave >> 1, ih = C.wave & 1;
    const int nks = ih ? 8 : 4;
    f32x16 acc[2][2];
#pragma unroll
    for (int mt = 0; mt < 2; ++mt)
#pragma unroll
        for (int nt = 0; nt < 2; ++nt)
#pragma unroll
            for (int r = 0; r < 16; ++r) acc[mt][nt][r] = 0.f;
    const int i16 = lane & 15;
    const LAS unsigned char* vb = C.lds + (8 * hi + (i16 >> 2)) * SGU_VS + (64 * h + 16 * ((lane >> 4) & 1) + 4 * (i16 & 3)) * 2;
    const bf16_t* wp = Wb + ((size_t)h * 128 + 64 * ih + r32) * 128 + 8 * hi;
    for (int ks = 0; ks < nks; ++ks) {
        bf16x8 af[2], bfr[2];
#pragma unroll
        for (int mt = 0; mt < 2; ++mt) { const s16x4 lo = ds_tr(vb + (16 * ks) * SGU_VS + 64 * mt), hi4 = ds_tr(vb + (16 * ks + 4) * SGU_VS + 64 * mt);
            af[mt] = (bf16x8){lo[0], lo[1], lo[2], lo[3], hi4[0], hi4[1], hi4[2], hi4[3]}; }
#pragma unroll
        for (int nt = 0; nt < 2; ++nt) bfr[nt] = *(const bf16x8*)(wp + (size_t)(32 * nt) * 128 + 16 * ks);
#pragma unroll
        for (int mt = 0; mt < 2; ++mt)
#pragma unroll
            for (int nt = 0; nt < 2; ++nt) acc[mt][nt] = __builtin_amdgcn_mfma_f32_32x32x16_bf16(af[mt], bfr[nt], acc[mt][nt], 0, 0, 0);
    }
#pragma unroll
    for (int nt = 0; nt < 2; ++nt) {
        const int i = 64 * ih + 32 * nt + r32; const float bias = sgu_b[h * 128 + i];
        const bf16_t* up = U + (t0 + i) * 256 + 64 * h + 4 * hi; bf16_t* op = O + (t0 + i) * D + 64 * h + 4 * hi;
        float ov[2][16]; float ss = 0.f;
#pragma unroll
        for (int mt = 0; mt < 2; ++mt)
#pragma unroll
            for (int q4 = 0; q4 < 4; ++q4) { const unsigned long long uw = *(const unsigned long long*)(up + 32 * mt + 8 * q4);
                const float u0 = __uint_as_float((unsigned)uw << 16), u1 = __uint_as_float((unsigned)uw & 0xffff0000u), u2 = __uint_as_float((unsigned)(uw >> 32) << 16), u3 = __uint_as_float((unsigned)(uw >> 32) & 0xffff0000u);
                const float o0 = u0 * (acc[mt][nt][4 * q4] + bias), o1 = u1 * (acc[mt][nt][4 * q4 + 1] + bias), o2 = u2 * (acc[mt][nt][4 * q4 + 2] + bias), o3 = u3 * (acc[mt][nt][4 * q4 + 3] + bias);
                ov[mt][4 * q4] = o0; ov[mt][4 * q4 + 1] = o1; ov[mt][4 * q4 + 2] = o2; ov[mt][4 * q4 + 3] = o3; ss += (o0 * o0 + o1 * o1) + (o2 * o2 + o3 * o3); }
        ss += __shfl_xor(ss, 32);
        const float rn = 1.0f / sqrtf(ss * (1.f / 64.f) + EPS);
#pragma unroll
        for (int mt = 0; mt < 2; ++mt)
#pragma unroll
            for (int q4 = 0; q4 < 4; ++q4)
                *(unsigned long long*)(op + 32 * mt + 8 * q4) = (unsigned long long)pk2(ov[mt][4 * q4] * rn, ov[mt][4 * q4 + 1] * rn) | ((unsigned long long)pk2(ov[mt][4 * q4 + 2] * rn, ov[mt][4 * q4 + 3] * rn) << 32);
    }
    __syncthreads();
}

__device__ __forceinline__ void route_block(const Ctx& C, int l, int it) {
    const float* bg = gptr(C.in[23]) + l * 4; const float* be = gptr(C.in[25]) + l * 16;
    unsigned* cnt = (unsigned*)(C.ws + WS_CTL) + (C.dry ? 2048 : CW_CNT + l * 32);
    int* m_bucket = (int*)(C.ws + WS_META + MT_BUCKET); int* m_pos = (int*)(C.ws + WS_META + MT_POS);
    float* m_gw0 = (float*)(C.ws + WS_META + MT_GW0); float* m_gw1 = (float*)(C.ws + WS_META + MT_GW1); float* m_rs = (float*)(C.ws + WS_META + MT_RS2);
    bf16_t* XB = (bf16_t*)(C.ws + WS_XB);
    LAS unsigned* hist = (LAS unsigned*)C.lds; LAS unsigned* hbase = hist + 32;
    const int lane = C.lane, r32 = lane & 31, hi = lane >> 5;
    if (C.tid < 32) hist[C.tid] = 0u;
    __syncthreads();
    int bk = 0, rank = 0; float glo = 0.f, ghi = 0.f, rs = 0.f; const int t = it * 128 + C.wave * 32 + r32;
    if (C.wave < 4) {
        const bf16_t* xbr = XB + (size_t)t * D + 8 * hi;
        const bf16_t* whp = opaque((const bf16_t*)(C.ws + WS_ROUTEW) + (size_t)l * 65536 + (size_t)lane * 8);
        f32x16 acc;
#pragma unroll
        for (int r = 0; r < 16; ++r) acc[r] = 0.f;
        for (int kb = 0; kb < 8; ++kb) {
            bf16x8 xh[8], wh[8], wl[8];
#pragma unroll
            for (int i = 0; i < 8; ++i) { const int ks = 8 * kb + i; xh[i] = *(const bf16x8*)(xbr + 16 * ks); wh[i] = *(const bf16x8*)(whp + 512 * ks); wl[i] = *(const bf16x8*)(whp + 32768 + 512 * ks); }
#pragma unroll
            for (int i = 0; i < 8; ++i) { acc = __builtin_amdgcn_mfma_f32_32x32x16_bf16(wh[i], xh[i], acc, 0, 0, 0); acc = __builtin_amdgcn_mfma_f32_32x32x16_bf16(wl[i], xh[i], acc, 0, 0, 0); }
        }
        rs = row_rstd((const float*)(C.ws + WS_SSQB), t);
        float mine[12], oth[12];
#pragma unroll
        for (int r = 0; r < 12; ++r) { mine[r] = acc[r]; oth[r] = __shfl_xor(acc[r], 32); }
        float lg[20];
#pragma unroll
        for (int q = 0; q < 5; ++q)
#pragma unroll
            for (int e = 0; e < 4; ++e) { const int n = 4 * q + e;
                const float v0 = ((q & 1) == 0) ? mine[4 * (q >> 1) + e] : oth[4 * (q >> 1) + e], v1 = ((q & 1) == 0) ? oth[4 * (q >> 1) + e] : mine[4 * (q >> 1) + e];
                lg[n] = (hi == 0 ? v0 : v1) * rs; }
        float gl[4]; int gt = 0;
#pragma unroll
        for (int i = 0; i < 4; ++i) gl[i] = lg[i] + bg[i];
        float gm = gl[0];
#pragma unroll
        for (int i = 1; i < 4; ++i) if (gl[i] > gm) { gm = gl[i]; gt = i; }
        float gs = 0.f;
#pragma unroll
        for (int i = 0; i < 4; ++i) gs += __expf(gl[i] - gm);
        const float pg = 1.f / gs;
        float el[4];
#pragma unroll
        for (int i = 0; i < 4; ++i) { float v = 0.f;
#pragma unroll
            for (int gi = 0; gi < 4; ++gi) v = (gi == gt) ? lg[4 + 4 * gi + i] + be[gi * 4 + i] : v;
            el[i] = v; }
        int i1 = 0; float m1 = el[0];
#pragma unroll
        for (int i = 1; i < 4; ++i) if (el[i] > m1) { m1 = el[i]; i1 = i; }
        int i2 = -1; float m2 = -3.0e38f;
#pragma unroll
        for (int i = 0; i < 4; ++i) if (i != i1 && el[i] > m2) { m2 = el[i]; i2 = i; }
        const float e2 = __expf(m2 - m1); const float w1 = 1.f / (1.f + e2), w2 = e2 / (1.f + e2);
        const int lo = i1 < i2 ? i1 : i2, hi2 = i1 < i2 ? i2 : i1;
        const int pi = (lo == 0) ? (hi2 - 1) : (lo == 1 ? hi2 + 1 : 5);
        bk = gt * 6 + pi;
        glo = pg * (i1 < i2 ? w1 : w2); ghi = pg * (i1 < i2 ? w2 : w1);
        if (hi == 0) rank = (int)atomicAdd((unsigned*)(hist + bk), 1u);
    }
    __syncthreads();
    if (C.tid < NBUCKET) { const unsigned n = hist[C.tid]; hbase[C.tid] = n ? atomicAdd(cnt + C.tid, n) : 0u; }
    __syncthreads();
    if (C.wave < 4 && hi == 0) { const size_t li = C.dry ? (size_t)(T * 24) + (size_t)(t & 1023) : (size_t)bk * T + hbase[bk] + rank;
        ((int*)(C.ws + WS_BLIST))[li] = t; ((float*)(C.ws + WS_BGW0))[li] = glo; ((float*)(C.ws + WS_BGW1))[li] = ghi; ((float*)(C.ws + WS_BRS))[li] = rs; }
    __syncthreads();
}
__device__ __forceinline__ void phase_perm(const Ctx& C, int l) {
    const unsigned* cnt = (const unsigned*)(C.ws + WS_CTL) + CW_CNT + l * 32; unsigned* tileb = (unsigned*)(C.ws + WS_CTL) + CW_TILEB + l * 160;
    const int* m_bucket = (const int*)(C.ws + WS_META + MT_BUCKET); const int* m_pos = (const int*)(C.ws + WS_META + MT_POS);
    const float* m_gw0 = (const float*)(C.ws + WS_META + MT_GW0); const float* m_gw1 = (const float*)(C.ws + WS_META + MT_GW1); const float* m_rs = (const float*)(C.ws + WS_META + MT_RS2);
    const bf16_t* XB = (const bf16_t*)(C.ws + WS_XB); bf16_t* XS = (bf16_t*)(C.ws + WS_XS); int* stok = (int*)(C.ws + WS_META + MT_STOK) + l * MAXROWS;
    float* sgw0 = (float*)(C.ws + WS_META + MT_SGW0); float* sgw1 = (float*)(C.ws + WS_META + MT_SGW1); float* srs = (float*)(C.ws + WS_META + MT_SRS);
    const int lane = C.lane;
    int nt = (lane < NBUCKET) ? (((int)cnt[lane] + 255) >> 8) : 0, incl = nt;
#pragma unroll
    for (int o = 1; o < 32; o <<= 1) { const int v = __shfl_up(incl, o); if (lane >= o) incl += v; }
    const int excl = incl - nt;
    if (C.gw == 0) { if (lane < NBUCKET) for (int i = 0; i < nt; ++i) tileb[excl + i] = (unsigned)lane; if (lane == NBUCKET - 1) tileb[159] = (unsigned)incl; }
    for (int t = C.gw * 4; t < T; t += C.ngw * 4) {
        int dst[4]; u32x4 v[4][2];
#pragma unroll
        for (int j = 0; j < 4; ++j) { const int bk = m_bucket[t + j]; dst[j] = __shfl(excl, bk) * 256 + m_pos[t + j];
            const u32x4* src = (const u32x4*)(XB + (size_t)(t + j) * D) + lane; v[j][0] = src[0]; v[j][1] = src[64]; }
#pragma unroll
        for (int j = 0; j < 4; ++j) { u32x4* d = (u32x4*)(XS + (size_t)dst[j] * D) + lane; d[0] = v[j][0]; d[64] = v[j][1];
            if (lane == 0) { stok[dst[j]] = t + j; sgw0[dst[j]] = m_gw0[t + j]; sgw1[dst[j]] = m_gw1[t + j]; srs[dst[j]] = m_rs[t + j]; } }
    }
}

__device__ __forceinline__ void phase_prologue(const Ctx& C) {
    LAS float* scr = (LAS float*)(C.lds + C.wave * 16896);
    { const int l = 0; REPEAT(101, phase_prep_weights(C, scr)); }
    { const int l = 0; REPEAT(102, for (int it = C.gw; it < S5_ITEMS; it += C.ngw) s5_prep_item(C, it, scr)); }
    { bf16_t* rw = (bf16_t*)(C.ws + WS_ROUTEW);
      for (int i = C.gw * 64 + C.lane; i < DEPTH * 32 * D; i += C.ngw * 64) { const int l = i / (32 * D), n = (i / D) & 31, k = i & (D - 1);
          float v = 0.f;
          if (n < 4) v = gptr(C.in[22])[((size_t)l * D + k) * 4 + n]; else if (n < 20) v = gptr(C.in[24])[(((size_t)l * 4 + ((n - 4) >> 2)) * D + k) * 4 + ((n - 4) & 3)];
          v *= gptr(C.in[21])[l * D + k];
          const bf16_t h = f2bf(v); const size_t fo = (size_t)l * 65536 + (size_t)(((k >> 4) * 64 + ((k >> 3) & 1) * 32 + n) * 8 + (k & 7));
          rw[fo] = h; rw[fo + 32768] = f2bf(v - bf2f(h)); } }
    { const float* sw = gptr(C.in[4]); bf16_t* dw = (bf16_t*)(C.ws + WS_SGUW);
      for (int i = C.gw * 64 + C.lane; i < DEPTH * 65536 / 2; i += C.ngw * 64) ((unsigned*)dw)[i] = pk2(sw[2 * i], sw[2 * i + 1]); }
    { const int l = 0; REPEAT(103, phase_conv(C, gptr(C.in[0]))); }
}


#define XB_TMO      128
#define XB_XCNT(j)  (256  + 64 * (j))
#define XB_XSUB(j)  (1280 + 64 * (j))
#define XB_XGEN(j)  (2304 + 64 * (j))
#define XB_TOP      3328
#define XB_TOPGEN   3392
#define XCD_BAR_WORDS 3456
#define XB_SPIN_CAP (1u << 18)

__device__ __forceinline__ unsigned xb_ld(unsigned* p)              { return __hip_atomic_load(p, __ATOMIC_RELAXED, __HIP_MEMORY_SCOPE_AGENT); }
__device__ __forceinline__ unsigned xb_add(unsigned* p, unsigned v) { return __hip_atomic_fetch_add(p, v, __ATOMIC_RELAXED, __HIP_MEMORY_SCOPE_AGENT); }
__device__ __forceinline__ unsigned xb_xcc_id() { return (unsigned)__builtin_amdgcn_s_getreg((3 << 11) | 20) & 0xFu; }
#define XB_SPIN(cond, bar) do { unsigned _sp = 0; while (cond) { __builtin_amdgcn_s_sleep(1); \
    if ((++_sp & 255u) == 0u) { if (xb_ld(&(bar)[XB_TMO])) break; if (_sp > XB_SPIN_CAP) { atomicAdd(&(bar)[XB_TMO], 1u); break; } } } } while (0)

struct XcdBarrier {
    unsigned* bar; unsigned x;
    volatile LAS unsigned* st;
};

__device__ __forceinline__ XcdBarrier xcd_barrier_post(unsigned* bar, volatile LAS unsigned* st) {
    XcdBarrier b; b.bar = bar; b.x = xb_xcc_id(); b.st = st;
    if (threadIdx.x == 0) (void)xb_add(&bar[XB_XCNT(b.x)], 1u);
    return b;
}
__device__ __forceinline__ void xcd_barrier_complete(unsigned* bar, unsigned x, unsigned& nloc, unsigned& nx) {
    const unsigned G = gridDim.x * gridDim.y * gridDim.z;
    unsigned sum, cnt, mine, sp = 0u;
    for (;;) {
        sum = 0u; cnt = 0u; mine = 0u;
#pragma unroll
        for (unsigned j = 0; j < 16; ++j) { const unsigned c = xb_ld(&bar[XB_XCNT(j)]); sum += c; cnt += (c > 0u) ? 1u : 0u; mine = (j == x) ? c : mine; }
        if (sum == G) break;
        __builtin_amdgcn_s_sleep(1);
        if ((++sp & 255u) == 0u) { if (xb_ld(&bar[XB_TMO])) break; if (sp > XB_SPIN_CAP) { atomicAdd(&bar[XB_TMO], 1u); break; } }
    }
    nloc = mine > 0u ? mine : 1u; nx = cnt > 0u ? cnt : 1u;
}

__device__ __forceinline__ void xcd_barrier(const XcdBarrier& b) {
    asm volatile("s_waitcnt vmcnt(0)" ::: "memory");
    __syncthreads();
    if (threadIdx.x == 0) {
        unsigned* bar = b.bar;
        __builtin_amdgcn_s_waitcnt(0);
        unsigned nloc = b.st[0], nx = b.st[1];
        if (nloc == 0u) { xcd_barrier_complete(bar, b.x, nloc, nx); b.st[0] = nloc; b.st[1] = nx; }
        const unsigned old = xb_add(&bar[XB_XSUB(b.x)], 1u);
        const unsigned gen = old / nloc;
        if (old + 1u == (gen + 1u) * nloc) {
            __builtin_amdgcn_fence(__ATOMIC_RELEASE, "agent");
            asm volatile("s_waitcnt vmcnt(0)" ::: "memory");
            const unsigned og = xb_add(&bar[XB_TOP], 1u);
            const unsigned tg = og / nx;
            if (og + 1u == (tg + 1u) * nx) xb_add(&bar[XB_TOPGEN], 1u);
            else XB_SPIN(xb_ld(&bar[XB_TOPGEN]) == tg, bar);
            __builtin_amdgcn_fence(__ATOMIC_ACQUIRE, "agent");
            xb_add(&bar[XB_XGEN(b.x)], 1u);
            asm volatile("s_waitcnt vmcnt(0)" ::: "memory");
        } else {
            XB_SPIN(xb_ld(&bar[XB_XGEN(b.x)]) == gen, bar);
            __builtin_amdgcn_fence(__ATOMIC_ACQUIRE, "agent");
            asm volatile("s_waitcnt vmcnt(0)" ::: "memory");
        }
    }
    __syncthreads();
}

constexpr int PH_PER_LAYER = 7, N_PHASES = 1 + DEPTH * PH_PER_LAYER;
__global__ void __launch_bounds__(NTHREADS, 2) mk_fwd(KArgs args) {
    extern __shared__ __attribute__((aligned(16))) unsigned char lds_raw[];
    const int lo = args.ph_lo, hi = args.ph_hi;
    const int wave_s = __builtin_amdgcn_readfirstlane(threadIdx.x >> 6);
    if (threadIdx.x < 16) ((LAS unsigned*)(lds_raw + LDS_BARW))[threadIdx.x] = 0u;
    __syncthreads();
    cg::this_grid().sync();
    XcdBarrier bar = xcd_barrier_post((unsigned*)(args.ws + WS_CTL) + CW_BAR, (volatile LAS unsigned*)((LAS unsigned char*)lds_raw + LDS_BARW));
    int reps_left = REP_N - 1;
    for (int ph = lo; ph < hi; ++ph) {
        unsigned ones = ~0u; asm volatile("" : "+s"(ones));
        int tid = wave_s * 64 + (int)__builtin_amdgcn_mbcnt_hi(ones, __builtin_amdgcn_mbcnt_lo(ones, 0u)); asm volatile("" : "+v"(tid));
        GAS unsigned char* wsg = (GAS unsigned char*)args.ws; asm volatile("" : "+s"(wsg)); unsigned char* ws = (unsigned char*)wsg;
        Ctx C;
        C.lds = (LAS unsigned char*)lds_raw;
        C.in = args.in; { GAS float* og = (GAS float*)args.out; asm volatile("" : "+s"(og)); C.out = (float*)og; } C.ws = ws;
        C.tid = tid; C.lane = tid & 63; C.wave = __builtin_amdgcn_readfirstlane(tid >> 6);
        C.G = gridDim.x; C.gw = blockIdx.x * NWAVES + C.wave; C.ngw = C.G * NWAVES; C.dry = (ph == REP_PH && reps_left > 0);
        if (ph == 0) { const int l = 0; REPEAT(100, phase_prologue(C)); }
        else {
            const int l = (ph - 1) / PH_PER_LAYER, k = (ph - 1) % PH_PER_LAYER;
            const float* xres = (l == 0) ? gptr(args.in[0]) : (const float*)C.out;
            const unsigned* tileb = (const unsigned*)(ws + WS_CTL) + CW_TILEB + l * 160;
            if (k == 0) {
                if (l > 0) {
                    const float* ssqp = (const float*)(ws + WS_SSQP); float* rstd = (float*)(ws + WS_META + MT_RSTD);
                    for (int r0 = C.gw * 4; r0 < T; r0 += C.ngw * 4) { const int row = r0 + (C.lane >> 4); float v = ssqp[(size_t)row * 16 + (C.lane & 15)];
#pragma unroll
                        for (int o = 1; o < 16; o <<= 1) v += __shfl_xor(v, o);
                        if ((C.lane & 15) == 0) rstd[row] = 1.0f / sqrtf(v * (1.f / D) + EPS); }
                    xcd_barrier(bar);
                }
                DenseSched S; S.init(ws + WS_XB, (const bf16_t*)(ws + WS_WIN) + (size_t)l * NIN * D, T, NIN, D, C.G, (int)blockIdx.x);
                EpiIn E{(const float*)(ws + WS_META + MT_RSTD), (bf16_t*)(ws + WS_U), (bf16_t*)(ws + WS_QH), gptr(args.in[16]) + l * 64, gptr(args.in[17]) + l * 64};
                REPEAT(0, (pg8::gemm_phase<EpiIn, DenseSched, true, true>(C.lds, D, S, E, C.tid)));
            } else if (k == 1) {
                REPEAT(10, for (int it = C.gw; it < BATCH * 32 * 16; it += C.ngw) s5a_item(C, l, it));
                REPEAT(11, phase_attn(C, l, ((int)blockIdx.x & 7) * (C.G >> 3) + ((int)blockIdx.x >> 3), C.G, 3));
            } else if (k == 2) {
                const int half = C.G >> 1;
                if ((int)blockIdx.x < half) { REPEAT(21, for (int it = blockIdx.x; it < BATCH * 32; it += half) s5c_item(C, l, it)); }
                else { const int bx = (int)blockIdx.x - half;
                    REPEAT(20, for (int it = bx; it < T / 128; it += half) sgu_item(C, l, it));
                    phase_attn(C, l, 3 * C.G + (bx & 7) * (half >> 3) + (bx >> 3), half, 2); }
            } else if (k == 3) {
                DenseSched S; S.init(ws + WS_O, (const bf16_t*)(ws + WS_WOUT) + (size_t)l * D * D, T, D, D, C.G, (int)blockIdx.x);
                EpiOut E{(bf16_t*)(ws + WS_XB), (float*)(ws + WS_SSQB), C.dry ? (size_t)((WS_XS - WS_XB) / 2) : (size_t)0};
                REPEAT(3, (pg8::gemm_phase<EpiOut, DenseSched, true, true>(C.lds, D, S, E, C.tid)));
            } else if (k == 4) {
                for (int it = blockIdx.x; it < T / 128; it += C.G) route_block(C, l, it);
            } else if (k == 5) {
                build_tile_table(C, l);
                TileTab tt{(const LAS int*)(C.lds + TB_OFF)};
                GroupSched S{(const char*)(ws + WS_XB), (const char*)((const bf16_t*)(ws + WS_WGU) + (size_t)l * 16 * 512 * D), tt, (const int*)(ws + WS_BLIST), tt.ntiles(), C.G, (int)blockIdx.x, 1, (size_t)0};
                EpiG1 E{tt, (const float*)(ws + WS_BGW0), (const float*)(ws + WS_BGW1), (const float*)(ws + WS_BRS), (bf16_t*)(ws + WS_H)};
                REPEAT(6, (pg8::gemm_phase<EpiG1, GroupSched, true, true, true>(C.lds, D, S, E, C.tid)));
            } else {
                build_tile_table(C, l);
                TileTab tt{(const LAS int*)(C.lds + TB_OFF)};
                GroupSched S{(const char*)(ws + WS_H), (const char*)((const bf16_t*)(ws + WS_WDN) + (size_t)l * NBUCKET * D * 512), tt, (const int*)(ws + WS_BLIST), tt.ntiles(), C.G, (int)blockIdx.x, 2, (size_t)256 * 512 * 2};
                if (l + 1 < DEPTH) { EpiG2<true> E{tt, (const int*)(ws + WS_BLIST), C.out, (bf16_t*)(ws + WS_XB), (float*)(ws + WS_SSQP), C.dry ? (size_t)((WS_XS - WS_XB) / 2) : (size_t)0};
                    pg8::gemm_phase<EpiG2<true>, GroupSched, true, true>(C.lds, 512, S, E, C.tid); }
                else { EpiG2<false> E{tt, (const int*)(ws + WS_BLIST), C.out, (bf16_t*)(ws + WS_XB), nullptr, (size_t)0};
                    pg8::gemm_phase<EpiG2<false>, GroupSched, true, true>(C.lds, 512, S, E, C.tid); }
            }
        }
        if (ph == REP_PH && reps_left > 0) { --reps_left; --ph; }
        if (ph + 1 < hi) xcd_barrier(bar);
    }
}

extern "C" void kernel_launch(void* const* d_in, const int* in_sizes, int n_in, void* d_out, int out_size, void* d_ws, size_t ws_size, hipStream_t stream) {
    static int grid = 0;
    if (grid == 0) {
        if (n_in != 29 || ws_size < WS_END) { fprintf(stderr, "kernel_launch: unexpected inputs (n_in %d, ws %zu)\n", n_in, ws_size); grid = -1; return; }
        int dev = 0, cus = 0, per_cu = 0;
        (void)hipGetDevice(&dev); (void)hipDeviceGetAttribute(&cus, hipDeviceAttributeMultiprocessorCount, dev);
        if (hipFuncSetAttribute((const void*)mk_fwd, hipFuncAttributeMaxDynamicSharedMemorySize, LDS_BYTES) != hipSuccess) { fprintf(stderr, "kernel_launch: hipFuncSetAttribute failed\n"); grid = -1; return; }
        if (hipOccupancyMaxActiveBlocksPerMultiprocessor(&per_cu, (const void*)mk_fwd, NTHREADS, LDS_BYTES) != hipSuccess || per_cu < 1) { fprintf(stderr, "kernel_launch: occupancy query says %d blocks/CU\n", per_cu); per_cu = 1; }
        (void)hipGetLastError();
        grid = cus * (per_cu > 1 ? 1 : per_cu);
        fprintf(stderr, "kernel_launch: grid %d (cus %d, per_cu %d)\n", grid, cus, per_cu);
    }
    if (grid < 0) return;
    (void)hipMemsetAsync((char*)d_ws + WS_CTL, 0, 1 * MiB, stream);
    KArgs a{};
    for (int i = 0; i < 29; ++i) a.in[i] = (const float*)d_in[i];
    a.out = (float*)d_out; a.ws = (unsigned char*)d_ws;
#if MK_ONE_LAUNCH
    a.ph_lo = 0; a.ph_hi = N_PHASES;
    void* kargs[] = {&a};
    hipError_t e = hipLaunchCooperativeKernel((const void*)mk_fwd, dim3(grid), dim3(NTHREADS), kargs, LDS_BYTES, stream);
    if (e != hipSuccess) fprintf(stderr, "cooperative launch failed: %s (grid %d)\n", hipGetErrorString(e), grid);
#else
    for (int p = 0; p < N_PHASES - 1; ++p) { a.ph_lo = p; a.ph_hi = p + 1; hipLaunchKernelGGL(mk_fwd, dim3(grid), dim3(NTHREADS), LDS_BYTES, stream, a); }
#endif
}
```

```cpp
#include <hip/hip_runtime.h>
#include <hip/hip_cooperative_groups.h>
#include <cstdint>
#include <cstdio>
namespace cg = cooperative_groups;

#ifndef MK_ONE_LAUNCH
#define MK_ONE_LAUNCH 1
#endif

namespace pg8 {
#define PG8_LAS __attribute__((address_space(3)))
typedef unsigned short bf16_t;
typedef short bf16x8 __attribute__((ext_vector_type(8)));
typedef float f32x4 __attribute__((ext_vector_type(4)));
typedef unsigned u32x4 __attribute__((ext_vector_type(4)));
constexpr int BM = 256, BK = 64, HALF = 128, HTB = HALF * BK * 2  , STAGE_BYTES = 8 * HTB, NXCD = 8, WGM = 8;
__host__ __device__ __forceinline__ int lds_byte(int r, int c) { const int st = (r >> 4) * 2 + (c >> 5), rr = r & 15, cc = c & 31, ob = rr * 64 + cc * 2; return st * 1024 + (ob ^ (((ob >> 9) & 1) << 5)); }
__host__ __device__ __forceinline__ void stage_rc(int b, int& R, int& C) { const int st = b / 1024, sb = b % 1024, swz = sb ^ (((sb >> 9) & 1) << 5); R = (st >> 1) * 16 + swz / 64; C = (st & 1) * 32 + (swz % 64) / 2; }
__host__ __device__ __forceinline__ int perm32(int rho) { const int n = rho >> 4, i = rho & 15; return 8 * (i >> 2) + 4 * n + (i & 3); }
struct Unit { int pm, pn, hf; };
__device__ __forceinline__ unsigned cvt_pk_bf16(float lo, float hi) { unsigned r; asm volatile("v_cvt_pk_bf16_f32 %0, %1, %2" : "=v"(r) : "v"(lo), "v"(hi)); return r; }
template <class Epi, class Sched, bool ALIGN_EPI = false, bool SP2 = false, bool GATHER = false>
__device__ __forceinline__ void gemm_phase(PG8_LAS unsigned char* lds, const int gK, const Sched& S, const Epi& E, const int tid) {
    const int wid = __builtin_amdgcn_readfirstlane(tid >> 6), lane = tid & 63, wr = wid >> 2, wc = wid & 3, fr = lane & 15, fq = lane >> 4;
    const int K = gK, nt = K / BK;
    unsigned voffA[2], voffB[2];
#pragma unroll
    for (int i = 0; i < 2; ++i) { int R, C; stage_rc(tid * 16 + i * 8192, R, C); const int Rb = Epi::PERM ? ((R & ~31) + perm32(R & 31)) : R;
        voffA[i] = (unsigned)(R * K + C) * 2u; voffB[i] = (unsigned)(Rb * K + C) * 2u; }
    unsigned gA[2], gN[2], gcol[2];
    if constexpr (GATHER) { _Pragma("unroll") for (int i = 0; i < 2; ++i) { int R_, C_; stage_rc(tid * 16 + i * 8192, R_, C_); gcol[i] = (unsigned)C_ * 2u; } }
#define PG8_GLOAD(dst, unit) do { _Pragma("unroll") for (int _h = 0; _h < 2; ++_h) { int R0_, R1_, C_; stage_rc(tid * 16, R0_, C_); stage_rc(tid * 16 + 8192, R1_, C_); \
        dst[_h] = (unsigned)S.a_row(unit, R0_ + 128 * _h) | ((unsigned)S.a_row(unit, R1_ + 128 * _h) << 16); } } while (0)
#define PG8_STAGE_A(bufoff, gbase, half, isnext) do { if constexpr (GATHER) { const unsigned g_ = (isnext) ? gN[half] : gA[half]; \
            unsigned vv_[2] = {(g_ & 0xffffu) * (unsigned)(K * 2) + gcol[0], (g_ >> 16) * (unsigned)(K * 2) + gcol[1]}; PG8_STAGE(bufoff, gbase, vv_); } \
        else { PG8_STAGE(bufoff, (gbase) + (half) * hstep, voffA); } } while (0)
    const size_t kstep = (size_t)(BK * 2);
    const size_t hstep = (size_t)HALF * K * 2;
    const unsigned ldsw = (unsigned)wid * 1024u;
    const int aoff = lds_byte(wr * 64 + fr, fq * 8), boff = lds_byte(wc * 32 + fr, fq * 8);
#define PG8_SA(b, h) (((b) * 2 + (h)) * HTB)
#define PG8_SB(b, h) ((4 + (b) * 2 + (h)) * HTB)
#define PG8_STAGE(bufoff, gbase, voff) do { _Pragma("unroll") for (int _i = 0; _i < 2; ++_i) \
        __builtin_amdgcn_global_load_lds((const unsigned*)((const char*)(gbase) + (voff)[_i]), (PG8_LAS unsigned*)(lds + (bufoff) + ldsw + _i * 8192), 16, 0, 0); } while (0)
#define PG8_LDA(dst, b, h) do { _Pragma("unroll") for (int m = 0; m < 4; ++m) _Pragma("unroll") for (int k = 0; k < 2; ++k) dst[m][k] = *(const PG8_LAS bf16x8*)(lds + PG8_SA(b, h) + aoff + m * 2048 + k * 1024); } while (0)
#define PG8_LDB(dst, b, h) do { _Pragma("unroll") for (int n = 0; n < 2; ++n) _Pragma("unroll") for (int k = 0; k < 2; ++k) dst[n][k] = *(const PG8_LAS bf16x8*)(lds + PG8_SB(b, h) + boff + n * 2048 + k * 1024); } while (0)
#define PG8_MMA(ai, bj, At, Bt) do { __builtin_amdgcn_s_setprio(1); _Pragma("unroll") for (int m = 0; m < 4; ++m) _Pragma("unroll") for (int n = 0; n < 2; ++n) _Pragma("unroll") for (int k = 0; k < 2; ++k) \
        acc[ai][bj][m][n] = __builtin_amdgcn_mfma_f32_16x16x32_bf16(Bt[n][k], At[m][k], acc[ai][bj][m][n], 0, 0, 0); __builtin_amdgcn_s_setprio(0); } while (0)
#define PG8_WAIT_V(n) asm volatile("s_waitcnt vmcnt(" #n ")" ::: "memory")
#define PG8_WAIT_L(n) asm volatile("s_waitcnt lgkmcnt(" #n ")" ::: "memory")
#define PG8_BAR __builtin_amdgcn_s_barrier()
#define PG8_SCHED __builtin_amdgcn_sched_barrier(0)
    Unit cur, nxt; int ui = 0;
    if (!S.next(0, cur)) return;
    f32x4 acc[2][2][4][2];
#pragma unroll
    for (int a = 0; a < 2; ++a)
#pragma unroll
        for (int b = 0; b < 2; ++b)
#pragma unroll
            for (int m = 0; m < 4; ++m)
#pragma unroll
                for (int n = 0; n < 2; ++n) acc[a][b][m][n] = (f32x4){0.f, 0.f, 0.f, 0.f};
    bf16x8 At[4][2], B0[2][2], B1[2][2];
    const char* cA = S.a_base(cur); const char* cB = S.b_base(cur);
    S.a_ready(cur);
    if constexpr (GATHER) PG8_GLOAD(gA, cur);
    if constexpr (SP2) {
        PG8_STAGE(PG8_SB(0, 0), cB, voffB); PG8_STAGE(PG8_SB(0, 1), cB + hstep, voffB); PG8_STAGE_A(PG8_SA(0, 0), cA, 0, false); PG8_STAGE_A(PG8_SA(0, 1), cA, 1, false);
        if (wr == 1) PG8_BAR;
        PG8_WAIT_V(2); PG8_BAR;
        PG8_STAGE(PG8_SB(1, 0), cB + kstep, voffB); PG8_STAGE_A(PG8_SA(1, 0), cA + kstep, 0, false); PG8_STAGE(PG8_SB(1, 1), cB + hstep + kstep, voffB);
        PG8_WAIT_V(6); PG8_BAR;
    } else {
        PG8_STAGE(PG8_SB(0, 0), cB, voffB); PG8_STAGE(PG8_SA(0, 0), cA, voffA); PG8_STAGE(PG8_SB(0, 1), cB + hstep, voffB); PG8_STAGE(PG8_SA(0, 1), cA + hstep, voffA);
        if (wr == 1) PG8_BAR;
        PG8_WAIT_V(4); PG8_BAR;
        PG8_STAGE(PG8_SB(1, 0), cB + kstep, voffB); PG8_STAGE(PG8_SA(1, 0), cA + kstep, voffA); PG8_STAGE(PG8_SB(1, 1), cB + hstep + kstep, voffB);
        PG8_WAIT_V(6); PG8_BAR;
    }
    for (;;) {
        const bool has_next = S.next(ui + 1, nxt);
        if constexpr (GATHER) { if (has_next) { PG8_GLOAD(gN, nxt); asm volatile("s_waitcnt vmcnt(0)" ::: "memory");
            asm volatile("" : "+v"(gN[0]), "+v"(gN[1])); } }
        const char* nA = has_next ? S.a_base(nxt) : cA; const char* nB = has_next ? S.b_base(nxt) : cB;
        for (int t = 0; t < nt; t += 2) {
            const bool last = (t == nt - 2); const bool lastnext = last && has_next; (void)lastnext; const bool fullu = (cur.hf == 0);
            const char* a1 = cA + (size_t)(t + 1) * kstep;
            const char* a2 = last ? nA : cA + (size_t)(t + 2) * kstep; const char* b2 = last ? nB : cB + (size_t)(t + 2) * kstep;
            const char* a3 = a2 + kstep; const char* b3 = b2 + kstep;
            if (last && has_next) S.a_ready(nxt);
            if constexpr (SP2) {
            PG8_LDB(B0, 0, 0); PG8_LDB(B1, 0, 1); PG8_SCHED; PG8_LDA(At, 0, 0); PG8_STAGE_A(PG8_SA(1, 1), a1, 1, false);
            PG8_WAIT_V(8); PG8_WAIT_L(0); PG8_BAR; PG8_MMA(0, 0, At, B0); PG8_MMA(0, 1, At, B1); PG8_BAR; PG8_SCHED;
            PG8_LDA(At, 0, 1); PG8_STAGE(PG8_SB(0, 0), b2, voffB); PG8_STAGE(PG8_SB(0, 1), b2 + hstep, voffB); PG8_STAGE_A(PG8_SA(0, 0), a2, 0, lastnext);
            PG8_WAIT_V(8); PG8_WAIT_L(0); PG8_BAR; if (fullu) { PG8_MMA(1, 0, At, B0); PG8_MMA(1, 1, At, B1); } PG8_BAR; PG8_SCHED;
            PG8_LDB(B0, 1, 0); PG8_LDB(B1, 1, 1); PG8_SCHED; PG8_LDA(At, 1, 0); PG8_STAGE_A(PG8_SA(0, 1), a2, 1, lastnext);
            PG8_WAIT_V(8); PG8_WAIT_L(0); PG8_BAR; PG8_MMA(0, 0, At, B0); PG8_MMA(0, 1, At, B1); PG8_BAR; PG8_SCHED;
            PG8_LDA(At, 1, 1); PG8_STAGE(PG8_SB(1, 0), b3, voffB); PG8_STAGE(PG8_SB(1, 1), b3 + hstep, voffB); PG8_STAGE_A(PG8_SA(1, 0), a3, 0, lastnext);
            PG8_WAIT_V(8); PG8_WAIT_L(0); PG8_BAR; if (fullu) { PG8_MMA(1, 0, At, B0); PG8_MMA(1, 1, At, B1); } PG8_BAR; PG8_SCHED;
            } else {
            PG8_LDB(B0, 0, 0); PG8_SCHED; PG8_LDA(At, 0, 0); PG8_STAGE(PG8_SA(1, 1), a1 + hstep, voffA);
            PG8_WAIT_L(8); PG8_BAR; PG8_WAIT_L(0); PG8_MMA(0, 0, At, B0); PG8_BAR; PG8_SCHED;
            PG8_LDB(B1, 0, 1); PG8_STAGE(PG8_SB(0, 0), b2, voffB);
            PG8_BAR; PG8_WAIT_L(0); PG8_MMA(0, 1, At, B1); PG8_BAR;
            PG8_LDA(At, 0, 1); PG8_STAGE(PG8_SA(0, 0), a2, voffA);
            PG8_BAR; PG8_WAIT_L(0); PG8_MMA(1, 0, At, B0); PG8_BAR; PG8_SCHED;
            PG8_STAGE(PG8_SB(0, 1), b2 + hstep, voffB);
            PG8_WAIT_V(6); PG8_BAR; PG8_MMA(1, 1, At, B1); PG8_BAR;
            PG8_LDB(B0, 1, 0); PG8_SCHED; PG8_LDA(At, 1, 0); PG8_STAGE(PG8_SA(0, 1), a2 + hstep, voffA);
            PG8_WAIT_L(8); PG8_BAR; PG8_WAIT_L(0); PG8_MMA(0, 0, At, B0); PG8_BAR; PG8_SCHED;
            PG8_LDB(B1, 1, 1); PG8_STAGE(PG8_SB(1, 0), b3, voffB);
            PG8_BAR; PG8_WAIT_L(0); PG8_MMA(0, 1, At, B1); PG8_BAR;
            PG8_LDA(At, 1, 1); PG8_STAGE(PG8_SA(1, 0), a3, voffA);
            PG8_BAR; PG8_WAIT_L(0); PG8_MMA(1, 0, At, B0); PG8_BAR; PG8_SCHED;
            PG8_STAGE(PG8_SB(1, 1), b3 + hstep, voffB);
            PG8_WAIT_V(6); PG8_BAR; PG8_MMA(1, 1, At, B1); PG8_BAR;
            }
        }
        if constexpr (ALIGN_EPI) { if (wr == 0) PG8_BAR; }
        if constexpr (!Epi::AFTER_DRAIN) { E(acc, cur, wr, wc, fr, fq); S.done(cur); }
        if (!has_next) break;
#pragma unroll
        for (int a = 0; a < 2; ++a)
#pragma unroll
            for (int b = 0; b < 2; ++b)
#pragma unroll
                for (int m = 0; m < 4; ++m)
#pragma unroll
                    for (int n = 0; n < 2; ++n) acc[a][b][m][n] = (f32x4){0.f, 0.f, 0.f, 0.f};
        cur = nxt; cA = nA; cB = nB; ++ui;
        if constexpr (GATHER) { gA[0] = gN[0]; gA[1] = gN[1]; }
        if constexpr (ALIGN_EPI) { if (wr == 1) PG8_BAR; }
    }
    PG8_WAIT_V(0);
    if constexpr (!ALIGN_EPI) { if (wr == 0) PG8_BAR; }
    PG8_BAR;
    if constexpr (Epi::AFTER_DRAIN) { E.fused(acc, cur, wr, wc, fr, fq, lds, wid, lane); S.done(cur); }
#undef PG8_SA
#undef PG8_GLOAD
#undef PG8_STAGE_A
#undef PG8_SB
#undef PG8_STAGE
#undef PG8_LDA
#undef PG8_LDB
#undef PG8_MMA
#undef PG8_WAIT_V
#undef PG8_WAIT_L
#undef PG8_BAR
#undef PG8_SCHED
}
}

typedef unsigned short bf16_t;
typedef unsigned u32x4 __attribute__((ext_vector_type(4)));
typedef float f32x4 __attribute__((ext_vector_type(4)));
#define LAS __attribute__((address_space(3)))

constexpr int BATCH = 4, SEQ = 8192, T = BATCH * SEQ, D = 1024, NIN = 2304, DEPTH = 2;
constexpr int NH = 8;
constexpr int NBUCKET = 24, MAXTILES = 152, MAXROWS = MAXTILES * 256;
constexpr float EPS = 1e-6f;
constexpr float LOG2E = 1.4426950408889634f;
constexpr int NWAVES = 8, NTHREADS = 512;
constexpr int LDS_BYTES = 155648;
constexpr int LDS_BARW = LDS_BYTES - 64;

constexpr size_t MiB = 1u << 20;
constexpr size_t WS_CTL = 0;
constexpr size_t WS_WIN = 1 * MiB;
constexpr size_t WS_WOUT = 10 * MiB;
constexpr size_t WS_WGU = 14 * MiB;
constexpr size_t WS_WDN = 46 * MiB;
constexpr size_t WS_GLU = 94 * MiB;
constexpr size_t WS_S5 = 95 * MiB;
constexpr size_t S5_M1 = 0, S5_M2P = 1 * MiB, S5_TT = 2 * MiB, S5_AP16 = 2 * MiB + 256 * 1024, S5_AP256 = 2 * MiB + 512 * 1024, S5_LAYER = 4 * MiB;
constexpr size_t WS_S5F = WS_S5 + 8 * MiB;
constexpr size_t WS_SGUW = 94 * MiB + 512 * 1024;
constexpr size_t WS_ROUTEW = 105 * MiB;
constexpr size_t WS_XB = 106 * MiB;
constexpr size_t WS_META = 170 * MiB;
constexpr size_t WS_PROJ = 172 * MiB;
constexpr size_t WS_U = WS_PROJ, WS_V = WS_PROJ + 16 * MiB, WS_ZS = WS_PROJ + 32 * MiB;
constexpr size_t WS_QH = WS_PROJ + 48 * MiB, WS_KH = WS_PROJ + 80 * MiB, WS_VH = WS_PROJ + 112 * MiB;
constexpr size_t WS_XS = WS_PROJ;
constexpr size_t WS_H = WS_PROJ + 76 * MiB;
constexpr size_t WS_O = 316 * MiB;
constexpr size_t WS_YG = 380 * MiB;
constexpr size_t WS_SSQP = 380 * MiB;
constexpr size_t WS_SSQB = 382 * MiB;
constexpr size_t WS_BLIST = 384 * MiB;
constexpr size_t WS_BGW0 = 388 * MiB, WS_BGW1 = 392 * MiB, WS_BRS = 396 * MiB;
constexpr size_t WS_END = 412 * MiB;
constexpr size_t MT_RSTD = 0;
constexpr size_t MT_VR = 128 * 1024;
constexpr size_t MT_BUCKET = 256 * 1024;
constexpr size_t MT_POS = 384 * 1024;
constexpr size_t MT_GW0 = 512 * 1024;
constexpr size_t MT_GW1 = 640 * 1024;
constexpr size_t MT_RS2 = 768 * 1024;
constexpr size_t MT_STOK = 896 * 1024;
constexpr size_t MT_SGW0 = 1216 * 1024;
constexpr size_t MT_SGW1 = 1408 * 1024;
constexpr size_t MT_SRS = 1600 * 1024;
constexpr int CW_CNT = 64;
constexpr int CW_BAR = 4096;
constexpr int CW_TILEB = 256;

__device__ __forceinline__ float bf2f(bf16_t v) { return __uint_as_float(((unsigned)v) << 16); }
__device__ __forceinline__ bf16_t f2bf(float f) { unsigned u = __float_as_uint(f); return (bf16_t)((u + 0x7fffu + ((u >> 16) & 1u)) >> 16); }
__device__ __forceinline__ unsigned pk2(float lo, float hi) { return pg8::cvt_pk_bf16(lo, hi); }
__device__ __forceinline__ float fast_sigmoid_mul(float x, float z) { return x * __builtin_amdgcn_rcpf(1.f + __expf(-z)); }
__device__ __forceinline__ float gelu_tanh(float x) { const float u = 0.7978845608028654f * (x + 0.044715f * x * x * x); return fast_sigmoid_mul(x, 2.f * u); }
__device__ __forceinline__ float wave_sum(float v) {
#pragma unroll
    for (int o = 1; o < 64; o <<= 1) v += __shfl_xor(v, o);
    return v;
}
__device__ __forceinline__ float wave_max(float v) {
#pragma unroll
    for (int o = 1; o < 64; o <<= 1) v = fmaxf(v, __shfl_xor(v, o));
    return v;
}
#define GAS __attribute__((address_space(1)))
template <class Tp> __device__ __forceinline__ Tp* opaque(Tp* q) { GAS Tp* g = (GAS Tp*)q; asm volatile("" : "+v"(g)); return (Tp*)g; }
__device__ __forceinline__ const float* gptr(const float* q) { const GAS float* g = (const GAS float*)q; asm("" : "+s"(g)); return (const float*)g; }
__device__ __forceinline__ int pair_lo(int pi) { return pi < 3 ? 0 : (pi < 5 ? 1 : 2); }
__device__ __forceinline__ int pair_hi(int pi) { return pi < 3 ? pi + 1 : (pi < 5 ? pi - 1 : 3); }

#ifndef REP_ID
#define REP_ID -1
#endif
#ifndef REP_N
#define REP_N 4
#endif
#ifndef REP_PH
#define REP_PH -1
#endif
#define REPEAT(id, body) do { const int nrep_ = (REP_ID == (id) && l == 0) ? REP_N : 1; for (int rep_ = 0; rep_ < nrep_; ++rep_) { body; } } while (0)

struct KArgs { const float* in[29]; float* out; unsigned char* ws; int ph_lo, ph_hi; };

struct Ctx {
    LAS unsigned char* lds;
    const float* const* in; float* out; unsigned char* ws;
    int tid, lane, wave, gw, ngw, G;
    bool dry;
};

__host__ __device__ __forceinline__ int inproj_row_of_col(int n) {
    if (n < 768) return n;
    const int pn = n >> 8, r = n & 255, wc = r >> 6, bj = (r >> 5) & 1, i = r & 31;
    return pn * 256 + bj * 128 + wc * 32 + i;
}
struct TDesc { const float* W; const float* scale; bf16_t* WT; int N, ldk, koff, k0, n0, rowmode; };
struct TRegs { f32x4 v[16]; float s[16]; };
__device__ __forceinline__ void tr_load(const TDesc& d, TRegs& r, int lane) {
    const int kr = lane >> 4, c4 = (lane & 15) * 4;
#pragma unroll
    for (int i = 0; i < 16; ++i) { r.v[i] = *(const f32x4*)(d.W + (size_t)(d.k0 + 4 * i + kr) * d.N + d.n0 + c4); r.s[i] = d.scale ? d.scale[d.k0 + 4 * i + kr] : 1.f; }
}
__device__ __forceinline__ void tr_finish(const TDesc& d, const TRegs& r, LAS float* scr, int lane) {
    const int kr = lane >> 4, c4 = (lane & 15) * 4;
#pragma unroll
    for (int i = 0; i < 16; ++i) { const int kk = 4 * i + kr; const float s = r.s[i];
        LAS float* q = scr + kk * 65 + c4; q[0] = r.v[i].x * s; q[1] = r.v[i].y * s; q[2] = r.v[i].z * s; q[3] = r.v[i].w * s; }
    asm volatile("s_waitcnt lgkmcnt(0)" ::: "memory");
    const int c = lane & 7;
#pragma unroll
    for (int j = 0; j < 8; ++j) {
        const int nl = (lane >> 3) + 8 * j; const LAS float* s = scr + (8 * c) * 65 + nl;
        u32x4 o; o.x = pk2(s[0 * 65], s[1 * 65]); o.y = pk2(s[2 * 65], s[3 * 65]); o.z = pk2(s[4 * 65], s[5 * 65]); o.w = pk2(s[6 * 65], s[7 * 65]);
        const int n = d.n0 + nl; int row;
        if (d.rowmode == 0) row = n;
        else if (d.rowmode == 1) row = inproj_row_of_col(n);
        else if (d.rowmode == 2) row = 256 * (n >> 7) + (n & 127);
        else row = 256 * (n >> 7) + 128 + (n & 127);
        if (d.rowmode == 4) { const int k8 = (d.k0 >> 3) + c;
            *(u32x4*)(d.WT + ((size_t)(((n >> 5) * 16 + (k8 >> 1)) * 64 + (k8 & 1) * 32 + (n & 31))) * 8) = o; }
        else *(u32x4*)(d.WT + (size_t)row * d.ldk + d.koff + d.k0 + 8 * c) = o;
    }
    asm volatile("s_waitcnt lgkmcnt(0)" ::: "memory");
}
constexpr int IT_WIN = 16 * 36, IT_WOUT = 16 * 16, IT_WGU1 = 16 * 4, IT_WDN1 = 4 * 16, IT_GLU = 4 * 4;
constexpr int IT_L = IT_WIN + IT_WOUT + 16 * 2 * IT_WGU1 + NBUCKET * 2 * IT_WDN1 + IT_GLU;
constexpr int IT_TOTAL = DEPTH * IT_L;
__device__ __forceinline__ TDesc prep_desc(const Ctx& C, int it) {
    const int l = it / IT_L; int r = it % IT_L;
    unsigned char* ws = C.ws; TDesc d;
    if (r < IT_WIN) { const int kb = r / 36, nb = r % 36;
        d = TDesc{gptr(C.in[2]) + (size_t)l * D * NIN, gptr(C.in[1]) + l * D, (bf16_t*)(ws + WS_WIN) + (size_t)l * NIN * D, NIN, D, 0, kb * 64, nb * 64, 1}; return d; }
    r -= IT_WIN;
    if (r < IT_WOUT) { const int kb = r / 16, nb = r % 16;
        d = TDesc{gptr(C.in[20]) + (size_t)l * D * D, gptr(C.in[19]) + l * D, (bf16_t*)(ws + WS_WOUT) + (size_t)l * D * D, D, D, 0, kb * 64, nb * 64, 0}; return d; }
    r -= IT_WOUT;
    if (r < 16 * 2 * IT_WGU1) { const int e = r / (2 * IT_WGU1), q = r % (2 * IT_WGU1), isup = q / IT_WGU1, t = q % IT_WGU1, kb = t / 4, nb = t % 4;
        const float* W = (isup ? gptr(C.in[27]) : gptr(C.in[26])) + ((size_t)l * 16 + e) * D * 256;
        d = TDesc{W, gptr(C.in[21]) + l * D, (bf16_t*)(ws + WS_WGU) + ((size_t)l * 16 + e) * 512 * D, 256, D, 0, kb * 64, nb * 64, isup ? 3 : 2}; return d; }
    r -= 16 * 2 * IT_WGU1;
    if (r < NBUCKET * 2 * IT_WDN1) { const int bk = r / (2 * IT_WDN1), q = r % (2 * IT_WDN1), slot = q / IT_WDN1, t = q % IT_WDN1, kb = t / 16, nb = t % 16;
        const int g = bk / 6, pi = bk % 6, e = 4 * g + (slot ? pair_hi(pi) : pair_lo(pi));
        d = TDesc{gptr(C.in[28]) + ((size_t)l * 16 + e) * 256 * D, nullptr, (bf16_t*)(ws + WS_WDN) + ((size_t)l * NBUCKET + bk) * D * 512, D, 512, slot * 256, kb * 64, nb * 64, 0}; return d; }
    r -= NBUCKET * 2 * IT_WDN1;
    { const int kb = r / 4, nb = r % 4;
        d = TDesc{gptr(C.in[14]) + (size_t)l * 256 * 256, nullptr, (bf16_t*)(ws + WS_GLU) + (size_t)l * 256 * 256, 256, 256, 0, kb * 64, nb * 64, 4}; return d; }
}
__device__ __forceinline__ void phase_prep_weights(const Ctx& C, LAS float* scr) {
    TDesc d0, d1; TRegs r0, r1;
    int it = C.gw; bool h0 = it < IT_TOTAL;
    if (h0) { d0 = prep_desc(C, it); tr_load(d0, r0, C.lane); }
    while (h0) {
        const int it1 = it + C.ngw; const bool h1 = it1 < IT_TOTAL;
        if (h1) { d1 = prep_desc(C, it1); tr_load(d1, r1, C.lane); }
        tr_finish(d0, r0, scr, C.lane);
        if (!h1) break;
        const int it2 = it1 + C.ngw; h0 = it2 < IT_TOTAL;
        if (h0) { d0 = prep_desc(C, it2); tr_load(d0, r0, C.lane); }
        tr_finish(d1, r1, scr, C.lane);
        it = it2;
    }
}
__device__ __forceinline__ void conv_row(const float* xrow, bf16_t* orow, float* rstd_out, int lane) {
    const f32x4* xr = (const f32x4*)xrow + lane;
    f32x4 v[4]; float s = 0.f;
#pragma unroll
    for (int j = 0; j < 4; ++j) { v[j] = xr[64 * j]; s += (v[j].x * v[j].x + v[j].y * v[j].y) + (v[j].z * v[j].z + v[j].w * v[j].w); }
    s = wave_sum(s);
    if (lane == 0) *rstd_out = 1.0f / sqrtf(s * (1.f / D) + EPS);
    unsigned long long* o8 = (unsigned long long*)orow + lane;
#pragma unroll
    for (int j = 0; j < 4; ++j) o8[64 * j] = (unsigned long long)pk2(v[j].x, v[j].y) | ((unsigned long long)pk2(v[j].z, v[j].w) << 32);
}
__device__ __forceinline__ void phase_conv(const Ctx& C, const float* x) {
    bf16_t* XB = (bf16_t*)(C.ws + WS_XB); float* RSTD = (float*)(C.ws + WS_META + MT_RSTD);
    for (int m = C.gw * 4; m < T; m += C.ngw * 4) {
        f32x4 v[4][4]; float s[4];
#pragma unroll
        for (int r = 0; r < 4; ++r) { const f32x4* xr = (const f32x4*)(x + (size_t)(m + r) * D) + C.lane;
#pragma unroll
            for (int j = 0; j < 4; ++j) v[r][j] = xr[64 * j]; }
#pragma unroll
        for (int r = 0; r < 4; ++r) { float a = 0.f;
#pragma unroll
            for (int j = 0; j < 4; ++j) a += (v[r][j].x * v[r][j].x + v[r][j].y * v[r][j].y) + (v[r][j].z * v[r][j].z + v[r][j].w * v[r][j].w);
            s[r] = wave_sum(a);
            unsigned long long* o8 = (unsigned long long*)(XB + (size_t)(m + r) * D) + C.lane;
#pragma unroll
            for (int j = 0; j < 4; ++j) o8[64 * j] = (unsigned long long)pk2(v[r][j].x, v[r][j].y) | ((unsigned long long)pk2(v[r][j].z, v[r][j].w) << 32); }
        if (C.lane < 4) RSTD[m + C.lane] = 1.0f / sqrtf((C.lane == 0 ? s[0] : C.lane == 1 ? s[1] : C.lane == 2 ? s[2] : s[3]) * (1.f / D) + EPS);
    }
}
struct DenseSched {
    const char* A; const char* Bt; int nM, nN, nwg, G, c; size_t tstep;
    __device__ __forceinline__ void init(const void* A_, const void* Bt_, int M, int N, int K, int G_, int c_) { A = (const char*)A_; Bt = (const char*)Bt_; nM = M / 256; nN = N / 256; nwg = nM * nN; G = G_; c = c_; tstep = (size_t)256 * K * 2; }
    __device__ __forceinline__ bool next(int i, pg8::Unit& u) const {
        const int R = nwg / G, r = nwg - R * G; long L; u.hf = 0;
        if (i < R) L = (long)i * G + c;
        else if (i == R && r > 0) { if (2 * r <= G) { if (c >= 2 * r) return false; L = (long)R * G + (c % r); u.hf = 1 + c / r; } else { if (c >= r) return false; L = (long)R * G + c; } }
        else return false;
        int wgid = (int)L; { const int q = nwg / 8, rr = nwg % 8, xcd = wgid % 8, off = wgid / 8; wgid = (xcd < rr ? xcd * (q + 1) : rr * (q + 1) + (xcd - rr) * q) + off; }
        const int nig = 8 * nN, gid = wgid / nig, fm = gid * 8, gsz = (nM - fm) < 8 ? (nM - fm) : 8;
        u.pm = fm + ((wgid % nig) % gsz); u.pn = (wgid % nig) / gsz; return true;
    }
    __device__ __forceinline__ const char* a_base(const pg8::Unit& u) const { return A + (size_t)u.pm * tstep + (u.hf == 2 ? tstep / 2 : 0); }
    __device__ __forceinline__ const char* b_base(const pg8::Unit& u) const { return Bt + (size_t)u.pn * tstep; }
    __device__ __forceinline__ int a_row(const pg8::Unit&, int) const { return 0; }
    __device__ __forceinline__ void a_ready(const pg8::Unit&) const {}
    __device__ __forceinline__ void done(const pg8::Unit&) const {}
};
constexpr int TB_OFF = 131072;
struct TileTab { const LAS int* t;
    __device__ __forceinline__ int bucket(int pm) const { return t[pm]; }
    __device__ __forceinline__ int row0(int pm, int bk) const { return (pm - t[160 + bk]) * 256; }
    __device__ __forceinline__ int count(int bk) const { return t[192 + bk]; }
    __device__ __forceinline__ int ntiles() const { return t[224]; } };
__device__ __forceinline__ void build_tile_table(const Ctx& C, int l) {
    LAS int* t = (LAS int*)(C.lds + TB_OFF); const unsigned* cnt = (const unsigned*)(C.ws + WS_CTL) + CW_CNT + l * 32;
    if (C.tid < 64) { const int lane = C.tid; const int c = (lane < NBUCKET) ? (int)cnt[lane] : 0; const int nt = (c + 255) >> 8; int incl = nt;
#pragma unroll
        for (int o = 1; o < 32; o <<= 1) { const int v = __shfl_up(incl, o); if (lane >= o) incl += v; }
        const int excl = incl - nt;
        if (lane < 32) { t[160 + lane] = excl; t[192 + lane] = c; }
        if (lane < NBUCKET) for (int i = 0; i < nt; ++i) t[excl + i] = lane;
        if (lane == NBUCKET - 1) t[224] = incl; }
    __syncthreads();
}
struct GroupSched {
    const char* A; const char* B; TileTab tt; const int* blist; int ntiles, G, c, mode; size_t a_tile_bytes;
    __device__ __forceinline__ bool next(int i, pg8::Unit& u) const {
        const int NU = ntiles * 4, R = NU / G, r = NU - R * G; int L; u.hf = 0;
        const int cv = ((G & 7) == 0) ? (c & 7) * (G >> 3) + (c >> 3) : c;
        if (i < R) L = i * G + cv;
        else if (i == R && r > 0) { if (2 * r <= G) { if (cv >= 2 * r) return false; L = R * G + (cv % r); u.hf = 1 + cv / r; } else { if (cv >= r) return false; L = R * G + cv; } }
        else return false;
        u.pm = L >> 2; u.pn = L & 3; return true; }
    __device__ __forceinline__ const char* a_base(const pg8::Unit& u) const { return mode == 1 ? A : A + (size_t)u.pm * a_tile_bytes + (u.hf == 2 ? a_tile_bytes / 2 : 0); }
    __device__ __forceinline__ int a_row(const pg8::Unit& u, int row) const {
        const int bk = tt.bucket(u.pm), r = tt.row0(u.pm, bk) + row + (u.hf == 2 ? 128 : 0); return blist[bk * T + (r < tt.count(bk) ? r : 0)]; }
    __device__ __forceinline__ const char* b_base(const pg8::Unit& u) const {
        const int bk = tt.bucket(u.pm);
        if (mode == 1) { const int g = bk / 6, pi = bk % 6, e = 4 * g + ((u.pn >> 1) ? pair_hi(pi) : pair_lo(pi)); return B + ((size_t)e * 512 + (u.pn & 1) * 256) * (size_t)(D * 2); }
        return B + ((size_t)bk * D + u.pn * 256) * (size_t)(512 * 2);
    }
    __device__ __forceinline__ void a_ready(const pg8::Unit&) const {}
    __device__ __forceinline__ void done(const pg8::Unit&) const {}
};

__device__ __forceinline__ float row_rstd(const float* ssqp, int row) {
    const f32x4* q = (const f32x4*)(ssqp + (size_t)row * 16); const f32x4 a = q[0], b = q[1], c = q[2], d = q[3];
    const float s = (((a.x + a.y) + (a.z + a.w)) + ((b.x + b.y) + (b.z + b.w))) + (((c.x + c.y) + (c.z + c.w)) + ((d.x + d.y) + (d.z + d.w)));
    return 1.0f / sqrtf(s * (1.f / D) + EPS);
}
struct EpiIn {
    static constexpr bool PERM = true, AFTER_DRAIN = false;
    const float* rstd; bf16_t *U, *QH; const float *qg, *kg;
    __device__ __forceinline__ void operator()(const f32x4 (&acc)[2][2][4][2], const pg8::Unit& u, int wr, int wc, int fr, int fq) const {
        const int pn = u.pn; const int row0 = u.pm * 256 + (u.hf == 2 ? 128 : 0) + wr * 64 + fr; const bool halfu = u.hf != 0;
        if (pn < 3) {
            bf16_t* base = U + (size_t)pn * (8u << 20) + wc * 32 + 8 * fq;
#pragma unroll
            for (int ai = 0; ai < 2; ++ai)
#pragma unroll
                for (int m = 0; m < 4; ++m) { if (ai == 1 && halfu) continue; const int row = row0 + ai * 128 + m * 16; const float rs = rstd[row];
#pragma unroll
                    for (int bj = 0; bj < 2; ++bj) { f32x4 v0 = acc[ai][bj][m][0] * rs, v1 = acc[ai][bj][m][1] * rs;
                        if (pn < 2) { v0.x = gelu_tanh(v0.x); v0.y = gelu_tanh(v0.y); v0.z = gelu_tanh(v0.z); v0.w = gelu_tanh(v0.w); v1.x = gelu_tanh(v1.x); v1.y = gelu_tanh(v1.y); v1.z = gelu_tanh(v1.z); v1.w = gelu_tanh(v1.w); }
                        u32x4 w; w.x = pk2(v0.x, v0.y); w.y = pk2(v0.z, v0.w); w.z = pk2(v1.x, v1.y); w.w = pk2(v1.z, v1.w);
                        *(u32x4*)(base + (size_t)row * 256 + bj * 128) = w; } }
        } else {
            const int typ = (pn - 3) >> 1, head = 4 * ((pn - 3) & 1) + wc;
            bf16_t* dstb = QH + (size_t)typ * (16u << 20) + 8 * fq;
            f32x4 gv[2][2];
            const float* gsrc = qg + (kg - qg) * (typ == 1 ? 1 : 0) + 8 * fq; const float sc = (typ == 0) ? 0.125f * LOG2E : 1.f;
#pragma unroll
            for (int bj = 0; bj < 2; ++bj)
#pragma unroll
                for (int n = 0; n < 2; ++n) gv[bj][n] = (typ < 2) ? *(const f32x4*)(gsrc + 32 * bj + 4 * n) * sc : (f32x4){1.f, 1.f, 1.f, 1.f};
#pragma unroll
            for (int ai = 0; ai < 2; ++ai)
#pragma unroll
                for (int m = 0; m < 4; ++m) { if (ai == 1 && halfu) continue; const int row = row0 + ai * 128 + m * 16; const float rs = rstd[row];
                    f32x4 v[2][2]; float ss = 0.f;
#pragma unroll
                    for (int bj = 0; bj < 2; ++bj)
#pragma unroll
                        for (int n = 0; n < 2; ++n) { v[bj][n] = acc[ai][bj][m][n] * rs; ss += (v[bj][n].x * v[bj][n].x + v[bj][n].y * v[bj][n].y) + (v[bj][n].z * v[bj][n].z + v[bj][n].w * v[bj][n].w); }
                    ss += __shfl_xor(ss, 16); ss += __shfl_xor(ss, 32);
                    const float r = (typ < 2) ? 1.0f / sqrtf(ss * (1.f / 64.f) + EPS) : 1.f;
                    const int b = row >> 13, s = row & (SEQ - 1);
                    bf16_t* dst = dstb + ((size_t)(b * NH + head) * SEQ + s) * 64;
#pragma unroll
                    for (int bj = 0; bj < 2; ++bj) { const f32x4 v0 = v[bj][0] * r * gv[bj][0], v1 = v[bj][1] * r * gv[bj][1];
                        u32x4 w; w.x = pk2(v0.x, v0.y); w.y = pk2(v0.z, v0.w); w.z = pk2(v1.x, v1.y); w.w = pk2(v1.z, v1.w);
                        *(u32x4*)(dst + 32 * bj) = w; } }
        }
    }
};
__device__ __forceinline__ f32x4 bf_lo4(unsigned a, unsigned b) { return (f32x4){__uint_as_float(a << 16), __uint_as_float(a & 0xffff0000u), __uint_as_float(b << 16), __uint_as_float(b & 0xffff0000u)}; }
struct EpiOut {
    static constexpr bool PERM = true, AFTER_DRAIN = false;
    bf16_t* xb; float* ssq; size_t wofs;
    __device__ __forceinline__ void operator()(const f32x4 (&acc)[2][2][4][2], const pg8::Unit& u, int wr, int wc, int fr, int fq) const {
        const int row0 = u.pm * 256 + wr * 64 + fr, col0 = u.pn * 256 + wc * 32 + 8 * fq;
#pragma unroll
        for (int ai = 0; ai < 2; ++ai)
#pragma unroll
            for (int m = 0; m < 4; ++m) { const int row = row0 + ai * 128 + m * 16; bf16_t* xp = xb + (size_t)row * D + col0; float ss = 0.f;
#pragma unroll
                for (int bj = 0; bj < 2; ++bj) { const u32x4 w = *(const u32x4*)(xp + bj * 128);
                    const f32x4 v0 = bf_lo4(w.x, w.y) + acc[ai][bj][m][0], v1 = bf_lo4(w.z, w.w) + acc[ai][bj][m][1];
                    u32x4 o; o.x = pk2(v0.x, v0.y); o.y = pk2(v0.z, v0.w); o.z = pk2(v1.x, v1.y); o.w = pk2(v1.z, v1.w); *(u32x4*)(xp + wofs + bj * 128) = o;
                    const f32x4 r0 = bf_lo4(o.x, o.y), r1 = bf_lo4(o.z, o.w);
                    ss += (r0.x * r0.x + r0.y * r0.y) + (r0.z * r0.z + r0.w * r0.w) + (r1.x * r1.x + r1.y * r1.y) + (r1.z * r1.z + r1.w * r1.w); }
                ss += __shfl_xor(ss, 16); ss += __shfl_xor(ss, 32); if (fq == 0) ssq[(size_t)row * 16 + u.pn * 4 + wc] = ss; }
    }
};
struct EpiG1 {
    static constexpr bool PERM = true, AFTER_DRAIN = false;
    TileTab tt; const float *bgw0, *bgw1, *brs; bf16_t* H;
    __device__ __forceinline__ void operator()(const f32x4 (&acc)[2][2][4][2], const pg8::Unit& u, int wr, int wc, int fr, int fq) const {
        const int rl0 = (u.hf == 2 ? 128 : 0) + wr * 64 + fr; const int slot = u.pn >> 1, hh = u.pn & 1; const bool halfu = u.hf != 0;
        const int bk = tt.bucket(u.pm); const size_t lbase = (size_t)bk * T + tt.row0(u.pm, bk);
        const float* bgw = slot ? bgw1 : bgw0;
        bf16_t* hb = H + (size_t)u.pm * 256 * 512 + slot * 256 + hh * 128 + wc * 32 + 8 * fq;
#pragma unroll
        for (int ai = 0; ai < 2; ++ai)
#pragma unroll
            for (int m = 0; m < 4; ++m) { if (ai == 1 && halfu) continue; const int rl = rl0 + ai * 128 + m * 16; const float rs = brs[lbase + rl], gw = bgw[lbase + rl];
                float h[8];
#pragma unroll
                for (int n = 0; n < 2; ++n) { const f32x4 g = acc[ai][0][m][n] * rs, up = acc[ai][1][m][n] * (rs * gw);
                    h[4 * n] = fast_sigmoid_mul(g.x, g.x) * up.x; h[4 * n + 1] = fast_sigmoid_mul(g.y, g.y) * up.y; h[4 * n + 2] = fast_sigmoid_mul(g.z, g.z) * up.z; h[4 * n + 3] = fast_sigmoid_mul(g.w, g.w) * up.w; }
                u32x4 w; w.x = pk2(h[0], h[1]); w.y = pk2(h[2], h[3]); w.z = pk2(h[4], h[5]); w.w = pk2(h[6], h[7]);
                *(u32x4*)(hb + (size_t)rl * 512) = w; }
    }
};
template <bool NEXT> struct EpiG2 {
    static constexpr bool PERM = true, AFTER_DRAIN = false;
    TileTab tt; const int* blist; float* out; bf16_t* xb; float* ssq; size_t wofs;
    __device__ __forceinline__ void operator()(const f32x4 (&acc)[2][2][4][2], const pg8::Unit& u, int wr, int wc, int fr, int fq) const {
        const int rl0 = (u.hf == 2 ? 128 : 0) + wr * 64 + fr, col0 = u.pn * 256 + wc * 32 + 8 * fq; const bool halfu = u.hf != 0;
        const int bk = tt.bucket(u.pm), r0 = tt.row0(u.pm, bk), bc = tt.count(bk); const int* bl = blist + (size_t)bk * T;
#pragma unroll
        for (int ai = 0; ai < 2; ++ai)
#pragma unroll
            for (int m = 0; m < 4; ++m) { if (ai == 1 && halfu) continue; const int r = r0 + rl0 + ai * 128 + m * 16; const int tok = (r < bc) ? bl[r] : -1;
                float ss = 0.f;
                if (tok >= 0) { bf16_t* xp = xb + (size_t)tok * D + col0;
#pragma unroll
                    for (int bj = 0; bj < 2; ++bj) { const u32x4 w = *(const u32x4*)(xp + bj * 128);
                        const f32x4 v0 = bf_lo4(w.x, w.y) + acc[ai][bj][m][0], v1 = bf_lo4(w.z, w.w) + acc[ai][bj][m][1];
                        if (NEXT) { u32x4 o; o.x = pk2(v0.x, v0.y); o.y = pk2(v0.z, v0.w); o.z = pk2(v1.x, v1.y); o.w = pk2(v1.z, v1.w); *(u32x4*)(xp + wofs + bj * 128) = o;
                            const f32x4 r0 = bf_lo4(o.x, o.y), r1 = bf_lo4(o.z, o.w);
                            ss += (r0.x * r0.x + r0.y * r0.y) + (r0.z * r0.z + r0.w * r0.w) + (r1.x * r1.x + r1.y * r1.y) + (r1.z * r1.z + r1.w * r1.w); }
                        else { f32x4* op = (f32x4*)(out + (size_t)tok * D + col0 + bj * 128); __builtin_nontemporal_store(v0, op); __builtin_nontemporal_store(v1, op + 1); } } }
                if (NEXT) { ss += __shfl_xor(ss, 16); ss += __shfl_xor(ss, 32); if (fq == 0 && tok >= 0) ssq[(size_t)tok * 16 + u.pn * 4 + wc] = ss; } }
    }
};

__device__ __forceinline__ void phase_vrstd(const Ctx& C) {
    const bf16_t* V = (const bf16_t*)(C.ws + WS_V); float* vr = (float*)(C.ws + WS_META + MT_VR);
    for (int m = C.gw; m < T; m += C.ngw) {
        const unsigned long long w = ((const unsigned long long*)(V + (size_t)m * 256))[C.lane];
        const float a = __uint_as_float((unsigned)(w << 16)), b = __uint_as_float((unsigned)w & 0xffff0000u), c = __uint_as_float((unsigned)(w >> 32) << 16), d = __uint_as_float((unsigned)(w >> 32) & 0xffff0000u);
        const float s = wave_sum(a * a + b * b + c * c + d * d);
        if (C.lane == 0) vr[m] = 1.0f / sqrtf(s * (1.f / 256.f) + EPS);
    }
}
__device__ __forceinline__ void phase_sgu_naive(const Ctx& C, int l) {
    const bf16_t* U = (const bf16_t*)(C.ws + WS_U); const bf16_t* V = (const bf16_t*)(C.ws + WS_V); const float* vr = (const float*)(C.ws + WS_META + MT_VR);
    const float* sgu_norm = gptr(C.in[3]) + l * 256; const float* sgu_w = gptr(C.in[4]) + (size_t)l * 4 * 128 * 128; const float* sgu_b = gptr(C.in[5]) + l * 512;
    bf16_t* O = (bf16_t*)(C.ws + WS_O);
    const int half = C.tid >> 8, ch = C.tid & 255, h = ch >> 6;
    const float gn = sgu_norm[ch];
    for (int t = blockIdx.x * 2 + half; t < T; t += C.G * 2) {
        const int s = t & (SEQ - 1), i = s & 127, t0 = t - i;
        const int jmax = (i < 64) ? 64 : 128;
        const float* w = sgu_w + ((size_t)h * 128 + i) * 128;
        float acc = 0.f;
        for (int j = 0; j < jmax; ++j) acc += w[j] * (bf2f(V[(size_t)(t0 + j) * 256 + ch]) * vr[t0 + j] * gn);
        acc += sgu_b[h * 128 + i];
        const float oa = bf2f(U[(size_t)t * 256 + ch]) * acc;
        const float ss = wave_sum(oa * oa);
        O[(size_t)t * D + ch] = f2bf(oa * (1.0f / sqrtf(ss * (1.f / 64.f) + EPS)));
    }
}

typedef short bf16x8 __attribute__((ext_vector_type(8)));
typedef short s16x4 __attribute__((ext_vector_type(4)));
typedef float f32x16 __attribute__((ext_vector_type(16)));
constexpr int ATT_BX = 640;
constexpr int ATT_VBUF = 16384;
constexpr int ATT_BX_OFF = NWAVES * ATT_VBUF;
__device__ __forceinline__ void glds16(const void* gsrc, unsigned lds_dst) { unsigned keep;
    asm volatile("s_mov_b32 %0, m0\n\ts_mov_b32 m0, %2\n\ts_nop 0\n\tglobal_load_lds_dwordx4 %1, off\n\ts_mov_b32 m0, %0" : "=&s"(keep) : "v"(gsrc), "s"(lds_dst) : "memory"); }
__device__ __forceinline__ float max3f(float a, float b, float c) { float r; asm("v_max3_f32 %0, %1, %2, %3" : "=v"(r) : "v"(a), "v"(b), "v"(c)); return r; }
__device__ __forceinline__ s16x4 ds_tr(const LAS unsigned char* p) { return __builtin_bit_cast(s16x4, __builtin_amdgcn_ds_read_tr16_b64_v4i16((LAS s16x4*)p)); }
__device__ __forceinline__ void attn_load_bias(const Ctx& C, int l) {
    LAS float* Bx = (LAS float*)(C.lds + ATT_BX_OFF);
    const float* rb = gptr(C.in[18]) + (size_t)l * NH * 513;
    for (int i = C.tid; i < NH * ATT_BX; i += NTHREADS) { const int h = i / ATT_BX, j = i % ATT_BX; int rel = j - 64; rel = rel > 256 ? 256 : rel; Bx[i] = rb[h * 513 + rel + 256] * LOG2E; }
}
constexpr int ATT_KOFF = 0, ATT_VOFF = 16384;
struct AttnState { float m_run, l_run; f32x16 o0, o1; };
__device__ __forceinline__ void attn_step(const Ctx& C, AttnState& S, const bf16x8 (&qf)[4], const LAS unsigned char* kb, const LAS unsigned char* vbt, const LAS float* Bx, int jbase) {
    const int lane = C.lane, r32 = lane & 31, hi = lane >> 5;
    typedef float f32x2 __attribute__((ext_vector_type(2)));
    f32x16 p0, p1;
#pragma unroll
    for (int r = 0; r < 16; ++r) { const int kk = (r & 3) + 8 * (r >> 2); p0[r] = Bx[jbase - kk]; p1[r] = Bx[jbase - kk - 32]; }
    bf16x8 kf[8];
#pragma unroll
    for (int t = 0; t < 2; ++t)
#pragma unroll
        for (int ks = 0; ks < 4; ++ks) kf[t * 4 + ks] = *(const LAS bf16x8*)(kb + (32 * t + r32) * 128 + 16 * ((2 * ks + hi) ^ (r32 & 7)));
#pragma unroll
    for (int ks = 0; ks < 4; ++ks) { p0 = __builtin_amdgcn_mfma_f32_32x32x16_bf16(kf[ks], qf[ks], p0, 0, 0, 0); p1 = __builtin_amdgcn_mfma_f32_32x32x16_bf16(kf[4 + ks], qf[ks], p1, 0, 0, 0); }
    asm volatile("s_nop 15\n\ts_nop 7" : "+v"(p0), "+v"(p1));
    float mx = max3f(p0[0], p1[0], p0[1]), my = max3f(p1[1], p0[2], p1[2]);
#pragma unroll
    for (int r = 3; r < 15; r += 2) { mx = max3f(mx, p0[r], p1[r]); my = max3f(my, p0[r + 1], p1[r + 1]); }
    mx = max3f(mx, p0[15], p1[15]); mx = max3f(mx, my, __shfl_xor(max3f(mx, my, my), 32));
    const float m_new = max3f(S.m_run, mx, mx);
    const float alpha = __builtin_amdgcn_exp2f(S.m_run - m_new);
    S.m_run = m_new;
    const f32x2 m2 = {m_new, m_new}; f32x2 ps2 = {0.f, 0.f};
#pragma unroll
    for (int r = 0; r < 16; r += 2) {
        f32x2 x = (f32x2){p0[r], p0[r + 1]} - m2, y = (f32x2){p1[r], p1[r + 1]} - m2;
        x.x = __builtin_amdgcn_exp2f(x.x); x.y = __builtin_amdgcn_exp2f(x.y); y.x = __builtin_amdgcn_exp2f(y.x); y.y = __builtin_amdgcn_exp2f(y.y);
        p0[r] = x.x; p0[r + 1] = x.y; p1[r] = y.x; p1[r + 1] = y.y; ps2 += x + y; }
    S.l_run = S.l_run * alpha + (ps2.x + ps2.y);
#pragma unroll
    for (int r = 0; r < 16; ++r) { S.o0[r] *= alpha; S.o1[r] *= alpha; }
    bf16x8 pf[4];
#pragma unroll
    for (int s = 0; s < 2; ++s) { u32x4 w0, w1;
        w0.x = pk2(p0[8 * s], p0[8 * s + 1]); w0.y = pk2(p0[8 * s + 2], p0[8 * s + 3]); w0.z = pk2(p0[8 * s + 4], p0[8 * s + 5]); w0.w = pk2(p0[8 * s + 6], p0[8 * s + 7]);
        w1.x = pk2(p1[8 * s], p1[8 * s + 1]); w1.y = pk2(p1[8 * s + 2], p1[8 * s + 3]); w1.z = pk2(p1[8 * s + 4], p1[8 * s + 5]); w1.w = pk2(p1[8 * s + 6], p1[8 * s + 7]);
        pf[s] = __builtin_bit_cast(bf16x8, w0); pf[2 + s] = __builtin_bit_cast(bf16x8, w1); }
    bf16x8 vf[8];
#pragma unroll
    for (int ts = 0; ts < 4; ++ts)
#pragma unroll
        for (int dt = 0; dt < 2; ++dt) { const s16x4 lo = ds_tr(vbt + ((2 * ts) * 2 + dt) * 512), hi4 = ds_tr(vbt + ((2 * ts + 1) * 2 + dt) * 512);
            vf[2 * ts + dt] = (bf16x8){lo[0], lo[1], lo[2], lo[3], hi4[0], hi4[1], hi4[2], hi4[3]}; }
#pragma unroll
    for (int ts = 0; ts < 4; ++ts) { S.o0 = __builtin_amdgcn_mfma_f32_32x32x16_bf16(vf[2 * ts], pf[ts], S.o0, 0, 0, 0); S.o1 = __builtin_amdgcn_mfma_f32_32x32x16_bf16(vf[2 * ts + 1], pf[ts], S.o1, 0, 0, 0); }
}
__device__ __forceinline__ void attn_block_item(const Ctx& C, int b, int h, int c0) {
    const bf16_t* QH = (const bf16_t*)(C.ws + WS_QH); const bf16_t* KH = (const bf16_t*)(C.ws + WS_KH); const bf16_t* VH = (const bf16_t*)(C.ws + WS_VH);
    bf16_t* O = (bf16_t*)(C.ws + WS_O);
    const int lane = C.lane, r32 = lane & 31, hi = lane >> 5, tid = C.tid, j = C.wave >> 1, half = C.wave & 1, qc = c0 + j;
    const unsigned lds0 = (unsigned)(uintptr_t)C.lds;
    const LAS float* Bx = (const LAS float*)(C.lds + ATT_BX_OFF) + h * ATT_BX;
    const size_t bh = (size_t)(b * NH + h) * SEQ;
    bf16x8 qf[4];
    { const bf16_t* Qp = QH + (bh + qc * 64 + half * 32 + r32) * 64 + 8 * hi;
#pragma unroll
      for (int ks = 0; ks < 4; ++ks) qf[ks] = *(const bf16x8*)(Qp + 16 * ks); }
    const bf16_t* Ksrc = KH + (bh + (tid >> 3)) * 64 + 8 * ((tid & 7) ^ ((tid >> 3) & 7));
    const bf16_t* Vsrc = VH + (bh + 8 * C.wave + ((lane & 31) >> 2)) * 64 + (4 * (lane >> 5) + (lane & 3)) * 8;
    const unsigned kdst = lds0 + ATT_KOFF + C.wave * 1024, vdst = lds0 + ATT_VOFF + C.wave * 1024;
    const int i16 = lane & 15;
    const int trbase = (4 * hi + (i16 >> 2)) * 64 + (16 * ((lane >> 4) & 1) + 4 * (i16 & 3)) * 2;
    const int qi = 32 * half + r32;
    AttnState S; S.m_run = -INFINITY; S.l_run = 0.f;
#pragma unroll
    for (int r = 0; r < 16; ++r) { S.o0[r] = 0.f; S.o1[r] = 0.f; }
    const int s0 = c0 >= 8 ? 0 : 8 - c0;
    { const size_t ko = (size_t)(c0 - 8 + s0) * 64 * 64;
      glds16(Ksrc + ko, (unsigned)__builtin_amdgcn_readfirstlane((int)(kdst + (s0 & 1) * 8192))); glds16(Vsrc + ko, (unsigned)__builtin_amdgcn_readfirstlane((int)(vdst + (s0 & 1) * 8192))); }
    asm volatile("s_waitcnt vmcnt(0) lgkmcnt(0)\n\ts_barrier" ::: "memory");
    for (int s = s0; s < 12; ++s) {
        if (s + 1 < 12) { const size_t ko = (size_t)(c0 - 8 + s + 1) * 64 * 64; const int nb = (s + 1) & 1;
            glds16(Ksrc + ko, (unsigned)__builtin_amdgcn_readfirstlane((int)(kdst + nb * 8192))); glds16(Vsrc + ko, (unsigned)__builtin_amdgcn_readfirstlane((int)(vdst + nb * 8192))); }
        const int jb = s - j;
        if (jb >= 0 && jb < 9) attn_step(C, S, qf, C.lds + ATT_KOFF + (s & 1) * 8192, C.lds + ATT_VOFF + (s & 1) * 8192 + trbase, Bx, 512 - 64 * jb + qi + 64 - 4 * hi);
        asm volatile("s_waitcnt vmcnt(0) lgkmcnt(0)\n\ts_barrier" ::: "memory");
    }
    float lt = S.l_run + __shfl_xor(S.l_run, 32);
    const float inv = 1.0f / lt;
    float ss = 0.f;
#pragma unroll
    for (int r = 0; r < 16; ++r) { S.o0[r] *= inv; S.o1[r] *= inv; ss += S.o0[r] * S.o0[r] + S.o1[r] * S.o1[r]; }
    ss += __shfl_xor(ss, 32);
    const float rn = 1.0f / sqrtf(ss * (1.f / 64.f) + EPS);
    bf16_t* op = O + (size_t)(b * SEQ + qc * 64 + half * 32 + r32) * D + 512 + h * 64 + 4 * hi;
#pragma unroll
    for (int g = 0; g < 4; ++g) {
        *(unsigned long long*)(op + 8 * g) = (unsigned long long)pk2(S.o0[4 * g] * rn, S.o0[4 * g + 1] * rn) | ((unsigned long long)pk2(S.o0[4 * g + 2] * rn, S.o0[4 * g + 3] * rn) << 32);
        *(unsigned long long*)(op + 32 + 8 * g) = (unsigned long long)pk2(S.o1[4 * g] * rn, S.o1[4 * g + 1] * rn) | ((unsigned long long)pk2(S.o1[4 * g + 2] * rn, S.o1[4 * g + 3] * rn) << 32);
    }
}
__device__ __forceinline__ void phase_attn(const Ctx& C, int l, int first, int stride, int count) {
    attn_load_bias(C, l);
    __syncthreads();
    for (int j = 0; j < count; ++j) { const int it = first + j * stride;
        if (it < BATCH * NH * (SEQ / 256)) { const int qq = it % (SEQ / 256), bh = it / (SEQ / 256), b = bh / NH, h = bh % NH;
            attn_block_item(C, b, h, qq * 4); } }
    __syncthreads();
}

struct S5C { float x; double y; float fr, fi; };
__device__ __forceinline__ void s5_sincos_d(double ang, float& sn, float& cs) {
    ang -= 6.283185307179586476925 * rint(ang * 0.15915494309189533577);
    const float a = (float)ang; sn = __sinf(a); cs = __cosf(a);
}
__device__ __forceinline__ S5C s5_consts(const Ctx& C, int l, int g, int p) {
    const float lr = gptr(C.in[6])[l * 1024 + g * 64 + p], li = gptr(C.in[7])[l * 1024 + g * 64 + p], dt = __expf(gptr(C.in[8])[l * 16 + g]);
    S5C c; c.x = lr * dt; c.y = (double)li * (double)dt;
    float sn, cs, sh, ch; s5_sincos_d(c.y, sn, cs); s5_sincos_d(0.5 * c.y, sh, ch);
    const float x = c.x;
    const float ex1 = x * (1.f + x * (0.5f + x * (0.16666667f + x * (0.041666668f + x * (0.0083333338f + x * 0.0013888889f))))), er = ex1 + 1.f;
    const float nr = ex1 * cs - 2.f * sh * sh, ni = er * sn, den = lr * lr + li * li;
    c.fr = (nr * lr + ni * li) / den; c.fi = (ni * lr - nr * li) / den;
    return c;
}
__device__ __forceinline__ void s5_cpow(const S5C& c, int n, float& re, float& im) {
    const float e = __expf(c.x * (float)n);
    float sn, cs; s5_sincos_d(c.y * (double)n, sn, cs); re = e * cs; im = e * sn;
}
__device__ __forceinline__ int s5_m2col(int sg) { const int ks = sg >> 5, rem = sg & 31; return 32 * ks + 8 * ((rem >> 2) & 3) + 4 * (rem >> 4) + (rem & 3); }
constexpr int S5_ITEMS_LG = 19, S5_ITEMS = DEPTH * 16 * S5_ITEMS_LG;
constexpr int S5_APS = 19 * 128;
__device__ __forceinline__ void s5_prep_item(const Ctx& C, int it, LAS float* scr) {
    const int lg = it / S5_ITEMS_LG, r = it % S5_ITEMS_LG, l = lg >> 4, g = lg & 15, lane = C.lane;
    unsigned char* base = C.ws + WS_S5 + (size_t)l * S5_LAYER;
    const float* bre = gptr(C.in[9]) + l * 16384 + g * 1024; const float* bim = gptr(C.in[10]) + l * 16384 + g * 1024;
    const float* cre = gptr(C.in[11]) + l * 16384 + g * 1024; const float* cim = gptr(C.in[12]) + l * 16384 + g * 1024;
    if (r < 16) {
        const int delta = r;
        { const int p = lane; const S5C c = s5_consts(C, l, g, p);
#pragma unroll
          for (int ts = 0; ts < 2; ++ts) { float pr = 0.f, pi = 0.f; if (delta - ts >= 0) s5_cpow(c, delta - ts, pr, pi);
              scr[(ts * 64 + p) * 2] = (delta - ts >= 0) ? pr * c.fr - pi * c.fi : 0.f; scr[(ts * 64 + p) * 2 + 1] = (delta - ts >= 0) ? pr * c.fi + pi * c.fr : 0.f; } }
        { LAS f32x4* sb = (LAS f32x4*)(scr + 256);
#pragma unroll
          for (int q = 0; q < 4; ++q) { sb[lane + 64 * q] = ((const f32x4*)bre)[lane + 64 * q]; sb[256 + lane + 64 * q] = ((const f32x4*)bim)[lane + 64 * q]; } }
        asm volatile("s_waitcnt lgkmcnt(0)" ::: "memory");
        const int h = lane & 15, kq = lane >> 4, ts = kq >> 1, tau = delta - ts;
        float acc[8];
#pragma unroll
        for (int j = 0; j < 8; ++j) acc[j] = 0.f;
        const LAS f32x4* sbr = (const LAS f32x4*)(scr + 256) + 2 * (kq & 1); const LAS f32x4* sbi = sbr + 256;
        float cr[64 / 16], ci[64 / 16];
#pragma unroll 1
        for (int p0 = 0; p0 < 64; p0 += 4) {
#pragma unroll
            for (int q = 0; q < 4; ++q) { cr[q] = cre[h * 64 + p0 + q]; ci[q] = cim[h * 64 + p0 + q]; }
#pragma unroll
            for (int q = 0; q < 4; ++q) { const int p = p0 + q;
                const float pr = scr[(ts * 64 + p) * 2], pi = scr[(ts * 64 + p) * 2 + 1];
                const float wr = cr[q] * pr - ci[q] * pi, wi = cr[q] * pi + ci[q] * pr;
                const f32x4 b0 = sbr[4 * p], b1 = sbr[4 * p + 1], c0 = sbi[4 * p], c1 = sbi[4 * p + 1];
                acc[0] += wr * b0.x - wi * c0.x; acc[1] += wr * b0.y - wi * c0.y; acc[2] += wr * b0.z - wi * c0.z; acc[3] += wr * b0.w - wi * c0.w;
                acc[4] += wr * b1.x - wi * c1.x; acc[5] += wr * b1.y - wi * c1.y; acc[6] += wr * b1.z - wi * c1.z; acc[7] += wr * b1.w - wi * c1.w; }
        }
        if (tau == 0) {
#pragma unroll
            for (int j = 0; j < 8; ++j) if (8 * (kq & 1) + j == h) acc[j] += gptr(C.in[13])[l * 256 + g * 16 + h];
        }
        u32x4 o; o.x = pk2(acc[0], acc[1]); o.y = pk2(acc[2], acc[3]); o.z = pk2(acc[4], acc[5]); o.w = pk2(acc[6], acc[7]);
        *(u32x4*)((bf16_t*)(base + S5_TT) + ((size_t)(g * 16 + delta) * 64 + lane) * 8) = o;
        asm volatile("s_waitcnt lgkmcnt(0)" ::: "memory");
    } else if (r == 16) {
        const int p = lane; const S5C c = s5_consts(C, l, g, p);
        float ar, ai; s5_cpow(c, 1, ar, ai);
        const float w1r = ar * c.fr - ai * c.fi, w1i = ar * c.fi + ai * c.fr;
        bf16_t* BB = (bf16_t*)(base + S5_M1) + (size_t)g * 128 * 32;
        unsigned re[16], im[16];
#pragma unroll
        for (int h2 = 0; h2 < 8; ++h2) {
            const float x0 = bre[p * 16 + 2 * h2], y0 = bim[p * 16 + 2 * h2], x1 = bre[p * 16 + 2 * h2 + 1], y1 = bim[p * 16 + 2 * h2 + 1];
            re[h2] = pk2(w1r * x0 - w1i * y0, w1r * x1 - w1i * y1); im[h2] = pk2(w1r * y0 + w1i * x0, w1r * y1 + w1i * x1);
            re[8 + h2] = pk2(c.fr * x0 - c.fi * y0, c.fr * x1 - c.fi * y1); im[8 + h2] = pk2(c.fr * y0 + c.fi * x0, c.fr * y1 + c.fi * x1);
        }
        u32x4* d0 = (u32x4*)(BB + (size_t)p * 32); u32x4* d1 = (u32x4*)(BB + (size_t)(64 + p) * 32);
#pragma unroll
        for (int q = 0; q < 4; ++q) { d0[q] = (u32x4){re[4 * q], re[4 * q + 1], re[4 * q + 2], re[4 * q + 3]}; d1[q] = (u32x4){im[4 * q], im[4 * q + 1], im[4 * q + 2], im[4 * q + 3]}; }
    } else if (r == 17) {
        const int p = lane;
        bf16_t* CMp = (bf16_t*)(base + S5_M2P) + (size_t)g * 16 * 128;
        const int c0 = s5_m2col(p), c1 = s5_m2col(64 + p);
#pragma unroll
        for (int h = 0; h < 16; ++h) { CMp[h * 128 + c0] = f2bf(cre[h * 64 + p]); CMp[h * 128 + c1] = f2bf(-cim[h * 64 + p]); }
    } else {
        const int p = lane; const S5C c = s5_consts(C, l, g, p);
        float* A16 = (float*)(base + S5_AP16) + (size_t)g * S5_APS; float* A256 = (float*)(base + S5_AP256) + (size_t)g * 32 * 128;
        for (int cc = 0; cc <= 18; ++cc) { float pr, pi; s5_cpow(c, cc <= 16 ? 16 * cc : cc - 16, pr, pi); A16[cc * 128 + p] = pr; A16[cc * 128 + 64 + p] = pi; }
        for (int m = 0; m < 32; ++m) { float pr, pi; s5_cpow(c, 256 * m, pr, pi); A256[m * 128 + p] = pr; A256[m * 128 + 64 + p] = pi; }
    }
}

__device__ __forceinline__ float dpp_shr(float v, int d) {
    int r;
    if (d == 1) r = __builtin_amdgcn_update_dpp(0, __float_as_int(v), 0x111, 0xf, 0xf, true);
    else if (d == 2) r = __builtin_amdgcn_update_dpp(0, __float_as_int(v), 0x112, 0xf, 0xf, true);
    else if (d == 4) r = __builtin_amdgcn_update_dpp(0, __float_as_int(v), 0x114, 0xf, 0xf, true);
    else r = __builtin_amdgcn_update_dpp(0, __float_as_int(v), 0x118, 0xf, 0xf, true);
    return __int_as_float(r);
}
struct S5Wave { bf16x8 uf[8]; f32x4 X[8]; f32x4 ar[4], ai[4], wr[4], wi[4]; };
#define S5_CSQR(pr, pi) do { _Pragma("unroll") for (int mt_ = 0; mt_ < 4; ++mt_) { const f32x4 r_ = pr[mt_] * pr[mt_] - pi[mt_] * pi[mt_], i_ = 2.f * (pr[mt_] * pi[mt_]); pr[mt_] = r_; pi[mt_] = i_; } } while (0)
template <bool NEEDW> __device__ __forceinline__ void s5_E_scan(const Ctx& C, int l, int b, int k, int g, S5Wave& W) {
    const int lane = C.lane, cc = lane & 15, kq = lane >> 4;
    const unsigned char* base = C.ws + WS_S5 + (size_t)l * S5_LAYER;
    const bf16_t* ZS = (const bf16_t*)(C.ws + WS_ZS);
    const bf16_t* up = ZS + ((size_t)b * SEQ + 256 * k + 16 * cc + (kq >> 1)) * 256 + 16 * g + 8 * (kq & 1);
#pragma unroll
    for (int ks = 0; ks < 8; ++ks) W.uf[ks] = *(const bf16x8*)(up + (size_t)(2 * ks) * 256);
    const bf16_t* bbp = opaque((const bf16_t*)(base + S5_M1) + (size_t)g * 128 * 32 + (size_t)cc * 32 + 8 * kq);
    bf16x8 bb[8];
#pragma unroll
    for (int mt = 0; mt < 8; ++mt) bb[mt] = *(const bf16x8*)(bbp + (size_t)(16 * mt) * 32);
    const float* A1 = opaque((const float*)(base + S5_AP16) + (size_t)g * S5_APS + 17 * 128 + 4 * kq);
#pragma unroll
    for (int mt = 0; mt < 4; ++mt) { W.ar[mt] = *(const f32x4*)(A1 + 16 * mt); W.ai[mt] = *(const f32x4*)(A1 + 64 + 16 * mt); }
    f32x4 pr[4], pi[4];
#pragma unroll
    for (int mt = 0; mt < 4; ++mt) { pr[mt] = W.ar[mt]; pi[mt] = W.ai[mt]; }
    S5_CSQR(pr, pi);
#pragma unroll
    for (int mt = 0; mt < 8; ++mt) W.X[mt] = (f32x4){0.f, 0.f, 0.f, 0.f};
#pragma unroll
    for (int ks = 0; ks < 8; ++ks) {
        if (ks) {
#pragma unroll
            for (int mt = 0; mt < 4; ++mt) { const f32x4 re = W.X[mt], im = W.X[mt + 4]; W.X[mt] = pr[mt] * re - pi[mt] * im; W.X[mt + 4] = pr[mt] * im + pi[mt] * re; }
        }
#pragma unroll
        for (int mt = 0; mt < 8; ++mt) W.X[mt] = __builtin_amdgcn_mfma_f32_16x16x32_bf16(bb[mt], W.uf[ks], W.X[mt], 0, 0, 0);
    }
    S5_CSQR(pr, pi); S5_CSQR(pr, pi); S5_CSQR(pr, pi);
    if (NEEDW) {
#pragma unroll
        for (int mt = 0; mt < 4; ++mt) { W.wr[mt] = (f32x4){1.f, 1.f, 1.f, 1.f}; W.wi[mt] = (f32x4){0.f, 0.f, 0.f, 0.f}; } }
#pragma unroll
    for (int d = 1; d < 16; d <<= 1) {
#pragma unroll
        for (int mt = 0; mt < 4; ++mt) {
#pragma unroll
            for (int r = 0; r < 4; ++r) { const float sr = dpp_shr(W.X[mt][r], d), si = dpp_shr(W.X[mt + 4][r], d);
                W.X[mt][r] += pr[mt][r] * sr - pi[mt][r] * si; W.X[mt + 4][r] += pr[mt][r] * si + pi[mt][r] * sr; }
        }
        if (NEEDW) { const bool sel = (cc & d) != 0;
#pragma unroll
            for (int mt = 0; mt < 4; ++mt) { const f32x4 nr = W.wr[mt] * pr[mt] - W.wi[mt] * pi[mt], ni = W.wr[mt] * pi[mt] + W.wi[mt] * pr[mt];
#pragma unroll
                for (int r = 0; r < 4; ++r) { W.wr[mt][r] = sel ? nr[r] : W.wr[mt][r]; W.wi[mt][r] = sel ? ni[r] : W.wi[mt][r]; } } }
        if (d < 8) S5_CSQR(pr, pi);
    }
}
__device__ __forceinline__ void s5a_item(const Ctx& C, int l, int it) {
    const int g = it & 15, k = (it >> 4) & 31, b = it >> 9;
    S5Wave W; s5_E_scan<false>(C, l, b, k, g, W);
    if ((C.lane & 15) == 15) { float* F = (float*)(C.ws + WS_S5F) + ((size_t)((b * 32 + k) * 16 + g)) * 128 + 4 * (C.lane >> 4);
#pragma unroll
        for (int mt = 0; mt < 8; ++mt) *(f32x4*)(F + 16 * mt) = W.X[mt]; }
}
constexpr int S5_YSTRIDE = 528;
__device__ __forceinline__ void s5c_group(const Ctx& C0, int l, int b, int k, int g) {
    Ctx C = C0; asm volatile("; S5C_GROUP_BEGIN\n" : "+v"(C.lane));
    const int lane = C.lane, cc = lane & 15, kq = lane >> 4;
    const unsigned char* base = C.ws + WS_S5 + (size_t)l * S5_LAYER;
    f32x4 gr[4], gi[4];
#pragma unroll
    for (int mt = 0; mt < 4; ++mt) { gr[mt] = (f32x4){0.f, 0.f, 0.f, 0.f}; gi[mt] = (f32x4){0.f, 0.f, 0.f, 0.f}; }
    if (k > 0) {
        const float* F = opaque((const float*)(C.ws + WS_S5F) + ((size_t)(b * 32) * 16 + g) * 128 + 4 * kq);
        const float* A256 = opaque((const float*)(base + S5_AP256) + (size_t)g * 32 * 128 + 4 * kq);
#pragma unroll
        for (int rep = 0; rep < 2; ++rep) { const int kp = cc + 16 * rep;
            if (kp < k) { const float* f = opaque(F + (size_t)kp * 16 * 128); const float* w = opaque(A256 + (size_t)(k - 1 - kp) * 128);
#pragma unroll
                for (int mt = 0; mt < 4; ++mt) { const f32x4 fr = *(const f32x4*)(f + 16 * mt), fi = *(const f32x4*)(f + 64 + 16 * mt), wr = *(const f32x4*)(w + 16 * mt), wi = *(const f32x4*)(w + 64 + 16 * mt);
                    gr[mt] += wr * fr - wi * fi; gi[mt] += wr * fi + wi * fr; } } }
#pragma unroll
        for (int mt = 0; mt < 4; ++mt)
#pragma unroll
            for (int r = 0; r < 4; ++r) {
#pragma unroll
                for (int o = 1; o < 16; o <<= 1) { gr[mt][r] += __shfl_xor(gr[mt][r], o); gi[mt][r] += __shfl_xor(gi[mt][r], o); } }
    }
    S5Wave W; s5_E_scan<true>(C, l, b, k, g, W);
#pragma unroll
    for (int mt = 0; mt < 8; ++mt)
#pragma unroll
        for (int r = 0; r < 4; ++r) W.X[mt][r] = dpp_shr(W.X[mt][r], 1);
#pragma unroll
    for (int mt = 0; mt < 4; ++mt) { W.X[mt] += W.wr[mt] * gr[mt] - W.wi[mt] * gi[mt]; W.X[mt + 4] += W.wr[mt] * gi[mt] + W.wi[mt] * gr[mt]; }
    bf16x8 tt[16];
    const bf16_t* ttp = opaque((const bf16_t*)(base + S5_TT) + ((size_t)(g * 16) * 64 + lane) * 8);
#pragma unroll
    for (int d4 = 0; d4 < 4; ++d4) { if (d4) ttp = opaque(ttp + 4 * 64 * 8);
#pragma unroll
        for (int d = 0; d < 4; ++d) tt[4 * d4 + d] = *(const bf16x8*)(ttp + (size_t)d * 64 * 8); }
    bf16x8 cm[4];
    const bf16_t* cmp = opaque((const bf16_t*)(base + S5_M2P) + (size_t)g * 16 * 128 + (size_t)cc * 128 + 8 * kq);
#pragma unroll
    for (int ks = 0; ks < 4; ++ks) cm[ks] = *(const bf16x8*)(cmp + 32 * ks);
    f32x4 a1r[4], a1i[4];
    { const float* A1 = opaque((const float*)(base + S5_AP16) + (size_t)g * S5_APS + 17 * 128 + 4 * kq);
#pragma unroll
      for (int mt = 0; mt < 4; ++mt) { a1r[mt] = *(const f32x4*)(A1 + 16 * mt); a1i[mt] = *(const f32x4*)(A1 + 64 + 16 * mt); } }
    LAS unsigned char* yt = C.lds + (size_t)(16 * cc) * S5_YSTRIDE + (16 * g + 4 * kq) * 2;
#pragma unroll
    for (int jj = 0; jj < 16; jj += 2) {
        bf16x8 sf1[4], sf2[4];
#pragma unroll
        for (int mt = 0; mt < 4; ++mt) { const f32x4 re = W.X[mt], im = W.X[mt + 4]; W.X[mt] = a1r[mt] * re - a1i[mt] * im; W.X[mt + 4] = a1r[mt] * im + a1i[mt] * re; }
#pragma unroll
        for (int ks = 0; ks < 4; ++ks) { u32x4 w; w.x = pk2(W.X[2 * ks][0], W.X[2 * ks][1]); w.y = pk2(W.X[2 * ks][2], W.X[2 * ks][3]); w.z = pk2(W.X[2 * ks + 1][0], W.X[2 * ks + 1][1]); w.w = pk2(W.X[2 * ks + 1][2], W.X[2 * ks + 1][3]); sf1[ks] = __builtin_bit_cast(bf16x8, w); }
#pragma unroll
        for (int mt = 0; mt < 4; ++mt) { const f32x4 re = W.X[mt], im = W.X[mt + 4]; W.X[mt] = a1r[mt] * re - a1i[mt] * im; W.X[mt + 4] = a1r[mt] * im + a1i[mt] * re; }
#pragma unroll
        for (int ks = 0; ks < 4; ++ks) { u32x4 w; w.x = pk2(W.X[2 * ks][0], W.X[2 * ks][1]); w.y = pk2(W.X[2 * ks][2], W.X[2 * ks][3]); w.z = pk2(W.X[2 * ks + 1][0], W.X[2 * ks + 1][1]); w.w = pk2(W.X[2 * ks + 1][2], W.X[2 * ks + 1][3]); sf2[ks] = __builtin_bit_cast(bf16x8, w); }
        f32x4 acc1 = {0.f, 0.f, 0.f, 0.f}, acc2 = {0.f, 0.f, 0.f, 0.f};
#pragma unroll
        for (int ks = 0; ks < 4; ++ks) { acc1 = __builtin_amdgcn_mfma_f32_16x16x32_bf16(cm[ks], sf1[ks], acc1, 0, 0, 0); acc2 = __builtin_amdgcn_mfma_f32_16x16x32_bf16(cm[ks], sf2[ks], acc2, 0, 0, 0); }
#pragma unroll
        for (int ks = 0; ks <= jj / 2; ++ks) { acc1 = __builtin_amdgcn_mfma_f32_16x16x32_bf16(tt[jj - 2 * ks], W.uf[ks], acc1, 0, 0, 0); acc2 = __builtin_amdgcn_mfma_f32_16x16x32_bf16(tt[jj + 1 - 2 * ks], W.uf[ks], acc2, 0, 0, 0); }
        const unsigned long long w1 = (unsigned long long)pk2(gelu_tanh(acc1[0]), gelu_tanh(acc1[1])) | ((unsigned long long)pk2(gelu_tanh(acc1[2]), gelu_tanh(acc1[3])) << 32);
        const unsigned long long w2 = (unsigned long long)pk2(gelu_tanh(acc2[0]), gelu_tanh(acc2[1])) | ((unsigned long long)pk2(gelu_tanh(acc2[2]), gelu_tanh(acc2[3])) << 32);
        *(LAS unsigned long long*)(yt + jj * S5_YSTRIDE) = w1; *(LAS unsigned long long*)(yt + (jj + 1) * S5_YSTRIDE) = w2;
    }
}
__device__ __forceinline__ void s5c_glu(const Ctx& C0, int l, int b, int k) {
    Ctx C = C0; asm volatile("; S5C_GLU_BEGIN\n" : "+v"(C.lane));
    const int lane = C.lane, r32 = lane & 31, hi = lane >> 5, tok = 32 * C.wave + r32;
    const bf16_t* gtp = opaque((const bf16_t*)(C.ws + WS_GLU) + (size_t)l * 65536 + (size_t)lane * 8);
    const float* gb = gptr(C.in[15]) + l * 256;
    const LAS unsigned char* yrow = C.lds + (size_t)tok * S5_YSTRIDE;
    bf16x8 yf[16];
#pragma unroll
    for (int ks = 0; ks < 16; ++ks) yf[ks] = *(const LAS bf16x8*)(yrow + (16 * ks + 8 * hi) * 2);
    bf16_t* op = (bf16_t*)(C.ws + WS_O) + ((size_t)b * SEQ + 256 * k + tok) * D + 256 + 4 * hi;
    bf16x8 wa[16], wb[16];
#pragma unroll
    for (int ks = 0; ks < 16; ++ks) wa[ks] = *(const bf16x8*)(gtp + 512 * ks);
#pragma unroll
    for (int ng = 0; ng < 4; ++ng) {
        f32x16 z[2];
#pragma unroll
        for (int r = 0; r < 16; ++r) { z[0][r] = 0.f; z[1][r] = 0.f; }
        gtp = opaque(gtp + 16 * 512);
#pragma unroll
        for (int ks = 0; ks < 16; ++ks) wb[ks] = *(const bf16x8*)(gtp + 512 * ks);
#pragma unroll
        for (int ks = 0; ks < 16; ++ks) z[0] = __builtin_amdgcn_mfma_f32_32x32x16_bf16(wa[ks], yf[ks], z[0], 0, 0, 0);
        if (ng < 3) { gtp = opaque(gtp + 16 * 512);
#pragma unroll
            for (int ks = 0; ks < 16; ++ks) wa[ks] = *(const bf16x8*)(gtp + 512 * ks); }
#pragma unroll
        for (int ks = 0; ks < 16; ++ks) z[1] = __builtin_amdgcn_mfma_f32_32x32x16_bf16(wb[ks], yf[ks], z[1], 0, 0, 0);
        float ob[2][16]; float ss = 0.f;
#pragma unroll
        for (int m2 = 0; m2 < 2; ++m2)
#pragma unroll
            for (int q4 = 0; q4 < 4; ++q4) { const int ch = 32 * (2 * ng + m2) + 8 * q4 + 4 * hi;
                const unsigned long long yw = *(const LAS unsigned long long*)(yrow + ch * 2); const f32x4 bb = *(const f32x4*)(gb + ch);
                const float y0 = __uint_as_float((unsigned)yw << 16), y1 = __uint_as_float((unsigned)yw & 0xffff0000u), y2 = __uint_as_float((unsigned)(yw >> 32) << 16), y3 = __uint_as_float((unsigned)(yw >> 32) & 0xffff0000u);
                const float o0 = fast_sigmoid_mul(y0, z[m2][4 * q4] + bb[0]), o1 = fast_sigmoid_mul(y1, z[m2][4 * q4 + 1] + bb[1]), o2 = fast_sigmoid_mul(y2, z[m2][4 * q4 + 2] + bb[2]), o3 = fast_sigmoid_mul(y3, z[m2][4 * q4 + 3] + bb[3]);
                ob[m2][4 * q4] = o0; ob[m2][4 * q4 + 1] = o1; ob[m2][4 * q4 + 2] = o2; ob[m2][4 * q4 + 3] = o3; ss += (o0 * o0 + o1 * o1) + (o2 * o2 + o3 * o3); }
        ss += __shfl_xor(ss, 32);
        const float rn = 1.0f / sqrtf(ss * (1.f / 64.f) + EPS);
#pragma unroll
        for (int m2 = 0; m2 < 2; ++m2)
#pragma unroll
            for (int q4 = 0; q4 < 4; ++q4)
                *(unsigned long long*)(op + 64 * ng + 32 * m2 + 8 * q4) = (unsigned long long)pk2(ob[m2][4 * q4] * rn, ob[m2][4 * q4 + 1] * rn) | ((unsigned long long)pk2(ob[m2][4 * q4 + 2] * rn, ob[m2][4 * q4 + 3] * rn) << 32);
    }
}
__device__ __forceinline__ void s5c_item(const Ctx& C, int l, int it) {
    const int b = it >> 5, k = it & 31;
    REPEAT(22, s5c_group(C, l, b, k, 2 * C.wave); s5c_group(C, l, b, k, 2 * C.wave + 1));
    __syncthreads();
    REPEAT(23, s5c_glu(C, l, b, k));
    __syncthreads();
}

constexpr int SGU_VS = 576;
__device__ __forceinline__ void sgu_item(const Ctx& C, int l, int it) {
    const bf16_t* U = (const bf16_t*)(C.ws + WS_U); const bf16_t* V = (const bf16_t*)(C.ws + WS_V); bf16_t* O = (bf16_t*)(C.ws + WS_O);
    const float* gain = gptr(C.in[3]) + l * 256; const float* sgu_b = gptr(C.in[5]) + l * 512;
    const bf16_t* Wb = (const bf16_t*)(C.ws + WS_SGUW) + (size_t)l * 65536;
    const int tid = C.tid, lane = C.lane, r32 = lane & 31, hi = lane >> 5;
    const size_t t0 = (size_t)it * 128;
    {
        const int row = tid >> 2, qt = tid & 3;
        const u32x4* src = (const u32x4*)(V + (t0 + row) * 256 + qt * 64);
        u32x4 w[8]; float ss = 0.f;
#pragma unroll
        for (int i = 0; i < 8; ++i) { w[i] = src[i];
#pragma unroll
            for (int e = 0; e < 4; ++e) { const float a = __uint_as_float(w[i][e] << 16), b = __uint_as_float(w[i][e] & 0xffff0000u); ss += a * a + b * b; } }
        ss += __shfl_xor(ss, 1); ss += __shfl_xor(ss, 2);
        const float rs = 1.0f / sqrtf(ss * (1.f / 256.f) + EPS);
        LAS unsigned char* dst = C.lds + row * SGU_VS + qt * 128;
#pragma unroll
        for (int i = 0; i < 8; ++i) { const f32x4 g0 = *(const f32x4*)(gain + qt * 64 + 8 * i), g1 = *(const f32x4*)(gain + qt * 64 + 8 * i + 4);
            u32x4 o;
            o.x = pk2(__uint_as_float(w[i].x << 16) * rs * g0.x, __uint_as_float(w[i].x & 0xffff0000u) * rs * g0.y); o.y = pk2(__uint_as_float(w[i].y << 16) * rs * g0.z, __uint_as_float(w[i].y & 0xffff0000u) * rs * g0.w);
            o.z = pk2(__uint_as_float(w[i].z << 16) * rs * g1.x, __uint_as_float(w[i].z & 0xffff0000u) * rs * g1.y); o.w = pk2(__uint_as_float(w[i].w << 16) * rs * g1.z, __uint_as_float(w[i].w & 0xffff0000u) * rs * g1.w);
            *(LAS u32x4*)(dst + 16 * i) = o; }
    }
    __syncthreads();
    const int h = C.wave >> 1, ih = C.wave & 1;
    const int nks = ih ? 8 : 4;
    f32x16 acc[2][2];
#pragma unroll
    for (int mt = 0; mt < 2; ++mt)
#pragma unroll
        for (int nt = 0; nt < 2; ++nt)
#pragma unroll
            for (int r = 0; r < 16; ++r) acc[mt][nt][r] = 0.f;
    const int i16 = lane & 15;
    const LAS unsigned char* vb = C.lds + (8 * hi + (i16 >> 2)) * SGU_VS + (64 * h + 16 * ((lane >> 4) & 1) + 4 * (i16 & 3)) * 2;
    const bf16_t* wp = Wb + ((size_t)h * 128 + 64 * ih + r32) * 128 + 8 * hi;
    for (int ks = 0; ks < nks; ++ks) {
        bf16x8 af[2], bfr[2];
#pragma unroll
        for (int mt = 0; mt < 2; ++mt) { const s16x4 lo = ds_tr(vb + (16 * ks) * SGU_VS + 64 * mt), hi4 = ds_tr(vb + (16 * ks + 4) * SGU_VS + 64 * mt);
            af[mt] = (bf16x8){lo[0], lo[1], lo[2], lo[3], hi4[0], hi4[1], hi4[2], hi4[3]}; }
#pragma unroll
        for (int nt = 0; nt < 2; ++nt) bfr[nt] = *(const bf16x8*)(wp + (size_t)(32 * nt) * 128 + 16 * ks);
#pragma unroll
        for (int mt = 0; mt < 2; ++mt)
#pragma unroll
            for (int nt = 0; nt < 2; ++nt) acc[mt][nt] = __builtin_amdgcn_mfma_f32_32x32x16_bf16(af[mt], bfr[nt], acc[mt][nt], 0, 0, 0);
    }
#pragma unroll
    for (int nt = 0; nt < 2; ++nt) {
        const int i = 64 * ih + 32 * nt + r32; const float bias = sgu_b[h * 128 + i];
        const bf16_t* up = U + (t0 + i) * 256 + 64 * h + 4 * hi; bf16_t* op = O + (t0 + i) * D + 64 * h + 4 * hi;
        float ov[2][16]; float ss = 0.f;
#pragma unroll
        for (int mt = 0; mt < 2; ++mt)
#pragma unroll
            for (int q4 = 0; q4 < 4; ++q4) { const unsigned long long uw = *(const unsigned long long*)(up + 32 * mt + 8 * q4);
                const float u0 = __uint_as_float((unsigned)uw << 16), u1 = __uint_as_float((unsigned)uw & 0xffff0000u), u2 = __uint_as_float((unsigned)(uw >> 32) << 16), u3 = __uint_as_float((unsigned)(uw >> 32) & 0xffff0000u);
                const float o0 = u0 * (acc[mt][nt][4 * q4] + bias), o1 = u1 * (acc[mt][nt][4 * q4 + 1] + bias), o2 = u2 * (acc[mt][nt][4 * q4 + 2] + bias), o3 = u3 * (acc[mt][nt][4 * q4 + 3] + bias);
                ov[mt][4 * q4] = o0; ov[mt][4 * q4 + 1] = o1; ov[mt][4 * q4 + 2] = o2; ov[mt][4 * q4 + 3] = o3; ss += (o0 * o0 + o1 * o1) + (o2 * o2 + o3 * o3); }
        ss += __shfl_xor(ss, 32);
        const float rn = 1.0f / sqrtf(ss * (1.f / 64.f) + EPS);
#pragma unroll
        for (int mt = 0; mt < 2; ++mt)
#pragma unroll
            for (int q4 = 0; q4 < 4; ++q4)
                *(unsigned long long*)(op + 32 * mt + 8 * q4) = (unsigned long long)pk2(ov[mt][4 * q4] * rn, ov[mt][4 * q4 + 1] * rn) | ((unsigned long long)pk2(ov[mt][4 * q4 + 2] * rn, ov[mt][4 * q4 + 3] * rn) << 32);
    }
    __syncthreads();
}

__device__ __forceinline__ void route_block(const Ctx& C, int l, int it) {
    const float* bg = gptr(C.in[23]) + l * 4; const float* be = gptr(C.in[25]) + l * 16;
    unsigned* cnt = (unsigned*)(C.ws + WS_CTL) + (C.dry ? 2048 : CW_CNT + l * 32);
    int* m_bucket = (int*)(C.ws + WS_META + MT_BUCKET); int* m_pos = (int*)(C.ws + WS_META + MT_POS);
    float* m_gw0 = (float*)(C.ws + WS_META + MT_GW0); float* m_gw1 = (float*)(C.ws + WS_META + MT_GW1); float* m_rs = (float*)(C.ws + WS_META + MT_RS2);
    bf16_t* XB = (bf16_t*)(C.ws + WS_XB);
    LAS unsigned* hist = (LAS unsigned*)C.lds; LAS unsigned* hbase = hist + 32;
    const int lane = C.lane, r32 = lane & 31, hi = lane >> 5;
    if (C.tid < 32) hist[C.tid] = 0u;
    __syncthreads();
    int bk = 0, rank = 0; float glo = 0.f, ghi = 0.f, rs = 0.f; const int t = it * 128 + C.wave * 32 + r32;
    if (C.wave < 4) {
        const bf16_t* xbr = XB + (size_t)t * D + 8 * hi;
        const bf16_t* whp = opaque((const bf16_t*)(C.ws + WS_ROUTEW) + (size_t)l * 65536 + (size_t)lane * 8);
        f32x16 acc;
#pragma unroll
        for (int r = 0; r < 16; ++r) acc[r] = 0.f;
        for (int kb = 0; kb < 8; ++kb) {
            bf16x8 xh[8], wh[8], wl[8];
#pragma unroll
            for (int i = 0; i < 8; ++i) { const int ks = 8 * kb + i; xh[i] = *(const bf16x8*)(xbr + 16 * ks); wh[i] = *(const bf16x8*)(whp + 512 * ks); wl[i] = *(const bf16x8*)(whp + 32768 + 512 * ks); }
#pragma unroll
            for (int i = 0; i < 8; ++i) { acc = __builtin_amdgcn_mfma_f32_32x32x16_bf16(wh[i], xh[i], acc, 0, 0, 0); acc = __builtin_amdgcn_mfma_f32_32x32x16_bf16(wl[i], xh[i], acc, 0, 0, 0); }
        }
        rs = row_rstd((const float*)(C.ws + WS_SSQB), t);
        float mine[12], oth[12];
#pragma unroll
        for (int r = 0; r < 12; ++r) { mine[r] = acc[r]; oth[r] = __shfl_xor(acc[r], 32); }
        float lg[20];
#pragma unroll
        for (int q = 0; q < 5; ++q)
#pragma unroll
            for (int e = 0; e < 4; ++e) { const int n = 4 * q + e;
                const float v0 = ((q & 1) == 0) ? mine[4 * (q >> 1) + e] : oth[4 * (q >> 1) + e], v1 = ((q & 1) == 0) ? oth[4 * (q >> 1) + e] : mine[4 * (q >> 1) + e];
                lg[n] = (hi == 0 ? v0 : v1) * rs; }
        float gl[4]; int gt = 0;
#pragma unroll
        for (int i = 0; i < 4; ++i) gl[i] = lg[i] + bg[i];
        float gm = gl[0];
#pragma unroll
        for (int i = 1; i < 4; ++i) if (gl[i] > gm) { gm = gl[i]; gt = i; }
        float gs = 0.f;
#pragma unroll
        for (int i = 0; i < 4; ++i) gs += __expf(gl[i] - gm);
        const float pg = 1.f / gs;
        float el[4];
#pragma unroll
        for (int i = 0; i < 4; ++i) { float v = 0.f;
#pragma unroll
            for (int gi = 0; gi < 4; ++gi) v = (gi == gt) ? lg[4 + 4 * gi + i] + be[gi * 4 + i] : v;
            el[i] = v; }
        int i1 = 0; float m1 = el[0];
#pragma unroll
        for (int i = 1; i < 4; ++i) if (el[i] > m1) { m1 = el[i]; i1 = i; }
        int i2 = -1; float m2 = -3.0e38f;
#pragma unroll
        for (int i = 0; i < 4; ++i) if (i != i1 && el[i] > m2) { m2 = el[i]; i2 = i; }
        const float e2 = __expf(m2 - m1); const float w1 = 1.f / (1.f + e2), w2 = e2 / (1.f + e2);
        const int lo = i1 < i2 ? i1 : i2, hi2 = i1 < i2 ? i2 : i1;
        const int pi = (lo == 0) ? (hi2 - 1) : (lo == 1 ? hi2 + 1 : 5);
        bk = gt * 6 + pi;
        glo = pg * (i1 < i2 ? w1 : w2); ghi = pg * (i1 < i2 ? w2 : w1);
        if (hi == 0) rank = (int)atomicAdd((unsigned*)(hist + bk), 1u);
    }
    __syncthreads();
    if (C.tid < NBUCKET) { const unsigned n = hist[C.tid]; hbase[C.tid] = n ? atomicAdd(cnt + C.tid, n) : 0u; }
    __syncthreads();
    if (C.wave < 4 && hi == 0) { const size_t li = C.dry ? (size_t)(T * 24) + (size_t)(t & 1023) : (size_t)bk * T + hbase[bk] + rank;
        ((int*)(C.ws + WS_BLIST))[li] = t; ((float*)(C.ws + WS_BGW0))[li] = glo; ((float*)(C.ws + WS_BGW1))[li] = ghi; ((float*)(C.ws + WS_BRS))[li] = rs; }
    __syncthreads();
}
__device__ __forceinline__ void phase_perm(const Ctx& C, int l) {
    const unsigned* cnt = (const unsigned*)(C.ws + WS_CTL) + CW_CNT + l * 32; unsigned* tileb = (unsigned*)(C.ws + WS_CTL) + CW_TILEB + l * 160;
    const int* m_bucket = (const int*)(C.ws + WS_META + MT_BUCKET); const int* m_pos = (const int*)(C.ws + WS_META + MT_POS);
    const float* m_gw0 = (const float*)(C.ws + WS_META + MT_GW0); const float* m_gw1 = (const float*)(C.ws + WS_META + MT_GW1); const float* m_rs = (const float*)(C.ws + WS_META + MT_RS2);
    const bf16_t* XB = (const bf16_t*)(C.ws + WS_XB); bf16_t* XS = (bf16_t*)(C.ws + WS_XS); int* stok = (int*)(C.ws + WS_META + MT_STOK) + l * MAXROWS;
    float* sgw0 = (float*)(C.ws + WS_META + MT_SGW0); float* sgw1 = (float*)(C.ws + WS_META + MT_SGW1); float* srs = (float*)(C.ws + WS_META + MT_SRS);
    const int lane = C.lane;
    int nt = (lane < NBUCKET) ? (((int)cnt[lane] + 255) >> 8) : 0, incl = nt;
#pragma unroll
    for (int o = 1; o < 32; o <<= 1) { const int v = __shfl_up(incl, o); if (lane >= o) incl += v; }
    const int excl = incl - nt;
    if (C.gw == 0) { if (lane < NBUCKET) for (int i = 0; i < nt; ++i) tileb[excl + i] = (unsigned)lane; if (lane == NBUCKET - 1) tileb[159] = (unsigned)incl; }
    for (int t = C.gw * 4; t < T; t += C.ngw * 4) {
        int dst[4]; u32x4 v[4][2];
#pragma unroll
        for (int j = 0; j < 4; ++j) { const int bk = m_bucket[t + j]; dst[j] = __shfl(excl, bk) * 256 + m_pos[t + j];
            const u32x4* src = (const u32x4*)(XB + (size_t)(t + j) * D) + lane; v[j][0] = src[0]; v[j][1] = src[64]; }
#pragma unroll
        for (int j = 0; j < 4; ++j) { u32x4* d = (u32x4*)(XS + (size_t)dst[j] * D) + lane; d[0] = v[j][0]; d[64] = v[j][1];
            if (lane == 0) { stok[dst[j]] = t + j; sgw0[dst[j]] = m_gw0[t + j]; sgw1[dst[j]] = m_gw1[t + j]; srs[dst[j]] = m_rs[t + j]; } }
    }
}

__device__ __forceinline__ void phase_prologue(const Ctx& C) {
    LAS float* scr = (LAS float*)(C.lds + C.wave * 16896);
    { const int l = 0; REPEAT(101, phase_prep_weights(C, scr)); }
    { const int l = 0; REPEAT(102, for (int it = C.gw; it < S5_ITEMS; it += C.ngw) s5_prep_item(C, it, scr)); }
    { bf16_t* rw = (bf16_t*)(C.ws + WS_ROUTEW);
      for (int i = C.gw * 64 + C.lane; i < DEPTH * 32 * D; i += C.ngw * 64) { const int l = i / (32 * D), n = (i / D) & 31, k = i & (D - 1);
          float v = 0.f;
          if (n < 4) v = gptr(C.in[22])[((size_t)l * D + k) * 4 + n]; else if (n < 20) v = gptr(C.in[24])[(((size_t)l * 4 + ((n - 4) >> 2)) * D + k) * 4 + ((n - 4) & 3)];
          v *= gptr(C.in[21])[l * D + k];
          const bf16_t h = f2bf(v); const size_t fo = (size_t)l * 65536 + (size_t)(((k >> 4) * 64 + ((k >> 3) & 1) * 32 + n) * 8 + (k & 7));
          rw[fo] = h; rw[fo + 32768] = f2bf(v - bf2f(h)); } }
    { const float* sw = gptr(C.in[4]); bf16_t* dw = (bf16_t*)(C.ws + WS_SGUW);
      for (int i = C.gw * 64 + C.lane; i < DEPTH * 65536 / 2; i += C.ngw * 64) ((unsigned*)dw)[i] = pk2(sw[2 * i], sw[2 * i + 1]); }
    { const int l = 0; REPEAT(103, phase_conv(C, gptr(C.in[0]))); }
}


#define XB_TMO      128
#define XB_XCNT(j)  (256  + 64 * (j))
#define XB_XSUB(j)  (1280 + 64 * (j))
#define XB_XGEN(j)  (2304 + 64 * (j))
#define XB_TOP      3328
#define XB_TOPGEN   3392
#define XCD_BAR_WORDS 3456
#define XB_SPIN_CAP (1u << 18)

__device__ __forceinline__ unsigned xb_ld(unsigned* p)              { return __hip_atomic_load(p, __ATOMIC_RELAXED, __HIP_MEMORY_SCOPE_AGENT); }
__device__ __forceinline__ unsigned xb_add(unsigned* p, unsigned v) { return __hip_atomic_fetch_add(p, v, __ATOMIC_RELAXED, __HIP_MEMORY_SCOPE_AGENT); }
__device__ __forceinline__ unsigned xb_xcc_id() { return (unsigned)__builtin_amdgcn_s_getreg((3 << 11) | 20) & 0xFu; }
#define XB_SPIN(cond, bar) do { unsigned _sp = 0; while (cond) { __builtin_amdgcn_s_sleep(1); \
    if ((++_sp & 255u) == 0u) { if (xb_ld(&(bar)[XB_TMO])) break; if (_sp > XB_SPIN_CAP) { atomicAdd(&(bar)[XB_TMO], 1u); break; } } } } while (0)

struct XcdBarrier {
    unsigned* bar; unsigned x;
    volatile LAS unsigned* st;
};

__device__ __forceinline__ XcdBarrier xcd_barrier_post(unsigned* bar, volatile LAS unsigned* st) {
    XcdBarrier b; b.bar = bar; b.x = xb_xcc_id(); b.st = st;
    if (threadIdx.x == 0) (void)xb_add(&bar[XB_XCNT(b.x)], 1u);
    return b;
}
__device__ __forceinline__ void xcd_barrier_complete(unsigned* bar, unsigned x, unsigned& nloc, unsigned& nx) {
    const unsigned G = gridDim.x * gridDim.y * gridDim.z;
    unsigned sum, cnt, mine, sp = 0u;
    for (;;) {
        sum = 0u; cnt = 0u; mine = 0u;
#pragma unroll
        for (unsigned j = 0; j < 16; ++j) { const unsigned c = xb_ld(&bar[XB_XCNT(j)]); sum += c; cnt += (c > 0u) ? 1u : 0u; mine = (j == x) ? c : mine; }
        if (sum == G) break;
        __builtin_amdgcn_s_sleep(1);
        if ((++sp & 255u) == 0u) { if (xb_ld(&bar[XB_TMO])) break; if (sp > XB_SPIN_CAP) { atomicAdd(&bar[XB_TMO], 1u); break; } }
    }
    nloc = mine > 0u ? mine : 1u; nx = cnt > 0u ? cnt : 1u;
}

__device__ __forceinline__ void xcd_barrier(const XcdBarrier& b) {
    asm volatile("s_waitcnt vmcnt(0)" ::: "memory");
    __syncthreads();
    if (threadIdx.x == 0) {
        unsigned* bar = b.bar;
        __builtin_amdgcn_s_waitcnt(0);
        unsigned nloc = b.st[0], nx = b.st[1];
        if (nloc == 0u) { xcd_barrier_complete(bar, b.x, nloc, nx); b.st[0] = nloc; b.st[1] = nx; }
        const unsigned old = xb_add(&bar[XB_XSUB(b.x)], 1u);
        const unsigned gen = old / nloc;
        if (old + 1u == (gen + 1u) * nloc) {
            __builtin_amdgcn_fence(__ATOMIC_RELEASE, "agent");
            asm volatile("s_waitcnt vmcnt(0)" ::: "memory");
            const unsigned og = xb_add(&bar[XB_TOP], 1u);
            const unsigned tg = og / nx;
            if (og + 1u == (tg + 1u) * nx) xb_add(&bar[XB_TOPGEN], 1u);
            else XB_SPIN(xb_ld(&bar[XB_TOPGEN]) == tg, bar);
            __builtin_amdgcn_fence(__ATOMIC_ACQUIRE, "agent");
            xb_add(&bar[XB_XGEN(b.x)], 1u);
            asm volatile("s_waitcnt vmcnt(0)" ::: "memory");
        } else {
            XB_SPIN(xb_ld(&bar[XB_XGEN(b.x)]) == gen, bar);
            __builtin_amdgcn_fence(__ATOMIC_ACQUIRE, "agent");
            asm volatile("s_waitcnt vmcnt(0)" ::: "memory");
        }
    }
    __syncthreads();
}

constexpr int PH_PER_LAYER = 7, N_PHASES = 1 + DEPTH * PH_PER_LAYER;
__global__ void __launch_bounds__(NTHREADS, 2) mk_fwd(KArgs args) {
    extern __shared__ __attribute__((aligned(16))) unsigned char lds_raw[];
    const int lo = args.ph_lo, hi = args.ph_hi;
    const int wave_s = __builtin_amdgcn_readfirstlane(threadIdx.x >> 6);
    if (threadIdx.x < 16) ((LAS unsigned*)(lds_raw + LDS_BARW))[threadIdx.x] = 0u;
    __syncthreads();
    cg::this_grid().sync();
    XcdBarrier bar = xcd_barrier_post((unsigned*)(args.ws + WS_CTL) + CW_BAR, (volatile LAS unsigned*)((LAS unsigned char*)lds_raw + LDS_BARW));
    int reps_left = REP_N - 1;
    for (int ph = lo; ph < hi; ++ph) {
        unsigned ones = ~0u; asm volatile("" : "+s"(ones));
        int tid = wave_s * 64 + (int)__builtin_amdgcn_mbcnt_hi(ones, __builtin_amdgcn_mbcnt_lo(ones, 0u)); asm volatile("" : "+v"(tid));
        GAS unsigned char* wsg = (GAS unsigned char*)args.ws; asm volatile("" : "+s"(wsg)); unsigned char* ws = (unsigned char*)wsg;
        Ctx C;
        C.lds = (LAS unsigned char*)lds_raw;
        C.in = args.in; { GAS float* og = (GAS float*)args.out; asm volatile("" : "+s"(og)); C.out = (float*)og; } C.ws = ws;
        C.tid = tid; C.lane = tid & 63; C.wave = __builtin_amdgcn_readfirstlane(tid >> 6);
        C.G = gridDim.x; C.gw = blockIdx.x * NWAVES + C.wave; C.ngw = C.G * NWAVES; C.dry = (ph == REP_PH && reps_left > 0);
        if (ph == 0) { const int l = 0; REPEAT(100, phase_prologue(C)); }
        else {
            const int l = (ph - 1) / PH_PER_LAYER, k = (ph - 1) % PH_PER_LAYER;
            const float* xres = (l == 0) ? gptr(args.in[0]) : (const float*)C.out;
            const unsigned* tileb = (const unsigned*)(ws + WS_CTL) + CW_TILEB + l * 160;
            if (k == 0) {
                if (l > 0) {
                    const float* ssqp = (const float*)(ws + WS_SSQP); float* rstd = (float*)(ws + WS_META + MT_RSTD);
                    for (int r0 = C.gw * 4; r0 < T; r0 += C.ngw * 4) { const int row = r0 + (C.lane >> 4); float v = ssqp[(size_t)row * 16 + (C.lane & 15)];
#pragma unroll
                        for (int o = 1; o < 16; o <<= 1) v += __shfl_xor(v, o);
                        if ((C.lane & 15) == 0) rstd[row] = 1.0f / sqrtf(v * (1.f / D) + EPS); }
                    xcd_barrier(bar);
                }
                DenseSched S; S.init(ws + WS_XB, (const bf16_t*)(ws + WS_WIN) + (size_t)l * NIN * D, T, NIN, D, C.G, (int)blockIdx.x);
                EpiIn E{(const float*)(ws + WS_META + MT_RSTD), (bf16_t*)(ws + WS_U), (bf16_t*)(ws + WS_QH), gptr(args.in[16]) + l * 64, gptr(args.in[17]) + l * 64};
                REPEAT(0, (pg8::gemm_phase<EpiIn, DenseSched, true, true>(C.lds, D, S, E, C.tid)));
            } else if (k == 1) {
                REPEAT(10, for (int it = C.gw; it < BATCH * 32 * 16; it += C.ngw) s5a_item(C, l, it));
                const int bxv = ((C.G & 7) == 0) ? ((int)blockIdx.x & 7) * (C.G >> 3) + ((int)blockIdx.x >> 3) : (int)blockIdx.x;
                REPEAT(11, phase_attn(C, l, bxv, C.G, 3));
            } else if (k == 2) {
                const int half = C.G >> 1;
                if ((int)blockIdx.x < half) { REPEAT(21, for (int it = blockIdx.x; it < BATCH * 32; it += half) s5c_item(C, l, it)); }
                else { const int bx = (int)blockIdx.x - half;
                    REPEAT(20, for (int it = bx; it < T / 128; it += half) sgu_item(C, l, it));
                    const int bxv = ((half & 7) == 0) ? (bx & 7) * (half >> 3) + (bx >> 3) : bx, rest = BATCH * NH * (SEQ / 256) - 3 * C.G;
                    phase_attn(C, l, 3 * C.G + bxv, half, rest > 0 ? (rest + half - 1) / half : 0); }
            } else if (k == 3) {
                DenseSched S; S.init(ws + WS_O, (const bf16_t*)(ws + WS_WOUT) + (size_t)l * D * D, T, D, D, C.G, (int)blockIdx.x);
                EpiOut E{(bf16_t*)(ws + WS_XB), (float*)(ws + WS_SSQB), C.dry ? (size_t)((WS_XS - WS_XB) / 2) : (size_t)0};
                REPEAT(3, (pg8::gemm_phase<EpiOut, DenseSched, true, true>(C.lds, D, S, E, C.tid)));
            } else if (k == 4) {
                for (int it = blockIdx.x; it < T / 128; it += C.G) route_block(C, l, it);
            } else if (k == 5) {
                build_tile_table(C, l);
                TileTab tt{(const LAS int*)(C.lds + TB_OFF)};
                GroupSched S{(const char*)(ws + WS_XB), (const char*)((const bf16_t*)(ws + WS_WGU) + (size_t)l * 16 * 512 * D), tt, (const int*)(ws + WS_BLIST), tt.ntiles(), C.G, (int)blockIdx.x, 1, (size_t)0};
                EpiG1 E{tt, (const float*)(ws + WS_BGW0), (const float*)(ws + WS_BGW1), (const float*)(ws + WS_BRS), (bf16_t*)(ws + WS_H)};
                REPEAT(6, (pg8::gemm_phase<EpiG1, GroupSched, true, true, true>(C.lds, D, S, E, C.tid)));
            } else {
                build_tile_table(C, l);
                TileTab tt{(const LAS int*)(C.lds + TB_OFF)};
                GroupSched S{(const char*)(ws + WS_H), (const char*)((const bf16_t*)(ws + WS_WDN) + (size_t)l * NBUCKET * D * 512), tt, (const int*)(ws + WS_BLIST), tt.ntiles(), C.G, (int)blockIdx.x, 2, (size_t)256 * 512 * 2};
                if (l + 1 < DEPTH) { EpiG2<true> E{tt, (const int*)(ws + WS_BLIST), C.out, (bf16_t*)(ws + WS_XB), (float*)(ws + WS_SSQP), C.dry ? (size_t)((WS_XS - WS_XB) / 2) : (size_t)0};
                    pg8::gemm_phase<EpiG2<true>, GroupSched, true, true>(C.lds, 512, S, E, C.tid); }
                else { EpiG2<false> E{tt, (const int*)(ws + WS_BLIST), C.out, (bf16_t*)(ws + WS_XB), nullptr, (size_t)0};
                    pg8::gemm_phase<EpiG2<false>, GroupSched, true, true>(C.lds, 512, S, E, C.tid); }
            }
        }
        if (ph == REP_PH && reps_left > 0) { --reps_left; --ph; }
        if (ph + 1 < hi) xcd_barrier(bar);
    }
}

extern "C" void kernel_launch(void* const* d_in, const int* in_sizes, int n_in, void* d_out, int out_size, void* d_ws, size_t ws_size, hipStream_t stream) {
    static int grid = 0;
    if (grid == 0) {
        if (n_in != 29 || ws_size < WS_END) { fprintf(stderr, "kernel_launch: unexpected inputs (n_in %d, ws %zu)\n", n_in, ws_size); grid = -1; return; }
        int dev = 0, cus = 0, per_cu = 0;
        (void)hipGetDevice(&dev); (void)hipDeviceGetAttribute(&cus, hipDeviceAttributeMultiprocessorCount, dev);
        if (hipFuncSetAttribute((const void*)mk_fwd, hipFuncAttributeMaxDynamicSharedMemorySize, LDS_BYTES) != hipSuccess) { fprintf(stderr, "kernel_launch: hipFuncSetAttribute failed\n"); grid = -1; return; }
        if (hipOccupancyMaxActiveBlocksPerMultiprocessor(&per_cu, (const void*)mk_fwd, NTHREADS, LDS_BYTES) != hipSuccess || per_cu < 1) { fprintf(stderr, "kernel_launch: occupancy query says %d blocks/CU\n", per_cu); per_cu = 1; }
        (void)hipGetLastError();
        grid = cus * (per_cu > 1 ? 1 : per_cu);
        fprintf(stderr, "kernel_launch: grid %d (cus %d, per_cu %d)\n", grid, cus, per_cu);
    }
    if (grid < 0) return;
    (void)hipMemsetAsync((char*)d_ws + WS_CTL, 0, 1 * MiB, stream);
    KArgs a{};
    for (int i = 0; i < 29; ++i) a.in[i] = (const float*)d_in[i];
    a.out = (float*)d_out; a.ws = (unsigned char*)d_ws;
#if MK_ONE_LAUNCH
    a.ph_lo = 0; a.ph_hi = N_PHASES;
    void* kargs[] = {&a};
    hipError_t e = hipLaunchCooperativeKernel((const void*)mk_fwd, dim3(grid), dim3(NTHREADS), kargs, LDS_BYTES, stream);
    if (e != hipSuccess) fprintf(stderr, "cooperative launch failed: %s (grid %d)\n", hipGetErrorString(e), grid);
#else
    for (int p = 0; p < N_PHASES - 1; ++p) { a.ph_lo = p; a.ph_hi = p + 1; hipLaunchKernelGGL(mk_fwd, dim3(grid), dim3(NTHREADS), LDS_BYTES, stream, a); }
#endif
}
```

```cpp
#include <hip/hip_runtime.h>
#include <hip/hip_cooperative_groups.h>
#include <cstdint>
#include <cstdio>
namespace cg = cooperative_groups;

#ifndef MK_ONE_LAUNCH
#define MK_ONE_LAUNCH 1
#endif

namespace pg8 {
#define PG8_LAS __attribute__((address_space(3)))
typedef unsigned short bf16_t;
typedef short bf16x8 __attribute__((ext_vector_type(8)));
typedef float f32x4 __attribute__((ext_vector_type(4)));
typedef unsigned u32x4 __attribute__((ext_vector_type(4)));
constexpr int BM = 256, BK = 64, HALF = 128, HTB = HALF * BK * 2  , STAGE_BYTES = 8 * HTB, NXCD = 8, WGM = 8;
__host__ __device__ __forceinline__ int lds_byte(int r, int c) { const int st = (r >> 4) * 2 + (c >> 5), rr = r & 15, cc = c & 31, ob = rr * 64 + cc * 2; return st * 1024 + (ob ^ (((ob >> 9) & 1) << 5)); }
__host__ __device__ __forceinline__ void stage_rc(int b, int& R, int& C) { const int st = b / 1024, sb = b % 1024, swz = sb ^ (((sb >> 9) & 1) << 5); R = (st >> 1) * 16 + swz / 64; C = (st & 1) * 32 + (swz % 64) / 2; }
__host__ __device__ __forceinline__ int perm32(int rho) { const int n = rho >> 4, i = rho & 15; return 8 * (i >> 2) + 4 * n + (i & 3); }
struct Unit { int pm, pn, hf; };
__device__ __forceinline__ unsigned cvt_pk_bf16(float lo, float hi) { unsigned r; asm volatile("v_cvt_pk_bf16_f32 %0, %1, %2" : "=v"(r) : "v"(lo), "v"(hi)); return r; }
template <class Epi, class Sched, bool ALIGN_EPI = false, bool SP2 = false, bool GATHER = false>
__device__ __forceinline__ void gemm_phase(PG8_LAS unsigned char* lds, const int gK, const Sched& S, const Epi& E, const int tid) {
    const int wid = __builtin_amdgcn_readfirstlane(tid >> 6), lane = tid & 63, wr = wid >> 2, wc = wid & 3, fr = lane & 15, fq = lane >> 4;
    const int K = gK, nt = K / BK;
    unsigned voffA[2], voffB[2];
#pragma unroll
    for (int i = 0; i < 2; ++i) { int R, C; stage_rc(tid * 16 + i * 8192, R, C); const int Rb = Epi::PERM ? ((R & ~31) + perm32(R & 31)) : R;
        voffA[i] = (unsigned)(R * K + C) * 2u; voffB[i] = (unsigned)(Rb * K + C) * 2u; }
    unsigned gA[2], gN[2], gcol[2];
    if constexpr (GATHER) { _Pragma("unroll") for (int i = 0; i < 2; ++i) { int R_, C_; stage_rc(tid * 16 + i * 8192, R_, C_); gcol[i] = (unsigned)C_ * 2u; } }
#define PG8_GLOAD(dst, unit) do { _Pragma("unroll") for (int _h = 0; _h < 2; ++_h) { int R0_, R1_, C_; stage_rc(tid * 16, R0_, C_); stage_rc(tid * 16 + 8192, R1_, C_); \
        dst[_h] = (unsigned)S.a_row(unit, R0_ + 128 * _h) | ((unsigned)S.a_row(unit, R1_ + 128 * _h) << 16); } } while (0)
#define PG8_STAGE_A(bufoff, gbase, half, isnext) do { if constexpr (GATHER) { const unsigned g_ = (isnext) ? gN[half] : gA[half]; \
            unsigned vv_[2] = {(g_ & 0xffffu) * (unsigned)(K * 2) + gcol[0], (g_ >> 16) * (unsigned)(K * 2) + gcol[1]}; PG8_STAGE(bufoff, gbase, vv_); } \
        else { PG8_STAGE(bufoff, (gbase) + (half) * hstep, voffA); } } while (0)
    const size_t kstep = (size_t)(BK * 2);
    const size_t hstep = (size_t)HALF * K * 2;
    const unsigned ldsw = (unsigned)wid * 1024u;
    const int aoff = lds_byte(wr * 64 + fr, fq * 8), boff = lds_byte(wc * 32 + fr, fq * 8);
#define PG8_SA(b, h) (((b) * 2 + (h)) * HTB)
#define PG8_SB(b, h) ((4 + (b) * 2 + (h)) * HTB)
#define PG8_STAGE(bufoff, gbase, voff) do { _Pragma("unroll") for (int _i = 0; _i < 2; ++_i) \
        __builtin_amdgcn_global_load_lds((const unsigned*)((const char*)(gbase) + (voff)[_i]), (PG8_LAS unsigned*)(lds + (bufoff) + ldsw + _i * 8192), 16, 0, 0); } while (0)
#define PG8_LDA(dst, b, h) do { _Pragma("unroll") for (int m = 0; m < 4; ++m) _Pragma("unroll") for (int k = 0; k < 2; ++k) dst[m][k] = *(const PG8_LAS bf16x8*)(lds + PG8_SA(b, h) + aoff + m * 2048 + k * 1024); } while (0)
#define PG8_LDB(dst, b, h) do { _Pragma("unroll") for (int n = 0; n < 2; ++n) _Pragma("unroll") for (int k = 0; k < 2; ++k) dst[n][k] = *(const PG8_LAS bf16x8*)(lds + PG8_SB(b, h) + boff + n * 2048 + k * 1024); } while (0)
#define PG8_MMA(ai, bj, At, Bt) do { __builtin_amdgcn_s_setprio(1); _Pragma("unroll") for (int m = 0; m < 4; ++m) _Pragma("unroll") for (int n = 0; n < 2; ++n) _Pragma("unroll") for (int k = 0; k < 2; ++k) \
        acc[ai][bj][m][n] = __builtin_amdgcn_mfma_f32_16x16x32_bf16(Bt[n][k], At[m][k], acc[ai][bj][m][n], 0, 0, 0); __builtin_amdgcn_s_setprio(0); } while (0)
#define PG8_WAIT_V(n) asm volatile("s_waitcnt vmcnt(" #n ")" ::: "memory")
#define PG8_WAIT_L(n) asm volatile("s_waitcnt lgkmcnt(" #n ")" ::: "memory")
#define PG8_BAR __builtin_amdgcn_s_barrier()
#define PG8_SCHED __builtin_amdgcn_sched_barrier(0)
    Unit cur, nxt; int ui = 0;
    if (!S.next(0, cur)) return;
    f32x4 acc[2][2][4][2];
#pragma unroll
    for (int a = 0; a < 2; ++a)
#pragma unroll
        for (int b = 0; b < 2; ++b)
#pragma unroll
            for (int m = 0; m < 4; ++m)
#pragma unroll
                for (int n = 0; n < 2; ++n) acc[a][b][m][n] = (f32x4){0.f, 0.f, 0.f, 0.f};
    bf16x8 At[4][2], B0[2][2], B1[2][2];
    const char* cA = S.a_base(cur); const char* cB = S.b_base(cur);
    S.a_ready(cur);
    if constexpr (GATHER) PG8_GLOAD(gA, cur);
    if constexpr (SP2) {
        PG8_STAGE(PG8_SB(0, 0), cB, voffB); PG8_STAGE(PG8_SB(0, 1), cB + hstep, voffB); PG8_STAGE_A(PG8_SA(0, 0), cA, 0, false); PG8_STAGE_A(PG8_SA(0, 1), cA, 1, false);
        if (wr == 1) PG8_BAR;
        PG8_WAIT_V(2); PG8_BAR;
        PG8_STAGE(PG8_SB(1, 0), cB + kstep, voffB); PG8_STAGE_A(PG8_SA(1, 0), cA + kstep, 0, false); PG8_STAGE(PG8_SB(1, 1), cB + hstep + kstep, voffB);
        PG8_WAIT_V(6); PG8_BAR;
    } else {
        PG8_STAGE(PG8_SB(0, 0), cB, voffB); PG8_STAGE(PG8_SA(0, 0), cA, voffA); PG8_STAGE(PG8_SB(0, 1), cB + hstep, voffB); PG8_STAGE(PG8_SA(0, 1), cA + hstep, voffA);
        if (wr == 1) PG8_BAR;
        PG8_WAIT_V(4); PG8_BAR;
        PG8_STAGE(PG8_SB(1, 0), cB + kstep, voffB); PG8_STAGE(PG8_SA(1, 0), cA + kstep, voffA); PG8_STAGE(PG8_SB(1, 1), cB + hstep + kstep, voffB);
        PG8_WAIT_V(6); PG8_BAR;
    }
    for (;;) {
        const bool has_next = S.next(ui + 1, nxt);
        if constexpr (GATHER) { if (has_next) { PG8_GLOAD(gN, nxt); asm volatile("s_waitcnt vmcnt(0)" ::: "memory");
            asm volatile("" : "+v"(gN[0]), "+v"(gN[1])); } }
        const char* nA = has_next ? S.a_base(nxt) : cA; const char* nB = has_next ? S.b_base(nxt) : cB;
        for (int t = 0; t < nt; t += 2) {
            const bool last = (t == nt - 2); const bool lastnext = last && has_next; (void)lastnext; const bool fullu = (cur.hf == 0);
            const char* a1 = cA + (size_t)(t + 1) * kstep;
            const char* a2 = last ? nA : cA + (size_t)(t + 2) * kstep; const char* b2 = last ? nB : cB + (size_t)(t + 2) * kstep;
            const char* a3 = a2 + kstep; const char* b3 = b2 + kstep;
            if (last && has_next) S.a_ready(nxt);
            if constexpr (SP2) {
            PG8_LDB(B0, 0, 0); PG8_LDB(B1, 0, 1); PG8_SCHED; PG8_LDA(At, 0, 0); PG8_STAGE_A(PG8_SA(1, 1), a1, 1, false);
            PG8_WAIT_V(8); PG8_WAIT_L(0); PG8_BAR; PG8_MMA(0, 0, At, B0); PG8_MMA(0, 1, At, B1); PG8_BAR; PG8_SCHED;
            PG8_LDA(At, 0, 1); PG8_STAGE(PG8_SB(0, 0), b2, voffB); PG8_STAGE(PG8_SB(0, 1), b2 + hstep, voffB); PG8_STAGE_A(PG8_SA(0, 0), a2, 0, lastnext);
            PG8_WAIT_V(8); PG8_WAIT_L(0); PG8_BAR; if (fullu) { PG8_MMA(1, 0, At, B0); PG8_MMA(1, 1, At, B1); } PG8_BAR; PG8_SCHED;
            PG8_LDB(B0, 1, 0); PG8_LDB(B1, 1, 1); PG8_SCHED; PG8_LDA(At, 1, 0); PG8_STAGE_A(PG8_SA(0, 1), a2, 1, lastnext);
            PG8_WAIT_V(8); PG8_WAIT_L(0); PG8_BAR; PG8_MMA(0, 0, At, B0); PG8_MMA(0, 1, At, B1); PG8_BAR; PG8_SCHED;
            PG8_LDA(At, 1, 1); PG8_STAGE(PG8_SB(1, 0), b3, voffB); PG8_STAGE(PG8_SB(1, 1), b3 + hstep, voffB); PG8_STAGE_A(PG8_SA(1, 0), a3, 0, lastnext);
            PG8_WAIT_V(8); PG8_WAIT_L(0); PG8_BAR; if (fullu) { PG8_MMA(1, 0, At, B0); PG8_MMA(1, 1, At, B1); } PG8_BAR; PG8_SCHED;
            } else {
            PG8_LDB(B0, 0, 0); PG8_SCHED; PG8_LDA(At, 0, 0); PG8_STAGE(PG8_SA(1, 1), a1 + hstep, voffA);
            PG8_WAIT_L(8); PG8_BAR; PG8_WAIT_L(0); PG8_MMA(0, 0, At, B0); PG8_BAR; PG8_SCHED;
            PG8_LDB(B1, 0, 1); PG8_STAGE(PG8_SB(0, 0), b2, voffB);
            PG8_BAR; PG8_WAIT_L(0); PG8_MMA(0, 1, At, B1); PG8_BAR;
            PG8_LDA(At, 0, 1); PG8_STAGE(PG8_SA(0, 0), a2, voffA);
            PG8_BAR; PG8_WAIT_L(0); PG8_MMA(1, 0, At, B0); PG8_BAR; PG8_SCHED;
            PG8_STAGE(PG8_SB(0, 1), b2 + hstep, voffB);
            PG8_WAIT_V(6); PG8_BAR; PG8_MMA(1, 1, At, B1); PG8_BAR;
            PG8_LDB(B0, 1, 0); PG8_SCHED; PG8_LDA(At, 1, 0); PG8_STAGE(PG8_SA(0, 1), a2 + hstep, voffA);
            PG8_WAIT_L(8); PG8_BAR; PG8_WAIT_L(0); PG8_MMA(0, 0, At, B0); PG8_BAR; PG8_SCHED;
            PG8_LDB(B1, 1, 1); PG8_STAGE(PG8_SB(1, 0), b3, voffB);
            PG8_BAR; PG8_WAIT_L(0); PG8_MMA(0, 1, At, B1); PG8_BAR;
            PG8_LDA(At, 1, 1); PG8_STAGE(PG8_SA(1, 0), a3, voffA);
            PG8_BAR; PG8_WAIT_L(0); PG8_MMA(1, 0, At, B0); PG8_BAR; PG8_SCHED;
            PG8_STAGE(PG8_SB(1, 1), b3 + hstep, voffB);
            PG8_WAIT_V(6); PG8_BAR; PG8_MMA(1, 1, At, B1); PG8_BAR;
            }
        }
        if constexpr (ALIGN_EPI) { if (wr == 0) PG8_BAR; }
        if constexpr (!Epi::AFTER_DRAIN) { E(acc, cur, wr, wc, fr, fq); S.done(cur); }
        if (!has_next) break;
#pragma unroll
        for (int a = 0; a < 2; ++a)
#pragma unroll
            for (int b = 0; b < 2; ++b)
#pragma unroll
                for (int m = 0; m < 4; ++m)
#pragma unroll
                    for (int n = 0; n < 2; ++n) acc[a][b][m][n] = (f32x4){0.f, 0.f, 0.f, 0.f};
        cur = nxt; cA = nA; cB = nB; ++ui;
        if constexpr (GATHER) { gA[0] = gN[0]; gA[1] = gN[1]; }
        if constexpr (ALIGN_EPI) { if (wr == 1) PG8_BAR; }
    }
    PG8_WAIT_V(0);
    if constexpr (!ALIGN_EPI) { if (wr == 0) PG8_BAR; }
    PG8_BAR;
    if constexpr (Epi::AFTER_DRAIN) { E.fused(acc, cur, wr, wc, fr, fq, lds, wid, lane); S.done(cur); }
#undef PG8_SA
#undef PG8_GLOAD
#undef PG8_STAGE_A
#undef PG8_SB
#undef PG8_STAGE
#undef PG8_LDA
#undef PG8_LDB
#undef PG8_MMA
#undef PG8_WAIT_V
#undef PG8_WAIT_L
#undef PG8_BAR
#undef PG8_SCHED
}
}

typedef unsigned short bf16_t;
typedef unsigned u32x4 __attribute__((ext_vector_type(4)));
typedef float f32x4 __attribute__((ext_vector_type(4)));
#define LAS __attribute__((address_space(3)))

constexpr int BATCH = 4, SEQ = 8192, T = BATCH * SEQ, D = 1024, NIN = 2304, DEPTH = 2;
constexpr int NH = 8;
constexpr int NBUCKET = 24, MAXTILES = 152, MAXROWS = MAXTILES * 256;
constexpr float EPS = 1e-6f;
constexpr float LOG2E = 1.4426950408889634f;
constexpr int NWAVES = 8, NTHREADS = 512;
constexpr int LDS_BYTES = 155648;
constexpr int LDS_BARW = LDS_BYTES - 64;

constexpr size_t MiB = 1u << 20;
constexpr size_t WS_CTL = 0;
constexpr size_t WS_WIN = 1 * MiB;
constexpr size_t WS_WOUT = 10 * MiB;
constexpr size_t WS_WGU = 14 * MiB;
constexpr size_t WS_WDN = 46 * MiB;
constexpr size_t WS_GLU = 94 * MiB;
constexpr size_t WS_S5 = 95 * MiB;
constexpr size_t S5_M1 = 0, S5_M2P = 1 * MiB, S5_TT = 2 * MiB, S5_AP16 = 2 * MiB + 256 * 1024, S5_AP256 = 2 * MiB + 512 * 1024, S5_LAYER = 4 * MiB;
constexpr size_t WS_S5F = WS_S5 + 8 * MiB;
constexpr size_t WS_SGUW = 94 * MiB + 512 * 1024;
constexpr size_t WS_ROUTEW = 105 * MiB;
constexpr size_t WS_XB = 106 * MiB;
constexpr size_t WS_META = 170 * MiB;
constexpr size_t WS_PROJ = 172 * MiB;
constexpr size_t WS_U = WS_PROJ, WS_V = WS_PROJ + 16 * MiB, WS_ZS = WS_PROJ + 32 * MiB;
constexpr size_t WS_QH = WS_PROJ + 48 * MiB, WS_KH = WS_PROJ + 80 * MiB, WS_VH = WS_PROJ + 112 * MiB;
constexpr size_t WS_XS = WS_PROJ;
constexpr size_t WS_H = WS_PROJ + 76 * MiB;
constexpr size_t WS_O = 316 * MiB;
constexpr size_t WS_YG = 380 * MiB;
constexpr size_t WS_SSQP = 380 * MiB;
constexpr size_t WS_SSQB = 382 * MiB;
constexpr size_t WS_BLIST = 384 * MiB;
constexpr size_t WS_BGW0 = 388 * MiB, WS_BGW1 = 392 * MiB, WS_BRS = 396 * MiB;
constexpr size_t WS_END = 412 * MiB;
constexpr size_t MT_RSTD = 0;
constexpr size_t MT_VR = 128 * 1024;
constexpr size_t MT_BUCKET = 256 * 1024;
constexpr size_t MT_POS = 384 * 1024;
constexpr size_t MT_GW0 = 512 * 1024;
constexpr size_t MT_GW1 = 640 * 1024;
constexpr size_t MT_RS2 = 768 * 1024;
constexpr size_t MT_STOK = 896 * 1024;
constexpr size_t MT_SGW0 = 1216 * 1024;
constexpr size_t MT_SGW1 = 1408 * 1024;
constexpr size_t MT_SRS = 1600 * 1024;
constexpr int CW_S5A = 48;
constexpr int CW_CNT = 64;
constexpr int CW_BAR = 4096;
constexpr int CW_TILEB = 256;

__device__ __forceinline__ float bf2f(bf16_t v) { return __uint_as_float(((unsigned)v) << 16); }
__device__ __forceinline__ bf16_t f2bf(float f) { unsigned u = __float_as_uint(f); return (bf16_t)((u + 0x7fffu + ((u >> 16) & 1u)) >> 16); }
__device__ __forceinline__ unsigned pk2(float lo, float hi) { return pg8::cvt_pk_bf16(lo, hi); }
__device__ __forceinline__ float fast_sigmoid_mul(float x, float z) { return x * __builtin_amdgcn_rcpf(1.f + __expf(-z)); }
__device__ __forceinline__ float gelu_tanh(float x) { const float u = 0.7978845608028654f * (x + 0.044715f * x * x * x); return fast_sigmoid_mul(x, 2.f * u); }
__device__ __forceinline__ float wave_sum(float v) {
#pragma unroll
    for (int o = 1; o < 64; o <<= 1) v += __shfl_xor(v, o);
    return v;
}
__device__ __forceinline__ float wave_max(float v) {
#pragma unroll
    for (int o = 1; o < 64; o <<= 1) v = fmaxf(v, __shfl_xor(v, o));
    return v;
}
#define GAS __attribute__((address_space(1)))
template <class Tp> __device__ __forceinline__ Tp* opaque(Tp* q) { GAS Tp* g = (GAS Tp*)q; asm volatile("" : "+v"(g)); return (Tp*)g; }
__device__ __forceinline__ const float* gptr(const float* q) { const GAS float* g = (const GAS float*)q; asm("" : "+s"(g)); return (const float*)g; }
__device__ __forceinline__ int pair_lo(int pi) { return pi < 3 ? 0 : (pi < 5 ? 1 : 2); }
__device__ __forceinline__ int pair_hi(int pi) { return pi < 3 ? pi + 1 : (pi < 5 ? pi - 1 : 3); }

#ifndef REP_ID
#define REP_ID -1
#endif
#ifndef REP_N
#define REP_N 4
#endif
#ifndef REP_PH
#define REP_PH -1
#endif
#define REPEAT(id, body) do { const int nrep_ = (REP_ID == (id) && l == 0) ? REP_N : 1; for (int rep_ = 0; rep_ < nrep_; ++rep_) { body; } } while (0)

struct KArgs { const float* in[29]; float* out; unsigned char* ws; int ph_lo, ph_hi; };

struct Ctx {
    LAS unsigned char* lds;
    const float* const* in; float* out; unsigned char* ws;
    int tid, lane, wave, gw, ngw, G;
    bool dry;
};

__host__ __device__ __forceinline__ int inproj_row_of_col(int n) {
    if (n < 768) return n;
    const int pn = n >> 8, r = n & 255, wc = r >> 6, bj = (r >> 5) & 1, i = r & 31;
    return pn * 256 + bj * 128 + wc * 32 + i;
}
struct TDesc { const float* W; const float* scale; bf16_t* WT; int N, ldk, koff, k0, n0, rowmode; };
struct TRegs { f32x4 v[16]; float s[16]; };
__device__ __forceinline__ void tr_load(const TDesc& d, TRegs& r, int lane) {
    const int kr = lane >> 4, c4 = (lane & 15) * 4;
#pragma unroll
    for (int i = 0; i < 16; ++i) { r.v[i] = *(const f32x4*)(d.W + (size_t)(d.k0 + 4 * i + kr) * d.N + d.n0 + c4); r.s[i] = d.scale ? d.scale[d.k0 + 4 * i + kr] : 1.f; }
}
__device__ __forceinline__ void tr_finish(const TDesc& d, const TRegs& r, LAS float* scr, int lane) {
    const int kr = lane >> 4, c4 = (lane & 15) * 4;
#pragma unroll
    for (int i = 0; i < 16; ++i) { const int kk = 4 * i + kr; const float s = r.s[i];
        LAS float* q = scr + kk * 65 + c4; q[0] = r.v[i].x * s; q[1] = r.v[i].y * s; q[2] = r.v[i].z * s; q[3] = r.v[i].w * s; }
    asm volatile("s_waitcnt lgkmcnt(0)" ::: "memory");
    const int c = lane & 7;
#pragma unroll
    for (int j = 0; j < 8; ++j) {
        const int nl = (lane >> 3) + 8 * j; const LAS float* s = scr + (8 * c) * 65 + nl;
        u32x4 o; o.x = pk2(s[0 * 65], s[1 * 65]); o.y = pk2(s[2 * 65], s[3 * 65]); o.z = pk2(s[4 * 65], s[5 * 65]); o.w = pk2(s[6 * 65], s[7 * 65]);
        const int n = d.n0 + nl; int row;
        if (d.rowmode == 0) row = n;
        else if (d.rowmode == 1) row = inproj_row_of_col(n);
        else if (d.rowmode == 2) row = 256 * (n >> 7) + (n & 127);
        else row = 256 * (n >> 7) + 128 + (n & 127);
        if (d.rowmode == 4) { const int k8 = (d.k0 >> 3) + c;
            *(u32x4*)(d.WT + ((size_t)(((n >> 5) * 16 + (k8 >> 1)) * 64 + (k8 & 1) * 32 + (n & 31))) * 8) = o; }
        else *(u32x4*)(d.WT + (size_t)row * d.ldk + d.koff + d.k0 + 8 * c) = o;
    }
    asm volatile("s_waitcnt lgkmcnt(0)" ::: "memory");
}
constexpr int IT_WIN = 16 * 36, IT_WOUT = 16 * 16, IT_WGU1 = 16 * 4, IT_WDN1 = 4 * 16, IT_GLU = 4 * 4;
constexpr int IT_L = IT_WIN + IT_WOUT + 16 * 2 * IT_WGU1 + NBUCKET * 2 * IT_WDN1 + IT_GLU;
constexpr int IT_TOTAL = DEPTH * IT_L;
__device__ __forceinline__ TDesc prep_desc(const Ctx& C, int it) {
    const int l = it / IT_L; int r = it % IT_L;
    unsigned char* ws = C.ws; TDesc d;
    if (r < IT_WIN) { const int kb = r / 36, nb = r % 36;
        d = TDesc{gptr(C.in[2]) + (size_t)l * D * NIN, gptr(C.in[1]) + l * D, (bf16_t*)(ws + WS_WIN) + (size_t)l * NIN * D, NIN, D, 0, kb * 64, nb * 64, 1}; return d; }
    r -= IT_WIN;
    if (r < IT_WOUT) { const int kb = r / 16, nb = r % 16;
        d = TDesc{gptr(C.in[20]) + (size_t)l * D * D, gptr(C.in[19]) + l * D, (bf16_t*)(ws + WS_WOUT) + (size_t)l * D * D, D, D, 0, kb * 64, nb * 64, 0}; return d; }
    r -= IT_WOUT;
    if (r < 16 * 2 * IT_WGU1) { const int e = r / (2 * IT_WGU1), q = r % (2 * IT_WGU1), isup = q / IT_WGU1, t = q % IT_WGU1, kb = t / 4, nb = t % 4;
        const float* W = (isup ? gptr(C.in[27]) : gptr(C.in[26])) + ((size_t)l * 16 + e) * D * 256;
        d = TDesc{W, gptr(C.in[21]) + l * D, (bf16_t*)(ws + WS_WGU) + ((size_t)l * 16 + e) * 512 * D, 256, D, 0, kb * 64, nb * 64, isup ? 3 : 2}; return d; }
    r -= 16 * 2 * IT_WGU1;
    if (r < NBUCKET * 2 * IT_WDN1) { const int bk = r / (2 * IT_WDN1), q = r % (2 * IT_WDN1), slot = q / IT_WDN1, t = q % IT_WDN1, kb = t / 16, nb = t % 16;
        const int g = bk / 6, pi = bk % 6, e = 4 * g + (slot ? pair_hi(pi) : pair_lo(pi));
        d = TDesc{gptr(C.in[28]) + ((size_t)l * 16 + e) * 256 * D, nullptr, (bf16_t*)(ws + WS_WDN) + ((size_t)l * NBUCKET + bk) * D * 512, D, 512, slot * 256, kb * 64, nb * 64, 0}; return d; }
    r -= NBUCKET * 2 * IT_WDN1;
    { const int kb = r / 4, nb = r % 4;
        d = TDesc{gptr(C.in[14]) + (size_t)l * 256 * 256, nullptr, (bf16_t*)(ws + WS_GLU) + (size_t)l * 256 * 256, 256, 256, 0, kb * 64, nb * 64, 4}; return d; }
}
__device__ __forceinline__ void phase_prep_weights(const Ctx& C, LAS float* scr) {
    TDesc d0, d1; TRegs r0, r1;
    int it = C.gw; bool h0 = it < IT_TOTAL;
    if (h0) { d0 = prep_desc(C, it); tr_load(d0, r0, C.lane); }
    while (h0) {
        const int it1 = it + C.ngw; const bool h1 = it1 < IT_TOTAL;
        if (h1) { d1 = prep_desc(C, it1); tr_load(d1, r1, C.lane); }
        tr_finish(d0, r0, scr, C.lane);
        if (!h1) break;
        const int it2 = it1 + C.ngw; h0 = it2 < IT_TOTAL;
        if (h0) { d0 = prep_desc(C, it2); tr_load(d0, r0, C.lane); }
        tr_finish(d1, r1, scr, C.lane);
        it = it2;
    }
}
__device__ __forceinline__ void conv_row(const float* xrow, bf16_t* orow, float* rstd_out, int lane) {
    const f32x4* xr = (const f32x4*)xrow + lane;
    f32x4 v[4]; float s = 0.f;
#pragma unroll
    for (int j = 0; j < 4; ++j) { v[j] = xr[64 * j]; s += (v[j].x * v[j].x + v[j].y * v[j].y) + (v[j].z * v[j].z + v[j].w * v[j].w); }
    s = wave_sum(s);
    if (lane == 0) *rstd_out = 1.0f / sqrtf(s * (1.f / D) + EPS);
    unsigned long long* o8 = (unsigned long long*)orow + lane;
#pragma unroll
    for (int j = 0; j < 4; ++j) o8[64 * j] = (unsigned long long)pk2(v[j].x, v[j].y) | ((unsigned long long)pk2(v[j].z, v[j].w) << 32);
}
__device__ __forceinline__ void phase_conv(const Ctx& C, const float* x) {
    bf16_t* XB = (bf16_t*)(C.ws + WS_XB); float* RSTD = (float*)(C.ws + WS_META + MT_RSTD);
    for (int m = C.gw * 4; m < T; m += C.ngw * 4) {
        f32x4 v[4][4]; float s[4];
#pragma unroll
        for (int r = 0; r < 4; ++r) { const f32x4* xr = (const f32x4*)(x + (size_t)(m + r) * D) + C.lane;
#pragma unroll
            for (int j = 0; j < 4; ++j) v[r][j] = xr[64 * j]; }
#pragma unroll
        for (int r = 0; r < 4; ++r) { float a = 0.f;
#pragma unroll
            for (int j = 0; j < 4; ++j) a += (v[r][j].x * v[r][j].x + v[r][j].y * v[r][j].y) + (v[r][j].z * v[r][j].z + v[r][j].w * v[r][j].w);
            s[r] = wave_sum(a);
            unsigned long long* o8 = (unsigned long long*)(XB + (size_t)(m + r) * D) + C.lane;
#pragma unroll
            for (int j = 0; j < 4; ++j) o8[64 * j] = (unsigned long long)pk2(v[r][j].x, v[r][j].y) | ((unsigned long long)pk2(v[r][j].z, v[r][j].w) << 32); }
        if (C.lane < 4) RSTD[m + C.lane] = 1.0f / sqrtf((C.lane == 0 ? s[0] : C.lane == 1 ? s[1] : C.lane == 2 ? s[2] : s[3]) * (1.f / D) + EPS);
    }
}
struct DenseSched {
    const char* A; const char* Bt; int nM, nN, nwg, G, c; size_t tstep;
    __device__ __forceinline__ void init(const void* A_, const void* Bt_, int M, int N, int K, int G_, int c_) { A = (const char*)A_; Bt = (const char*)Bt_; nM = M / 256; nN = N / 256; nwg = nM * nN; G = G_; c = c_; tstep = (size_t)256 * K * 2; }
    __device__ __forceinline__ bool next(int i, pg8::Unit& u) const {
        const int R = nwg / G, r = nwg - R * G; long L; u.hf = 0;
        if (i < R) L = (long)i * G + c;
        else if (i == R && r > 0) { if (2 * r <= G) { if (c >= 2 * r) return false; L = (long)R * G + (c % r); u.hf = 1 + c / r; } else { if (c >= r) return false; L = (long)R * G + c; } }
        else return false;
        int wgid = (int)L; { const int q = nwg / 8, rr = nwg % 8, xcd = wgid % 8, off = wgid / 8; wgid = (xcd < rr ? xcd * (q + 1) : rr * (q + 1) + (xcd - rr) * q) + off; }
        const int nig = 8 * nN, gid = wgid / nig, fm = gid * 8, gsz = (nM - fm) < 8 ? (nM - fm) : 8;
        u.pm = fm + ((wgid % nig) % gsz); u.pn = (wgid % nig) / gsz; return true;
    }
    __device__ __forceinline__ const char* a_base(const pg8::Unit& u) const { return A + (size_t)u.pm * tstep + (u.hf == 2 ? tstep / 2 : 0); }
    __device__ __forceinline__ const char* b_base(const pg8::Unit& u) const { return Bt + (size_t)u.pn * tstep; }
    __device__ __forceinline__ int a_row(const pg8::Unit&, int) const { return 0; }
    __device__ __forceinline__ void a_ready(const pg8::Unit&) const {}
    __device__ __forceinline__ void done(const pg8::Unit&) const {}
};
constexpr int TB_OFF = 131072;
struct TileTab { const LAS int* t;
    __device__ __forceinline__ int bucket(int pm) const { return t[pm]; }
    __device__ __forceinline__ int row0(int pm, int bk) const { return (pm - t[160 + bk]) * 256; }
    __device__ __forceinline__ int count(int bk) const { return t[192 + bk]; }
    __device__ __forceinline__ int ntiles() const { return t[224]; } };
__device__ __forceinline__ void build_tile_table(const Ctx& C, int l) {
    LAS int* t = (LAS int*)(C.lds + TB_OFF); const unsigned* cnt = (const unsigned*)(C.ws + WS_CTL) + CW_CNT + l * 32;
    if (C.tid < 64) { const int lane = C.tid; const int c = (lane < NBUCKET) ? (int)cnt[lane] : 0; const int nt = (c + 255) >> 8; int incl = nt;
#pragma unroll
        for (int o = 1; o < 32; o <<= 1) { const int v = __shfl_up(incl, o); if (lane >= o) incl += v; }
        const int excl = incl - nt;
        if (lane < 32) { t[160 + lane] = excl; t[192 + lane] = c; }
        if (lane < NBUCKET) for (int i = 0; i < nt; ++i) t[excl + i] = lane;
        if (lane == NBUCKET - 1) t[224] = incl; }
    __syncthreads();
}
struct GroupSched {
    const char* A; const char* B; TileTab tt; const int* blist; int ntiles, G, c, mode; size_t a_tile_bytes;
    __device__ __forceinline__ bool next(int i, pg8::Unit& u) const {
        const int NU = ntiles * 4, R = NU / G, r = NU - R * G; int L; u.hf = 0;
        const int cv = ((G & 7) == 0) ? (c & 7) * (G >> 3) + (c >> 3) : c;
        if (i < R) L = i * G + cv;
        else if (i == R && r > 0) { if (2 * r <= G) { if (cv >= 2 * r) return false; L = R * G + (cv % r); u.hf = 1 + cv / r; } else { if (cv >= r) return false; L = R * G + cv; } }
        else return false;
        u.pm = L >> 2; u.pn = L & 3; return true; }
    __device__ __forceinline__ const char* a_base(const pg8::Unit& u) const { return mode == 1 ? A : A + (size_t)u.pm * a_tile_bytes + (u.hf == 2 ? a_tile_bytes / 2 : 0); }
    __device__ __forceinline__ int a_row(const pg8::Unit& u, int row) const {
        const int bk = tt.bucket(u.pm), r = tt.row0(u.pm, bk) + row + (u.hf == 2 ? 128 : 0); return blist[bk * T + (r < tt.count(bk) ? r : 0)]; }
    __device__ __forceinline__ const char* b_base(const pg8::Unit& u) const {
        const int bk = tt.bucket(u.pm);
        if (mode == 1) { const int g = bk / 6, pi = bk % 6, e = 4 * g + ((u.pn >> 1) ? pair_hi(pi) : pair_lo(pi)); return B + ((size_t)e * 512 + (u.pn & 1) * 256) * (size_t)(D * 2); }
        return B + ((size_t)bk * D + u.pn * 256) * (size_t)(512 * 2);
    }
    __device__ __forceinline__ void a_ready(const pg8::Unit&) const {}
    __device__ __forceinline__ void done(const pg8::Unit&) const {}
};

__device__ __forceinline__ float row_rstd(const float* ssqp, int row) {
    const f32x4* q = (const f32x4*)(ssqp + (size_t)row * 16); const f32x4 a = q[0], b = q[1], c = q[2], d = q[3];
    const float s = (((a.x + a.y) + (a.z + a.w)) + ((b.x + b.y) + (b.z + b.w))) + (((c.x + c.y) + (c.z + c.w)) + ((d.x + d.y) + (d.z + d.w)));
    return 1.0f / sqrtf(s * (1.f / D) + EPS);
}
struct EpiIn {
    static constexpr bool PERM = true, AFTER_DRAIN = false;
    const float* rstd; bf16_t *U, *QH; const float *qg, *kg;
    __device__ __forceinline__ void operator()(const f32x4 (&acc)[2][2][4][2], const pg8::Unit& u, int wr, int wc, int fr, int fq) const {
        const int pn = u.pn; const int row0 = u.pm * 256 + (u.hf == 2 ? 128 : 0) + wr * 64 + fr; const bool halfu = u.hf != 0;
        if (pn < 3) {
            bf16_t* base = U + (size_t)pn * (8u << 20) + wc * 32 + 8 * fq;
#pragma unroll
            for (int ai = 0; ai < 2; ++ai)
#pragma unroll
                for (int m = 0; m < 4; ++m) { if (ai == 1 && halfu) continue; const int row = row0 + ai * 128 + m * 16; const float rs = rstd[row];
#pragma unroll
                    for (int bj = 0; bj < 2; ++bj) { f32x4 v0 = acc[ai][bj][m][0] * rs, v1 = acc[ai][bj][m][1] * rs;
                        if (pn < 2) { v0.x = gelu_tanh(v0.x); v0.y = gelu_tanh(v0.y); v0.z = gelu_tanh(v0.z); v0.w = gelu_tanh(v0.w); v1.x = gelu_tanh(v1.x); v1.y = gelu_tanh(v1.y); v1.z = gelu_tanh(v1.z); v1.w = gelu_tanh(v1.w); }
                        u32x4 w; w.x = pk2(v0.x, v0.y); w.y = pk2(v0.z, v0.w); w.z = pk2(v1.x, v1.y); w.w = pk2(v1.z, v1.w);
                        *(u32x4*)(base + (size_t)row * 256 + bj * 128) = w; } }
        } else {
            const int typ = (pn - 3) >> 1, head = 4 * ((pn - 3) & 1) + wc;
            bf16_t* dstb = QH + (size_t)typ * (16u << 20) + 8 * fq;
            f32x4 gv[2][2];
            const float* gsrc = qg + (kg - qg) * (typ == 1 ? 1 : 0) + 8 * fq; const float sc = (typ == 0) ? 0.125f * LOG2E : 1.f;
#pragma unroll
            for (int bj = 0; bj < 2; ++bj)
#pragma unroll
                for (int n = 0; n < 2; ++n) gv[bj][n] = (typ < 2) ? *(const f32x4*)(gsrc + 32 * bj + 4 * n) * sc : (f32x4){1.f, 1.f, 1.f, 1.f};
#pragma unroll
            for (int ai = 0; ai < 2; ++ai)
#pragma unroll
                for (int m = 0; m < 4; ++m) { if (ai == 1 && halfu) continue; const int row = row0 + ai * 128 + m * 16; const float rs = rstd[row];
                    f32x4 v[2][2]; float ss = 0.f;
#pragma unroll
                    for (int bj = 0; bj < 2; ++bj)
#pragma unroll
                        for (int n = 0; n < 2; ++n) { v[bj][n] = acc[ai][bj][m][n] * rs; ss += (v[bj][n].x * v[bj][n].x + v[bj][n].y * v[bj][n].y) + (v[bj][n].z * v[bj][n].z + v[bj][n].w * v[bj][n].w); }
                    ss += __shfl_xor(ss, 16); ss += __shfl_xor(ss, 32);
                    const float r = (typ < 2) ? 1.0f / sqrtf(ss * (1.f / 64.f) + EPS) : 1.f;
                    const int b = row >> 13, s = row & (SEQ - 1);
                    bf16_t* dst = dstb + ((size_t)(b * NH + head) * SEQ + s) * 64;
#pragma unroll
                    for (int bj = 0; bj < 2; ++bj) { const f32x4 v0 = v[bj][0] * r * gv[bj][0], v1 = v[bj][1] * r * gv[bj][1];
                        u32x4 w; w.x = pk2(v0.x, v0.y); w.y = pk2(v0.z, v0.w); w.z = pk2(v1.x, v1.y); w.w = pk2(v1.z, v1.w);
                        *(u32x4*)(dst + 32 * bj) = w; } }
        }
    }
};
__device__ __forceinline__ f32x4 bf_lo4(unsigned a, unsigned b) { return (f32x4){__uint_as_float(a << 16), __uint_as_float(a & 0xffff0000u), __uint_as_float(b << 16), __uint_as_float(b & 0xffff0000u)}; }
struct EpiOut {
    static constexpr bool PERM = true, AFTER_DRAIN = false;
    bf16_t* xb; float* ssq; size_t wofs;
    __device__ __forceinline__ void operator()(const f32x4 (&acc)[2][2][4][2], const pg8::Unit& u, int wr, int wc, int fr, int fq) const {
        const int row0 = u.pm * 256 + wr * 64 + fr, col0 = u.pn * 256 + wc * 32 + 8 * fq;
#pragma unroll
        for (int ai = 0; ai < 2; ++ai)
#pragma unroll
            for (int m = 0; m < 4; ++m) { const int row = row0 + ai * 128 + m * 16; bf16_t* xp = xb + (size_t)row * D + col0; float ss = 0.f;
#pragma unroll
                for (int bj = 0; bj < 2; ++bj) { const u32x4 w = *(const u32x4*)(xp + bj * 128);
                    const f32x4 v0 = bf_lo4(w.x, w.y) + acc[ai][bj][m][0], v1 = bf_lo4(w.z, w.w) + acc[ai][bj][m][1];
                    u32x4 o; o.x = pk2(v0.x, v0.y); o.y = pk2(v0.z, v0.w); o.z = pk2(v1.x, v1.y); o.w = pk2(v1.z, v1.w); *(u32x4*)(xp + wofs + bj * 128) = o;
                    const f32x4 r0 = bf_lo4(o.x, o.y), r1 = bf_lo4(o.z, o.w);
                    ss += (r0.x * r0.x + r0.y * r0.y) + (r0.z * r0.z + r0.w * r0.w) + (r1.x * r1.x + r1.y * r1.y) + (r1.z * r1.z + r1.w * r1.w); }
                ss += __shfl_xor(ss, 16); ss += __shfl_xor(ss, 32); if (fq == 0) ssq[(size_t)row * 16 + u.pn * 4 + wc] = ss; }
    }
};
struct EpiG1 {
    static constexpr bool PERM = true, AFTER_DRAIN = false;
    TileTab tt; const float *bgw0, *bgw1, *brs; bf16_t* H;
    __device__ __forceinline__ void operator()(const f32x4 (&acc)[2][2][4][2], const pg8::Unit& u, int wr, int wc, int fr, int fq) const {
        const int rl0 = (u.hf == 2 ? 128 : 0) + wr * 64 + fr; const int slot = u.pn >> 1, hh = u.pn & 1; const bool halfu = u.hf != 0;
        const int bk = tt.bucket(u.pm); const size_t lbase = (size_t)bk * T + tt.row0(u.pm, bk);
        const float* bgw = slot ? bgw1 : bgw0;
        bf16_t* hb = H + (size_t)u.pm * 256 * 512 + slot * 256 + hh * 128 + wc * 32 + 8 * fq;
#pragma unroll
        for (int ai = 0; ai < 2; ++ai)
#pragma unroll
            for (int m = 0; m < 4; ++m) { if (ai == 1 && halfu) continue; const int rl = rl0 + ai * 128 + m * 16; const float rs = brs[lbase + rl], gw = bgw[lbase + rl];
                float h[8];
#pragma unroll
                for (int n = 0; n < 2; ++n) { const f32x4 g = acc[ai][0][m][n] * rs, up = acc[ai][1][m][n] * (rs * gw);
                    h[4 * n] = fast_sigmoid_mul(g.x, g.x) * up.x; h[4 * n + 1] = fast_sigmoid_mul(g.y, g.y) * up.y; h[4 * n + 2] = fast_sigmoid_mul(g.z, g.z) * up.z; h[4 * n + 3] = fast_sigmoid_mul(g.w, g.w) * up.w; }
                u32x4 w; w.x = pk2(h[0], h[1]); w.y = pk2(h[2], h[3]); w.z = pk2(h[4], h[5]); w.w = pk2(h[6], h[7]);
                *(u32x4*)(hb + (size_t)rl * 512) = w; }
    }
};
template <bool NEXT> struct EpiG2 {
    static constexpr bool PERM = true, AFTER_DRAIN = false;
    TileTab tt; const int* blist; float* out; bf16_t* xb; float* ssq; size_t wofs;
    __device__ __forceinline__ void operator()(const f32x4 (&acc)[2][2][4][2], const pg8::Unit& u, int wr, int wc, int fr, int fq) const {
        const int rl0 = (u.hf == 2 ? 128 : 0) + wr * 64 + fr, col0 = u.pn * 256 + wc * 32 + 8 * fq; const bool halfu = u.hf != 0;
        const int bk = tt.bucket(u.pm), r0 = tt.row0(u.pm, bk), bc = tt.count(bk); const int* bl = blist + (size_t)bk * T;
#pragma unroll
        for (int ai = 0; ai < 2; ++ai)
#pragma unroll
            for (int m = 0; m < 4; ++m) { if (ai == 1 && halfu) continue; const int r = r0 + rl0 + ai * 128 + m * 16; const int tok = (r < bc) ? bl[r] : -1;
                float ss = 0.f;
                if (tok >= 0) { bf16_t* xp = xb + (size_t)tok * D + col0;
#pragma unroll
                    for (int bj = 0; bj < 2; ++bj) { const u32x4 w = *(const u32x4*)(xp + bj * 128);
                        const f32x4 v0 = bf_lo4(w.x, w.y) + acc[ai][bj][m][0], v1 = bf_lo4(w.z, w.w) + acc[ai][bj][m][1];
                        if (NEXT) { u32x4 o; o.x = pk2(v0.x, v0.y); o.y = pk2(v0.z, v0.w); o.z = pk2(v1.x, v1.y); o.w = pk2(v1.z, v1.w); *(u32x4*)(xp + wofs + bj * 128) = o;
                            const f32x4 r0 = bf_lo4(o.x, o.y), r1 = bf_lo4(o.z, o.w);
                            ss += (r0.x * r0.x + r0.y * r0.y) + (r0.z * r0.z + r0.w * r0.w) + (r1.x * r1.x + r1.y * r1.y) + (r1.z * r1.z + r1.w * r1.w); }
                        else { f32x4* op = (f32x4*)(out + (size_t)tok * D + col0 + bj * 128); __builtin_nontemporal_store(v0, op); __builtin_nontemporal_store(v1, op + 1); } } }
                if (NEXT) { ss += __shfl_xor(ss, 16); ss += __shfl_xor(ss, 32); if (fq == 0 && tok >= 0) ssq[(size_t)tok * 16 + u.pn * 4 + wc] = ss; } }
    }
};

__device__ __forceinline__ void phase_vrstd(const Ctx& C) {
    const bf16_t* V = (const bf16_t*)(C.ws + WS_V); float* vr = (float*)(C.ws + WS_META + MT_VR);
    for (int m = C.gw; m < T; m += C.ngw) {
        const unsigned long long w = ((const unsigned long long*)(V + (size_t)m * 256))[C.lane];
        const float a = __uint_as_float((unsigned)(w << 16)), b = __uint_as_float((unsigned)w & 0xffff0000u), c = __uint_as_float((unsigned)(w >> 32) << 16), d = __uint_as_float((unsigned)(w >> 32) & 0xffff0000u);
        const float s = wave_sum(a * a + b * b + c * c + d * d);
        if (C.lane == 0) vr[m] = 1.0f / sqrtf(s * (1.f / 256.f) + EPS);
    }
}
__device__ __forceinline__ void phase_sgu_naive(const Ctx& C, int l) {
    const bf16_t* U = (const bf16_t*)(C.ws + WS_U); const bf16_t* V = (const bf16_t*)(C.ws + WS_V); const float* vr = (const float*)(C.ws + WS_META + MT_VR);
    const float* sgu_norm = gptr(C.in[3]) + l * 256; const float* sgu_w = gptr(C.in[4]) + (size_t)l * 4 * 128 * 128; const float* sgu_b = gptr(C.in[5]) + l * 512;
    bf16_t* O = (bf16_t*)(C.ws + WS_O);
    const int half = C.tid >> 8, ch = C.tid & 255, h = ch >> 6;
    const float gn = sgu_norm[ch];
    for (int t = blockIdx.x * 2 + half; t < T; t += C.G * 2) {
        const int s = t & (SEQ - 1), i = s & 127, t0 = t - i;
        const int jmax = (i < 64) ? 64 : 128;
        const float* w = sgu_w + ((size_t)h * 128 + i) * 128;
        float acc = 0.f;
        for (int j = 0; j < jmax; ++j) acc += w[j] * (bf2f(V[(size_t)(t0 + j) * 256 + ch]) * vr[t0 + j] * gn);
        acc += sgu_b[h * 128 + i];
        const float oa = bf2f(U[(size_t)t * 256 + ch]) * acc;
        const float ss = wave_sum(oa * oa);
        O[(size_t)t * D + ch] = f2bf(oa * (1.0f / sqrtf(ss * (1.f / 64.f) + EPS)));
    }
}

typedef short bf16x8 __attribute__((ext_vector_type(8)));
typedef short s16x4 __attribute__((ext_vector_type(4)));
typedef float f32x16 __attribute__((ext_vector_type(16)));
constexpr int ATT_BX = 640;
constexpr int ATT_VBUF = 16384;
constexpr int ATT_BX_OFF = NWAVES * ATT_VBUF;
__device__ __forceinline__ void glds16(const void* gsrc, unsigned lds_dst) { unsigned keep;
    asm volatile("s_mov_b32 %0, m0\n\ts_mov_b32 m0, %2\n\ts_nop 0\n\tglobal_load_lds_dwordx4 %1, off\n\ts_mov_b32 m0, %0" : "=&s"(keep) : "v"(gsrc), "s"(lds_dst) : "memory"); }
__device__ __forceinline__ float max3f(float a, float b, float c) { float r; asm("v_max3_f32 %0, %1, %2, %3" : "=v"(r) : "v"(a), "v"(b), "v"(c)); return r; }
__device__ __forceinline__ s16x4 ds_tr(const LAS unsigned char* p) { return __builtin_bit_cast(s16x4, __builtin_amdgcn_ds_read_tr16_b64_v4i16((LAS s16x4*)p)); }
__device__ __forceinline__ void attn_load_bias(const Ctx& C, int l) {
    LAS float* Bx = (LAS float*)(C.lds + ATT_BX_OFF);
    const float* rb = gptr(C.in[18]) + (size_t)l * NH * 513;
    for (int i = C.tid; i < NH * ATT_BX; i += NTHREADS) { const int h = i / ATT_BX, j = i % ATT_BX; int rel = j - 64; rel = rel > 256 ? 256 : rel; Bx[i] = rb[h * 513 + rel + 256] * LOG2E; }
}
constexpr int ATT_KOFF = 0, ATT_VOFF = 16384;
struct AttnState { float m_run, l_run; f32x16 o0, o1; };
__device__ __forceinline__ void attn_step(const Ctx& C, AttnState& S, const bf16x8 (&qf)[4], const LAS unsigned char* kb, const LAS unsigned char* vbt, const LAS float* Bx, int jbase) {
    const int lane = C.lane, r32 = lane & 31, hi = lane >> 5;
    typedef float f32x2 __attribute__((ext_vector_type(2)));
    f32x16 p0, p1;
#pragma unroll
    for (int r = 0; r < 16; ++r) { const int kk = (r & 3) + 8 * (r >> 2); p0[r] = Bx[jbase - kk]; p1[r] = Bx[jbase - kk - 32]; }
    bf16x8 kf[8];
#pragma unroll
    for (int t = 0; t < 2; ++t)
#pragma unroll
        for (int ks = 0; ks < 4; ++ks) kf[t * 4 + ks] = *(const LAS bf16x8*)(kb + (32 * t + r32) * 128 + 16 * ((2 * ks + hi) ^ (r32 & 7)));
#pragma unroll
    for (int ks = 0; ks < 4; ++ks) { p0 = __builtin_amdgcn_mfma_f32_32x32x16_bf16(kf[ks], qf[ks], p0, 0, 0, 0); p1 = __builtin_amdgcn_mfma_f32_32x32x16_bf16(kf[4 + ks], qf[ks], p1, 0, 0, 0); }
    asm volatile("s_nop 15\n\ts_nop 7" : "+v"(p0), "+v"(p1));
    float mx = max3f(p0[0], p1[0], p0[1]), my = max3f(p1[1], p0[2], p1[2]);
#pragma unroll
    for (int r = 3; r < 15; r += 2) { mx = max3f(mx, p0[r], p1[r]); my = max3f(my, p0[r + 1], p1[r + 1]); }
    mx = max3f(mx, p0[15], p1[15]); mx = max3f(mx, my, __shfl_xor(max3f(mx, my, my), 32));
    const float m_new = max3f(S.m_run, mx, mx);
    const float alpha = __builtin_amdgcn_exp2f(S.m_run - m_new);
    S.m_run = m_new;
    const f32x2 m2 = {m_new, m_new}; f32x2 ps2 = {0.f, 0.f};
#pragma unroll
    for (int r = 0; r < 16; r += 2) {
        f32x2 x = (f32x2){p0[r], p0[r + 1]} - m2, y = (f32x2){p1[r], p1[r + 1]} - m2;
        x.x = __builtin_amdgcn_exp2f(x.x); x.y = __builtin_amdgcn_exp2f(x.y); y.x = __builtin_amdgcn_exp2f(y.x); y.y = __builtin_amdgcn_exp2f(y.y);
        p0[r] = x.x; p0[r + 1] = x.y; p1[r] = y.x; p1[r + 1] = y.y; ps2 += x + y; }
    S.l_run = S.l_run * alpha + (ps2.x + ps2.y);
#pragma unroll
    for (int r = 0; r < 16; ++r) { S.o0[r] *= alpha; S.o1[r] *= alpha; }
    bf16x8 pf[4];
#pragma unroll
    for (int s = 0; s < 2; ++s) { u32x4 w0, w1;
        w0.x = pk2(p0[8 * s], p0[8 * s + 1]); w0.y = pk2(p0[8 * s + 2], p0[8 * s + 3]); w0.z = pk2(p0[8 * s + 4], p0[8 * s + 5]); w0.w = pk2(p0[8 * s + 6], p0[8 * s + 7]);
        w1.x = pk2(p1[8 * s], p1[8 * s + 1]); w1.y = pk2(p1[8 * s + 2], p1[8 * s + 3]); w1.z = pk2(p1[8 * s + 4], p1[8 * s + 5]); w1.w = pk2(p1[8 * s + 6], p1[8 * s + 7]);
        pf[s] = __builtin_bit_cast(bf16x8, w0); pf[2 + s] = __builtin_bit_cast(bf16x8, w1); }
    bf16x8 vf[8];
#pragma unroll
    for (int ts = 0; ts < 4; ++ts)
#pragma unroll
        for (int dt = 0; dt < 2; ++dt) { const s16x4 lo = ds_tr(vbt + ((2 * ts) * 2 + dt) * 512), hi4 = ds_tr(vbt + ((2 * ts + 1) * 2 + dt) * 512);
            vf[2 * ts + dt] = (bf16x8){lo[0], lo[1], lo[2], lo[3], hi4[0], hi4[1], hi4[2], hi4[3]}; }
#pragma unroll
    for (int ts = 0; ts < 4; ++ts) { S.o0 = __builtin_amdgcn_mfma_f32_32x32x16_bf16(vf[2 * ts], pf[ts], S.o0, 0, 0, 0); S.o1 = __builtin_amdgcn_mfma_f32_32x32x16_bf16(vf[2 * ts + 1], pf[ts], S.o1, 0, 0, 0); }
}
__device__ __forceinline__ void attn_block_item(const Ctx& C, int b, int h, int c0) {
    const bf16_t* QH = (const bf16_t*)(C.ws + WS_QH); const bf16_t* KH = (const bf16_t*)(C.ws + WS_KH); const bf16_t* VH = (const bf16_t*)(C.ws + WS_VH);
    bf16_t* O = (bf16_t*)(C.ws + WS_O);
    const int lane = C.lane, r32 = lane & 31, hi = lane >> 5, tid = C.tid, j = C.wave >> 1, half = C.wave & 1, qc = c0 + j;
    const unsigned lds0 = (unsigned)(uintptr_t)C.lds;
    const LAS float* Bx = (const LAS float*)(C.lds + ATT_BX_OFF) + h * ATT_BX;
    const size_t bh = (size_t)(b * NH + h) * SEQ;
    bf16x8 qf[4];
    { const bf16_t* Qp = QH + (bh + qc * 64 + half * 32 + r32) * 64 + 8 * hi;
#pragma unroll
      for (int ks = 0; ks < 4; ++ks) qf[ks] = *(const bf16x8*)(Qp + 16 * ks); }
    const bf16_t* Ksrc = KH + (bh + (tid >> 3)) * 64 + 8 * ((tid & 7) ^ ((tid >> 3) & 7));
    const bf16_t* Vsrc = VH + (bh + 8 * C.wave + ((lane & 31) >> 2)) * 64 + (4 * (lane >> 5) + (lane & 3)) * 8;
    const unsigned kdst = lds0 + ATT_KOFF + C.wave * 1024, vdst = lds0 + ATT_VOFF + C.wave * 1024;
    const int i16 = lane & 15;
    const int trbase = (4 * hi + (i16 >> 2)) * 64 + (16 * ((lane >> 4) & 1) + 4 * (i16 & 3)) * 2;
    const int qi = 32 * half + r32;
    AttnState S; S.m_run = -INFINITY; S.l_run = 0.f;
#pragma unroll
    for (int r = 0; r < 16; ++r) { S.o0[r] = 0.f; S.o1[r] = 0.f; }
    const int s0 = c0 >= 8 ? 0 : 8 - c0;
    { const size_t ko = (size_t)(c0 - 8 + s0) * 64 * 64;
      glds16(Ksrc + ko, (unsigned)__builtin_amdgcn_readfirstlane((int)(kdst + (s0 & 1) * 8192))); glds16(Vsrc + ko, (unsigned)__builtin_amdgcn_readfirstlane((int)(vdst + (s0 & 1) * 8192))); }
    asm volatile("s_waitcnt vmcnt(0) lgkmcnt(0)\n\ts_barrier" ::: "memory");
    for (int s = s0; s < 12; ++s) {
        if (s + 1 < 12) { const size_t ko = (size_t)(c0 - 8 + s + 1) * 64 * 64; const int nb = (s + 1) & 1;
            glds16(Ksrc + ko, (unsigned)__builtin_amdgcn_readfirstlane((int)(kdst + nb * 8192))); glds16(Vsrc + ko, (unsigned)__builtin_amdgcn_readfirstlane((int)(vdst + nb * 8192))); }
        const int jb = s - j;
        if (jb >= 0 && jb < 9) attn_step(C, S, qf, C.lds + ATT_KOFF + (s & 1) * 8192, C.lds + ATT_VOFF + (s & 1) * 8192 + trbase, Bx, 512 - 64 * jb + qi + 64 - 4 * hi);
        asm volatile("s_waitcnt vmcnt(0) lgkmcnt(0)\n\ts_barrier" ::: "memory");
    }
    float lt = S.l_run + __shfl_xor(S.l_run, 32);
    const float inv = 1.0f / lt;
    float ss = 0.f;
#pragma unroll
    for (int r = 0; r < 16; ++r) { S.o0[r] *= inv; S.o1[r] *= inv; ss += S.o0[r] * S.o0[r] + S.o1[r] * S.o1[r]; }
    ss += __shfl_xor(ss, 32);
    const float rn = 1.0f / sqrtf(ss * (1.f / 64.f) + EPS);
    bf16_t* op = O + (size_t)(b * SEQ + qc * 64 + half * 32 + r32) * D + 512 + h * 64 + 4 * hi;
#pragma unroll
    for (int g = 0; g < 4; ++g) {
        *(unsigned long long*)(op + 8 * g) = (unsigned long long)pk2(S.o0[4 * g] * rn, S.o0[4 * g + 1] * rn) | ((unsigned long long)pk2(S.o0[4 * g + 2] * rn, S.o0[4 * g + 3] * rn) << 32);
        *(unsigned long long*)(op + 32 + 8 * g) = (unsigned long long)pk2(S.o1[4 * g] * rn, S.o1[4 * g + 1] * rn) | ((unsigned long long)pk2(S.o1[4 * g + 2] * rn, S.o1[4 * g + 3] * rn) << 32);
    }
}
__device__ __forceinline__ void phase_attn(const Ctx& C, int l, int first, int stride, int limit) {
    attn_load_bias(C, l);
    __syncthreads();
    for (int it = first; it < limit; it += stride) { const int qq = it % (SEQ / 256), bh = it / (SEQ / 256), b = bh / NH, h = bh % NH;
        attn_block_item(C, b, h, qq * 4); }
    __syncthreads();
}

struct S5C { float x; double y; float fr, fi; };
__device__ __forceinline__ void s5_sincos_d(double ang, float& sn, float& cs) {
    ang -= 6.283185307179586476925 * rint(ang * 0.15915494309189533577);
    const float a = (float)ang; sn = __sinf(a); cs = __cosf(a);
}
__device__ __forceinline__ S5C s5_consts(const Ctx& C, int l, int g, int p) {
    const float lr = gptr(C.in[6])[l * 1024 + g * 64 + p], li = gptr(C.in[7])[l * 1024 + g * 64 + p], dt = __expf(gptr(C.in[8])[l * 16 + g]);
    S5C c; c.x = lr * dt; c.y = (double)li * (double)dt;
    float sn, cs, sh, ch; s5_sincos_d(c.y, sn, cs); s5_sincos_d(0.5 * c.y, sh, ch);
    const float x = c.x;
    const float ex1 = x * (1.f + x * (0.5f + x * (0.16666667f + x * (0.041666668f + x * (0.0083333338f + x * 0.0013888889f))))), er = ex1 + 1.f;
    const float nr = ex1 * cs - 2.f * sh * sh, ni = er * sn, den = lr * lr + li * li;
    c.fr = (nr * lr + ni * li) / den; c.fi = (ni * lr - nr * li) / den;
    return c;
}
__device__ __forceinline__ void s5_cpow(const S5C& c, int n, float& re, float& im) {
    const float e = __expf(c.x * (float)n);
    float sn, cs; s5_sincos_d(c.y * (double)n, sn, cs); re = e * cs; im = e * sn;
}
__device__ __forceinline__ int s5_m2col(int sg) { const int ks = sg >> 5, rem = sg & 31; return 32 * ks + 8 * ((rem >> 2) & 3) + 4 * (rem >> 4) + (rem & 3); }
constexpr int S5_ITEMS_LG = 19, S5_ITEMS = DEPTH * 16 * S5_ITEMS_LG;
constexpr int S5_APS = 19 * 128;
__device__ __forceinline__ void s5_prep_item(const Ctx& C, int it, LAS float* scr) {
    const int lg = it / S5_ITEMS_LG, r = it % S5_ITEMS_LG, l = lg >> 4, g = lg & 15, lane = C.lane;
    unsigned char* base = C.ws + WS_S5 + (size_t)l * S5_LAYER;
    const float* bre = gptr(C.in[9]) + l * 16384 + g * 1024; const float* bim = gptr(C.in[10]) + l * 16384 + g * 1024;
    const float* cre = gptr(C.in[11]) + l * 16384 + g * 1024; const float* cim = gptr(C.in[12]) + l * 16384 + g * 1024;
    if (r < 16) {
        const int delta = r;
        { const int p = lane; const S5C c = s5_consts(C, l, g, p);
#pragma unroll
          for (int ts = 0; ts < 2; ++ts) { float pr = 0.f, pi = 0.f; if (delta - ts >= 0) s5_cpow(c, delta - ts, pr, pi);
              scr[(ts * 64 + p) * 2] = (delta - ts >= 0) ? pr * c.fr - pi * c.fi : 0.f; scr[(ts * 64 + p) * 2 + 1] = (delta - ts >= 0) ? pr * c.fi + pi * c.fr : 0.f; } }
        { LAS f32x4* sb = (LAS f32x4*)(scr + 256);
#pragma unroll
          for (int q = 0; q < 4; ++q) { sb[lane + 64 * q] = ((const f32x4*)bre)[lane + 64 * q]; sb[256 + lane + 64 * q] = ((const f32x4*)bim)[lane + 64 * q]; } }
        asm volatile("s_waitcnt lgkmcnt(0)" ::: "memory");
        const int h = lane & 15, kq = lane >> 4, ts = kq >> 1, tau = delta - ts;
        float acc[8];
#pragma unroll
        for (int j = 0; j < 8; ++j) acc[j] = 0.f;
        const LAS f32x4* sbr = (const LAS f32x4*)(scr + 256) + 2 * (kq & 1); const LAS f32x4* sbi = sbr + 256;
        float cr[64 / 16], ci[64 / 16];
#pragma unroll 1
        for (int p0 = 0; p0 < 64; p0 += 4) {
#pragma unroll
            for (int q = 0; q < 4; ++q) { cr[q] = cre[h * 64 + p0 + q]; ci[q] = cim[h * 64 + p0 + q]; }
#pragma unroll
            for (int q = 0; q < 4; ++q) { const int p = p0 + q;
                const float pr = scr[(ts * 64 + p) * 2], pi = scr[(ts * 64 + p) * 2 + 1];
                const float wr = cr[q] * pr - ci[q] * pi, wi = cr[q] * pi + ci[q] * pr;
                const f32x4 b0 = sbr[4 * p], b1 = sbr[4 * p + 1], c0 = sbi[4 * p], c1 = sbi[4 * p + 1];
                acc[0] += wr * b0.x - wi * c0.x; acc[1] += wr * b0.y - wi * c0.y; acc[2] += wr * b0.z - wi * c0.z; acc[3] += wr * b0.w - wi * c0.w;
                acc[4] += wr * b1.x - wi * c1.x; acc[5] += wr * b1.y - wi * c1.y; acc[6] += wr * b1.z - wi * c1.z; acc[7] += wr * b1.w - wi * c1.w; }
        }
        if (tau == 0) {
#pragma unroll
            for (int j = 0; j < 8; ++j) if (8 * (kq & 1) + j == h) acc[j] += gptr(C.in[13])[l * 256 + g * 16 + h];
        }
        u32x4 o; o.x = pk2(acc[0], acc[1]); o.y = pk2(acc[2], acc[3]); o.z = pk2(acc[4], acc[5]); o.w = pk2(acc[6], acc[7]);
        *(u32x4*)((bf16_t*)(base + S5_TT) + ((size_t)(g * 16 + delta) * 64 + lane) * 8) = o;
        asm volatile("s_waitcnt lgkmcnt(0)" ::: "memory");
    } else if (r == 16) {
        const int p = lane; const S5C c = s5_consts(C, l, g, p);
        float ar, ai; s5_cpow(c, 1, ar, ai);
        const float w1r = ar * c.fr - ai * c.fi, w1i = ar * c.fi + ai * c.fr;
        bf16_t* BB = (bf16_t*)(base + S5_M1) + (size_t)g * 128 * 32;
        unsigned re[16], im[16];
#pragma unroll
        for (int h2 = 0; h2 < 8; ++h2) {
            const float x0 = bre[p * 16 + 2 * h2], y0 = bim[p * 16 + 2 * h2], x1 = bre[p * 16 + 2 * h2 + 1], y1 = bim[p * 16 + 2 * h2 + 1];
            re[h2] = pk2(w1r * x0 - w1i * y0, w1r * x1 - w1i * y1); im[h2] = pk2(w1r * y0 + w1i * x0, w1r * y1 + w1i * x1);
            re[8 + h2] = pk2(c.fr * x0 - c.fi * y0, c.fr * x1 - c.fi * y1); im[8 + h2] = pk2(c.fr * y0 + c.fi * x0, c.fr * y1 + c.fi * x1);
        }
        u32x4* d0 = (u32x4*)(BB + (size_t)p * 32); u32x4* d1 = (u32x4*)(BB + (size_t)(64 + p) * 32);
#pragma unroll
        for (int q = 0; q < 4; ++q) { d0[q] = (u32x4){re[4 * q], re[4 * q + 1], re[4 * q + 2], re[4 * q + 3]}; d1[q] = (u32x4){im[4 * q], im[4 * q + 1], im[4 * q + 2], im[4 * q + 3]}; }
    } else if (r == 17) {
        const int p = lane;
        bf16_t* CMp = (bf16_t*)(base + S5_M2P) + (size_t)g * 16 * 128;
        const int c0 = s5_m2col(p), c1 = s5_m2col(64 + p);
#pragma unroll
        for (int h = 0; h < 16; ++h) { CMp[h * 128 + c0] = f2bf(cre[h * 64 + p]); CMp[h * 128 + c1] = f2bf(-cim[h * 64 + p]); }
    } else {
        const int p = lane; const S5C c = s5_consts(C, l, g, p);
        float* A16 = (float*)(base + S5_AP16) + (size_t)g * S5_APS; float* A256 = (float*)(base + S5_AP256) + (size_t)g * 32 * 128;
        for (int cc = 0; cc <= 18; ++cc) { float pr, pi; s5_cpow(c, cc <= 16 ? 16 * cc : cc - 16, pr, pi); A16[cc * 128 + p] = pr; A16[cc * 128 + 64 + p] = pi; }
        for (int m = 0; m < 32; ++m) { float pr, pi; s5_cpow(c, 256 * m, pr, pi); A256[m * 128 + p] = pr; A256[m * 128 + 64 + p] = pi; }
    }
}

__device__ __forceinline__ float dpp_shr(float v, int d) {
    int r;
    if (d == 1) r = __builtin_amdgcn_update_dpp(0, __float_as_int(v), 0x111, 0xf, 0xf, true);
    else if (d == 2) r = __builtin_amdgcn_update_dpp(0, __float_as_int(v), 0x112, 0xf, 0xf, true);
    else if (d == 4) r = __builtin_amdgcn_update_dpp(0, __float_as_int(v), 0x114, 0xf, 0xf, true);
    else r = __builtin_amdgcn_update_dpp(0, __float_as_int(v), 0x118, 0xf, 0xf, true);
    return __int_as_float(r);
}
struct S5Wave { bf16x8 uf[8]; f32x4 X[8]; f32x4 ar[4], ai[4], wr[4], wi[4]; };
#define S5_CSQR(pr, pi) do { _Pragma("unroll") for (int mt_ = 0; mt_ < 4; ++mt_) { const f32x4 r_ = pr[mt_] * pr[mt_] - pi[mt_] * pi[mt_], i_ = 2.f * (pr[mt_] * pi[mt_]); pr[mt_] = r_; pi[mt_] = i_; } } while (0)
template <bool NEEDW> __device__ __forceinline__ void s5_E_scan(const Ctx& C, int l, int b, int k, int g, S5Wave& W) {
    const int lane = C.lane, cc = lane & 15, kq = lane >> 4;
    const unsigned char* base = C.ws + WS_S5 + (size_t)l * S5_LAYER;
    const bf16_t* ZS = (const bf16_t*)(C.ws + WS_ZS);
    const bf16_t* up = ZS + ((size_t)b * SEQ + 256 * k + 16 * cc + (kq >> 1)) * 256 + 16 * g + 8 * (kq & 1);
#pragma unroll
    for (int ks = 0; ks < 8; ++ks) W.uf[ks] = *(const bf16x8*)(up + (size_t)(2 * ks) * 256);
    const bf16_t* bbp = opaque((const bf16_t*)(base + S5_M1) + (size_t)g * 128 * 32 + (size_t)cc * 32 + 8 * kq);
    bf16x8 bb[8];
#pragma unroll
    for (int mt = 0; mt < 8; ++mt) bb[mt] = *(const bf16x8*)(bbp + (size_t)(16 * mt) * 32);
    const float* A1 = opaque((const float*)(base + S5_AP16) + (size_t)g * S5_APS + 17 * 128 + 4 * kq);
#pragma unroll
    for (int mt = 0; mt < 4; ++mt) { W.ar[mt] = *(const f32x4*)(A1 + 16 * mt); W.ai[mt] = *(const f32x4*)(A1 + 64 + 16 * mt); }
    f32x4 pr[4], pi[4];
#pragma unroll
    for (int mt = 0; mt < 4; ++mt) { pr[mt] = W.ar[mt]; pi[mt] = W.ai[mt]; }
    S5_CSQR(pr, pi);
#pragma unroll
    for (int mt = 0; mt < 8; ++mt) W.X[mt] = (f32x4){0.f, 0.f, 0.f, 0.f};
#pragma unroll
    for (int ks = 0; ks < 8; ++ks) {
        if (ks) {
#pragma unroll
            for (int mt = 0; mt < 4; ++mt) { const f32x4 re = W.X[mt], im = W.X[mt + 4]; W.X[mt] = pr[mt] * re - pi[mt] * im; W.X[mt + 4] = pr[mt] * im + pi[mt] * re; }
        }
#pragma unroll
        for (int mt = 0; mt < 8; ++mt) W.X[mt] = __builtin_amdgcn_mfma_f32_16x16x32_bf16(bb[mt], W.uf[ks], W.X[mt], 0, 0, 0);
    }
    S5_CSQR(pr, pi); S5_CSQR(pr, pi); S5_CSQR(pr, pi);
    if (NEEDW) {
#pragma unroll
        for (int mt = 0; mt < 4; ++mt) { W.wr[mt] = (f32x4){1.f, 1.f, 1.f, 1.f}; W.wi[mt] = (f32x4){0.f, 0.f, 0.f, 0.f}; } }
#pragma unroll
    for (int d = 1; d < 16; d <<= 1) {
#pragma unroll
        for (int mt = 0; mt < 4; ++mt) {
#pragma unroll
            for (int r = 0; r < 4; ++r) { const float sr = dpp_shr(W.X[mt][r], d), si = dpp_shr(W.X[mt + 4][r], d);
                W.X[mt][r] += pr[mt][r] * sr - pi[mt][r] * si; W.X[mt + 4][r] += pr[mt][r] * si + pi[mt][r] * sr; }
        }
        if (NEEDW) { const bool sel = (cc & d) != 0;
#pragma unroll
            for (int mt = 0; mt < 4; ++mt) { const f32x4 nr = W.wr[mt] * pr[mt] - W.wi[mt] * pi[mt], ni = W.wr[mt] * pi[mt] + W.wi[mt] * pr[mt];
#pragma unroll
                for (int r = 0; r < 4; ++r) { W.wr[mt][r] = sel ? nr[r] : W.wr[mt][r]; W.wi[mt][r] = sel ? ni[r] : W.wi[mt][r]; } } }
        if (d < 8) S5_CSQR(pr, pi);
    }
}
__device__ __forceinline__ void s5a_item(const Ctx& C, int l, int it) {
    const int g = it & 15, k = (it >> 4) & 31, b = it >> 9;
    S5Wave W; s5_E_scan<false>(C, l, b, k, g, W);
    if ((C.lane & 15) == 15) { float* F = (float*)(C.ws + WS_S5F) + ((size_t)((b * 32 + k) * 16 + g)) * 128 + 4 * (C.lane >> 4);
#pragma unroll
        for (int mt = 0; mt < 8; ++mt) *(f32x4*)(F + 16 * mt) = W.X[mt]; }
}
constexpr int S5_YSTRIDE = 528;
__device__ __forceinline__ void s5c_group(const Ctx& C0, int l, int b, int k, int g) {
    Ctx C = C0; asm volatile("; S5C_GROUP_BEGIN\n" : "+v"(C.lane));
    const int lane = C.lane, cc = lane & 15, kq = lane >> 4;
    const unsigned char* base = C.ws + WS_S5 + (size_t)l * S5_LAYER;
    f32x4 gr[4], gi[4];
#pragma unroll
    for (int mt = 0; mt < 4; ++mt) { gr[mt] = (f32x4){0.f, 0.f, 0.f, 0.f}; gi[mt] = (f32x4){0.f, 0.f, 0.f, 0.f}; }
    if (k > 0) {
        const float* F = opaque((const float*)(C.ws + WS_S5F) + ((size_t)(b * 32) * 16 + g) * 128 + 4 * kq);
        const float* A256 = opaque((const float*)(base + S5_AP256) + (size_t)g * 32 * 128 + 4 * kq);
#pragma unroll
        for (int rep = 0; rep < 2; ++rep) { const int kp = cc + 16 * rep;
            if (kp < k) { const float* f = opaque(F + (size_t)kp * 16 * 128); const float* w = opaque(A256 + (size_t)(k - 1 - kp) * 128);
#pragma unroll
                for (int mt = 0; mt < 4; ++mt) { const f32x4 fr = *(const f32x4*)(f + 16 * mt), fi = *(const f32x4*)(f + 64 + 16 * mt), wr = *(const f32x4*)(w + 16 * mt), wi = *(const f32x4*)(w + 64 + 16 * mt);
                    gr[mt] += wr * fr - wi * fi; gi[mt] += wr * fi + wi * fr; } } }
#pragma unroll
        for (int mt = 0; mt < 4; ++mt)
#pragma unroll
            for (int r = 0; r < 4; ++r) {
#pragma unroll
                for (int o = 1; o < 16; o <<= 1) { gr[mt][r] += __shfl_xor(gr[mt][r], o); gi[mt][r] += __shfl_xor(gi[mt][r], o); } }
    }
    S5Wave W; s5_E_scan<true>(C, l, b, k, g, W);
#pragma unroll
    for (int mt = 0; mt < 8; ++mt)
#pragma unroll
        for (int r = 0; r < 4; ++r) W.X[mt][r] = dpp_shr(W.X[mt][r], 1);
#pragma unroll
    for (int mt = 0; mt < 4; ++mt) { W.X[mt] += W.wr[mt] * gr[mt] - W.wi[mt] * gi[mt]; W.X[mt + 4] += W.wr[mt] * gi[mt] + W.wi[mt] * gr[mt]; }
    bf16x8 tt[16];
    const bf16_t* ttp = opaque((const bf16_t*)(base + S5_TT) + ((size_t)(g * 16) * 64 + lane) * 8);
#pragma unroll
    for (int d4 = 0; d4 < 4; ++d4) { if (d4) ttp = opaque(ttp + 4 * 64 * 8);
#pragma unroll
        for (int d = 0; d < 4; ++d) tt[4 * d4 + d] = *(const bf16x8*)(ttp + (size_t)d * 64 * 8); }
    bf16x8 cm[4];
    const bf16_t* cmp = opaque((const bf16_t*)(base + S5_M2P) + (size_t)g * 16 * 128 + (size_t)cc * 128 + 8 * kq);
#pragma unroll
    for (int ks = 0; ks < 4; ++ks) cm[ks] = *(const bf16x8*)(cmp + 32 * ks);
    f32x4 a1r[4], a1i[4];
    { const float* A1 = opaque((const float*)(base + S5_AP16) + (size_t)g * S5_APS + 17 * 128 + 4 * kq);
#pragma unroll
      for (int mt = 0; mt < 4; ++mt) { a1r[mt] = *(const f32x4*)(A1 + 16 * mt); a1i[mt] = *(const f32x4*)(A1 + 64 + 16 * mt); } }
    LAS unsigned char* yt = C.lds + (size_t)(16 * cc) * S5_YSTRIDE + (16 * g + 4 * kq) * 2;
#pragma unroll
    for (int jj = 0; jj < 16; jj += 2) {
        bf16x8 sf1[4], sf2[4];
#pragma unroll
        for (int mt = 0; mt < 4; ++mt) { const f32x4 re = W.X[mt], im = W.X[mt + 4]; W.X[mt] = a1r[mt] * re - a1i[mt] * im; W.X[mt + 4] = a1r[mt] * im + a1i[mt] * re; }
#pragma unroll
        for (int ks = 0; ks < 4; ++ks) { u32x4 w; w.x = pk2(W.X[2 * ks][0], W.X[2 * ks][1]); w.y = pk2(W.X[2 * ks][2], W.X[2 * ks][3]); w.z = pk2(W.X[2 * ks + 1][0], W.X[2 * ks + 1][1]); w.w = pk2(W.X[2 * ks + 1][2], W.X[2 * ks + 1][3]); sf1[ks] = __builtin_bit_cast(bf16x8, w); }
#pragma unroll
        for (int mt = 0; mt < 4; ++mt) { const f32x4 re = W.X[mt], im = W.X[mt + 4]; W.X[mt] = a1r[mt] * re - a1i[mt] * im; W.X[mt + 4] = a1r[mt] * im + a1i[mt] * re; }
#pragma unroll
        for (int ks = 0; ks < 4; ++ks) { u32x4 w; w.x = pk2(W.X[2 * ks][0], W.X[2 * ks][1]); w.y = pk2(W.X[2 * ks][2], W.X[2 * ks][3]); w.z = pk2(W.X[2 * ks + 1][0], W.X[2 * ks + 1][1]); w.w = pk2(W.X[2 * ks + 1][2], W.X[2 * ks + 1][3]); sf2[ks] = __builtin_bit_cast(bf16x8, w); }
        f32x4 acc1 = {0.f, 0.f, 0.f, 0.f}, acc2 = {0.f, 0.f, 0.f, 0.f};
#pragma unroll
        for (int ks = 0; ks < 4; ++ks) { acc1 = __builtin_amdgcn_mfma_f32_16x16x32_bf16(cm[ks], sf1[ks], acc1, 0, 0, 0); acc2 = __builtin_amdgcn_mfma_f32_16x16x32_bf16(cm[ks], sf2[ks], acc2, 0, 0, 0); }
#pragma unroll
        for (int ks = 0; ks <= jj / 2; ++ks) { acc1 = __builtin_amdgcn_mfma_f32_16x16x32_bf16(tt[jj - 2 * ks], W.uf[ks], acc1, 0, 0, 0); acc2 = __builtin_amdgcn_mfma_f32_16x16x32_bf16(tt[jj + 1 - 2 * ks], W.uf[ks], acc2, 0, 0, 0); }
        const unsigned long long w1 = (unsigned long long)pk2(gelu_tanh(acc1[0]), gelu_tanh(acc1[1])) | ((unsigned long long)pk2(gelu_tanh(acc1[2]), gelu_tanh(acc1[3])) << 32);
        const unsigned long long w2 = (unsigned long long)pk2(gelu_tanh(acc2[0]), gelu_tanh(acc2[1])) | ((unsigned long long)pk2(gelu_tanh(acc2[2]), gelu_tanh(acc2[3])) << 32);
        *(LAS unsigned long long*)(yt + jj * S5_YSTRIDE) = w1; *(LAS unsigned long long*)(yt + (jj + 1) * S5_YSTRIDE) = w2;
    }
}
__device__ __forceinline__ void s5c_glu(const Ctx& C0, int l, int b, int k) {
    Ctx C = C0; asm volatile("; S5C_GLU_BEGIN\n" : "+v"(C.lane));
    const int lane = C.lane, r32 = lane & 31, hi = lane >> 5, tok = 32 * C.wave + r32;
    const bf16_t* gtp = opaque((const bf16_t*)(C.ws + WS_GLU) + (size_t)l * 65536 + (size_t)lane * 8);
    const float* gb = gptr(C.in[15]) + l * 256;
    const LAS unsigned char* yrow = C.lds + (size_t)tok * S5_YSTRIDE;
    bf16x8 yf[16];
#pragma unroll
    for (int ks = 0; ks < 16; ++ks) yf[ks] = *(const LAS bf16x8*)(yrow + (16 * ks + 8 * hi) * 2);
    bf16_t* op = (bf16_t*)(C.ws + WS_O) + ((size_t)b * SEQ + 256 * k + tok) * D + 256 + 4 * hi;
    bf16x8 wa[16], wb[16];
#pragma unroll
    for (int ks = 0; ks < 16; ++ks) wa[ks] = *(const bf16x8*)(gtp + 512 * ks);
#pragma unroll
    for (int ng = 0; ng < 4; ++ng) {
        f32x16 z[2];
#pragma unroll
        for (int r = 0; r < 16; ++r) { z[0][r] = 0.f; z[1][r] = 0.f; }
        gtp = opaque(gtp + 16 * 512);
#pragma unroll
        for (int ks = 0; ks < 16; ++ks) wb[ks] = *(const bf16x8*)(gtp + 512 * ks);
#pragma unroll
        for (int ks = 0; ks < 16; ++ks) z[0] = __builtin_amdgcn_mfma_f32_32x32x16_bf16(wa[ks], yf[ks], z[0], 0, 0, 0);
        if (ng < 3) { gtp = opaque(gtp + 16 * 512);
#pragma unroll
            for (int ks = 0; ks < 16; ++ks) wa[ks] = *(const bf16x8*)(gtp + 512 * ks); }
#pragma unroll
        for (int ks = 0; ks < 16; ++ks) z[1] = __builtin_amdgcn_mfma_f32_32x32x16_bf16(wb[ks], yf[ks], z[1], 0, 0, 0);
        float ob[2][16]; float ss = 0.f;
#pragma unroll
        for (int m2 = 0; m2 < 2; ++m2)
#pragma unroll
            for (int q4 = 0; q4 < 4; ++q4) { const int ch = 32 * (2 * ng + m2) + 8 * q4 + 4 * hi;
                const unsigned long long yw = *(const LAS unsigned long long*)(yrow + ch * 2); const f32x4 bb = *(const f32x4*)(gb + ch);
                const float y0 = __uint_as_float((unsigned)yw << 16), y1 = __uint_as_float((unsigned)yw & 0xffff0000u), y2 = __uint_as_float((unsigned)(yw >> 32) << 16), y3 = __uint_as_float((unsigned)(yw >> 32) & 0xffff0000u);
                const float o0 = fast_sigmoid_mul(y0, z[m2][4 * q4] + bb[0]), o1 = fast_sigmoid_mul(y1, z[m2][4 * q4 + 1] + bb[1]), o2 = fast_sigmoid_mul(y2, z[m2][4 * q4 + 2] + bb[2]), o3 = fast_sigmoid_mul(y3, z[m2][4 * q4 + 3] + bb[3]);
                ob[m2][4 * q4] = o0; ob[m2][4 * q4 + 1] = o1; ob[m2][4 * q4 + 2] = o2; ob[m2][4 * q4 + 3] = o3; ss += (o0 * o0 + o1 * o1) + (o2 * o2 + o3 * o3); }
        ss += __shfl_xor(ss, 32);
        const float rn = 1.0f / sqrtf(ss * (1.f / 64.f) + EPS);
#pragma unroll
        for (int m2 = 0; m2 < 2; ++m2)
#pragma unroll
            for (int q4 = 0; q4 < 4; ++q4)
                *(unsigned long long*)(op + 64 * ng + 32 * m2 + 8 * q4) = (unsigned long long)pk2(ob[m2][4 * q4] * rn, ob[m2][4 * q4 + 1] * rn) | ((unsigned long long)pk2(ob[m2][4 * q4 + 2] * rn, ob[m2][4 * q4 + 3] * rn) << 32);
    }
}
__device__ __forceinline__ void s5c_item(const Ctx& C, int l, int it) {
    const int b = it >> 5, k = it & 31;
    REPEAT(22, s5c_group(C, l, b, k, 2 * C.wave); s5c_group(C, l, b, k, 2 * C.wave + 1));
    __syncthreads();
    REPEAT(23, s5c_glu(C, l, b, k));
    __syncthreads();
}

constexpr int SGU_VS = 576;
__device__ __forceinline__ void sgu_item(const Ctx& C, int l, int it) {
    const bf16_t* U = (const bf16_t*)(C.ws + WS_U); const bf16_t* V = (const bf16_t*)(C.ws + WS_V); bf16_t* O = (bf16_t*)(C.ws + WS_O);
    const float* gain = gptr(C.in[3]) + l * 256; const float* sgu_b = gptr(C.in[5]) + l * 512;
    const bf16_t* Wb = (const bf16_t*)(C.ws + WS_SGUW) + (size_t)l * 65536;
    const int tid = C.tid, lane = C.lane, r32 = lane & 31, hi = lane >> 5;
    const size_t t0 = (size_t)it * 128;
    {
        const int row = tid >> 2, qt = tid & 3;
        const u32x4* src = (const u32x4*)(V + (t0 + row) * 256 + qt * 64);
        u32x4 w[8]; float ss = 0.f;
#pragma unroll
        for (int i = 0; i < 8; ++i) { w[i] = src[i];
#pragma unroll
            for (int e = 0; e < 4; ++e) { const float a = __uint_as_float(w[i][e] << 16), b = __uint_as_float(w[i][e] & 0xffff0000u); ss += a * a + b * b; } }
        ss += __shfl_xor(ss, 1); ss += __shfl_xor(ss, 2);
        const float rs = 1.0f / sqrtf(ss * (1.f / 256.f) + EPS);
        LAS unsigned char* dst = C.lds + row * SGU_VS + qt * 128;
#pragma unroll
        for (int i = 0; i < 8; ++i) { const f32x4 g0 = *(const f32x4*)(gain + qt * 64 + 8 * i), g1 = *(const f32x4*)(gain + qt * 64 + 8 * i + 4);
            u32x4 o;
            o.x = pk2(__uint_as_float(w[i].x << 16) * rs * g0.x, __uint_as_float(w[i].x & 0xffff0000u) * rs * g0.y); o.y = pk2(__uint_as_float(w[i].y << 16) * rs * g0.z, __uint_as_float(w[i].y & 0xffff0000u) * rs * g0.w);
            o.z = pk2(__uint_as_float(w[i].z << 16) * rs * g1.x, __uint_as_float(w[i].z & 0xffff0000u) * rs * g1.y); o.w = pk2(__uint_as_float(w[i].w << 16) * rs * g1.z, __uint_as_float(w[i].w & 0xffff0000u) * rs * g1.w);
            *(LAS u32x4*)(dst + 16 * i) = o; }
    }
    __syncthreads();
    const int h = C.wave >> 1, ih = C.wave & 1;
    const int nks = ih ? 8 : 4;
    f32x16 acc[2][2];
#pragma unroll
    for (int mt = 0; mt < 2; ++mt)
#pragma unroll
        for (int nt = 0; nt < 2; ++nt)
#pragma unroll
            for (int r = 0; r < 16; ++r) acc[mt][nt][r] = 0.f;
    const int i16 = lane & 15;
    const LAS unsigned char* vb = C.lds + (8 * hi + (i16 >> 2)) * SGU_VS + (64 * h + 16 * ((lane >> 4) & 1) + 4 * (i16 & 3)) * 2;
    const bf16_t* wp = Wb + ((size_t)h * 128 + 64 * ih + r32) * 128 + 8 * hi;
    for (int ks = 0; ks < nks; ++ks) {
        bf16x8 af[2], bfr[2];
#pragma unroll
        for (int mt = 0; mt < 2; ++mt) { const s16x4 lo = ds_tr(vb + (16 * ks) * SGU_VS + 64 * mt), hi4 = ds_tr(vb + (16 * ks + 4) * SGU_VS + 64 * mt);
            af[mt] = (bf16x8){lo[0], lo[1], lo[2], lo[3], hi4[0], hi4[1], hi4[2], hi4[3]}; }
#pragma unroll
        for (int nt = 0; nt < 2; ++nt) bfr[nt] = *(const bf16x8*)(wp + (size_t)(32 * nt) * 128 + 16 * ks);
#pragma unroll
        for (int mt = 0; mt < 2; ++mt)
#pragma unroll
            for (int nt = 0; nt < 2; ++nt) acc[mt][nt] = __builtin_amdgcn_mfma_f32_32x32x16_bf16(af[mt], bfr[nt], acc[mt][nt], 0, 0, 0);
    }
#pragma unroll
    for (int nt = 0; nt < 2; ++nt) {
        const int i = 64 * ih + 32 * nt + r32; const float bias = sgu_b[h * 128 + i];
        const bf16_t* up = U + (t0 + i) * 256 + 64 * h + 4 * hi; bf16_t* op = O + (t0 + i) * D + 64 * h + 4 * hi;
        float ov[2][16]; float ss = 0.f;
#pragma unroll
        for (int mt = 0; mt < 2; ++mt)
#pragma unroll
            for (int q4 = 0; q4 < 4; ++q4) { const unsigned long long uw = *(const unsigned long long*)(up + 32 * mt + 8 * q4);
                const float u0 = __uint_as_float((unsigned)uw << 16), u1 = __uint_as_float((unsigned)uw & 0xffff0000u), u2 = __uint_as_float((unsigned)(uw >> 32) << 16), u3 = __uint_as_float((unsigned)(uw >> 32) & 0xffff0000u);
                const float o0 = u0 * (acc[mt][nt][4 * q4] + bias), o1 = u1 * (acc[mt][nt][4 * q4 + 1] + bias), o2 = u2 * (acc[mt][nt][4 * q4 + 2] + bias), o3 = u3 * (acc[mt][nt][4 * q4 + 3] + bias);
                ov[mt][4 * q4] = o0; ov[mt][4 * q4 + 1] = o1; ov[mt][4 * q4 + 2] = o2; ov[mt][4 * q4 + 3] = o3; ss += (o0 * o0 + o1 * o1) + (o2 * o2 + o3 * o3); }
        ss += __shfl_xor(ss, 32);
        const float rn = 1.0f / sqrtf(ss * (1.f / 64.f) + EPS);
#pragma unroll
        for (int mt = 0; mt < 2; ++mt)
#pragma unroll
            for (int q4 = 0; q4 < 4; ++q4)
                *(unsigned long long*)(op + 32 * mt + 8 * q4) = (unsigned long long)pk2(ov[mt][4 * q4] * rn, ov[mt][4 * q4 + 1] * rn) | ((unsigned long long)pk2(ov[mt][4 * q4 + 2] * rn, ov[mt][4 * q4 + 3] * rn) << 32);
    }
    __syncthreads();
}

__device__ __forceinline__ void route_block(const Ctx& C, int l, int it) {
    const float* bg = gptr(C.in[23]) + l * 4; const float* be = gptr(C.in[25]) + l * 16;
    unsigned* cnt = (unsigned*)(C.ws + WS_CTL) + (C.dry ? 2048 : CW_CNT + l * 32);
    int* m_bucket = (int*)(C.ws + WS_META + MT_BUCKET); int* m_pos = (int*)(C.ws + WS_META + MT_POS);
    float* m_gw0 = (float*)(C.ws + WS_META + MT_GW0); float* m_gw1 = (float*)(C.ws + WS_META + MT_GW1); float* m_rs = (float*)(C.ws + WS_META + MT_RS2);
    bf16_t* XB = (bf16_t*)(C.ws + WS_XB);
    LAS unsigned* hist = (LAS unsigned*)C.lds; LAS unsigned* hbase = hist + 32;
    const int lane = C.lane, r32 = lane & 31, hi = lane >> 5;
    if (C.tid < 32) hist[C.tid] = 0u;
    __syncthreads();
    int bk = 0, rank = 0; float glo = 0.f, ghi = 0.f, rs = 0.f; const int t = it * 128 + C.wave * 32 + r32;
    if (C.wave < 4) {
        const bf16_t* xbr = XB + (size_t)t * D + 8 * hi;
        const bf16_t* whp = opaque((const bf16_t*)(C.ws + WS_ROUTEW) + (size_t)l * 65536 + (size_t)lane * 8);
        f32x16 acc;
#pragma unroll
        for (int r = 0; r < 16; ++r) acc[r] = 0.f;
        for (int kb = 0; kb < 8; ++kb) {
            bf16x8 xh[8], wh[8], wl[8];
#pragma unroll
            for (int i = 0; i < 8; ++i) { const int ks = 8 * kb + i; xh[i] = *(const bf16x8*)(xbr + 16 * ks); wh[i] = *(const bf16x8*)(whp + 512 * ks); wl[i] = *(const bf16x8*)(whp + 32768 + 512 * ks); }
#pragma unroll
            for (int i = 0; i < 8; ++i) { acc = __builtin_amdgcn_mfma_f32_32x32x16_bf16(wh[i], xh[i], acc, 0, 0, 0); acc = __builtin_amdgcn_mfma_f32_32x32x16_bf16(wl[i], xh[i], acc, 0, 0, 0); }
        }
        rs = row_rstd((const float*)(C.ws + WS_SSQB), t);
        float mine[12], oth[12];
#pragma unroll
        for (int r = 0; r < 12; ++r) { mine[r] = acc[r]; oth[r] = __shfl_xor(acc[r], 32); }
        float lg[20];
#pragma unroll
        for (int q = 0; q < 5; ++q)
#pragma unroll
            for (int e = 0; e < 4; ++e) { const int n = 4 * q + e;
                const float v0 = ((q & 1) == 0) ? mine[4 * (q >> 1) + e] : oth[4 * (q >> 1) + e], v1 = ((q & 1) == 0) ? oth[4 * (q >> 1) + e] : mine[4 * (q >> 1) + e];
                lg[n] = (hi == 0 ? v0 : v1) * rs; }
        float gl[4]; int gt = 0;
#pragma unroll
        for (int i = 0; i < 4; ++i) gl[i] = lg[i] + bg[i];
        float gm = gl[0];
#pragma unroll
        for (int i = 1; i < 4; ++i) if (gl[i] > gm) { gm = gl[i]; gt = i; }
        float gs = 0.f;
#pragma unroll
        for (int i = 0; i < 4; ++i) gs += __expf(gl[i] - gm);
        const float pg = 1.f / gs;
        float el[4];
#pragma unroll
        for (int i = 0; i < 4; ++i) { float v = 0.f;
#pragma unroll
            for (int gi = 0; gi < 4; ++gi) v = (gi == gt) ? lg[4 + 4 * gi + i] + be[gi * 4 + i] : v;
            el[i] = v; }
        int i1 = 0; float m1 = el[0];
#pragma unroll
        for (int i = 1; i < 4; ++i) if (el[i] > m1) { m1 = el[i]; i1 = i; }
        int i2 = -1; float m2 = -3.0e38f;
#pragma unroll
        for (int i = 0; i < 4; ++i) if (i != i1 && el[i] > m2) { m2 = el[i]; i2 = i; }
        const float e2 = __expf(m2 - m1); const float w1 = 1.f / (1.f + e2), w2 = e2 / (1.f + e2);
        const int lo = i1 < i2 ? i1 : i2, hi2 = i1 < i2 ? i2 : i1;
        const int pi = (lo == 0) ? (hi2 - 1) : (lo == 1 ? hi2 + 1 : 5);
        bk = gt * 6 + pi;
        glo = pg * (i1 < i2 ? w1 : w2); ghi = pg * (i1 < i2 ? w2 : w1);
        if (hi == 0) rank = (int)atomicAdd((unsigned*)(hist + bk), 1u);
    }
    __syncthreads();
    if (C.tid < NBUCKET) { const unsigned n = hist[C.tid]; hbase[C.tid] = n ? atomicAdd(cnt + C.tid, n) : 0u; }
    __syncthreads();
    if (C.wave < 4 && hi == 0) { const size_t li = C.dry ? (size_t)(T * 24) + (size_t)(t & 1023) : (size_t)bk * T + hbase[bk] + rank;
        ((int*)(C.ws + WS_BLIST))[li] = t; ((float*)(C.ws + WS_BGW0))[li] = glo; ((float*)(C.ws + WS_BGW1))[li] = ghi; ((float*)(C.ws + WS_BRS))[li] = rs; }
    __syncthreads();
}
__device__ __forceinline__ void phase_perm(const Ctx& C, int l) {
    const unsigned* cnt = (const unsigned*)(C.ws + WS_CTL) + CW_CNT + l * 32; unsigned* tileb = (unsigned*)(C.ws + WS_CTL) + CW_TILEB + l * 160;
    const int* m_bucket = (const int*)(C.ws + WS_META + MT_BUCKET); const int* m_pos = (const int*)(C.ws + WS_META + MT_POS);
    const float* m_gw0 = (const float*)(C.ws + WS_META + MT_GW0); const float* m_gw1 = (const float*)(C.ws + WS_META + MT_GW1); const float* m_rs = (const float*)(C.ws + WS_META + MT_RS2);
    const bf16_t* XB = (const bf16_t*)(C.ws + WS_XB); bf16_t* XS = (bf16_t*)(C.ws + WS_XS); int* stok = (int*)(C.ws + WS_META + MT_STOK) + l * MAXROWS;
    float* sgw0 = (float*)(C.ws + WS_META + MT_SGW0); float* sgw1 = (float*)(C.ws + WS_META + MT_SGW1); float* srs = (float*)(C.ws + WS_META + MT_SRS);
    const int lane = C.lane;
    int nt = (lane < NBUCKET) ? (((int)cnt[lane] + 255) >> 8) : 0, incl = nt;
#pragma unroll
    for (int o = 1; o < 32; o <<= 1) { const int v = __shfl_up(incl, o); if (lane >= o) incl += v; }
    const int excl = incl - nt;
    if (C.gw == 0) { if (lane < NBUCKET) for (int i = 0; i < nt; ++i) tileb[excl + i] = (unsigned)lane; if (lane == NBUCKET - 1) tileb[159] = (unsigned)incl; }
    for (int t = C.gw * 4; t < T; t += C.ngw * 4) {
        int dst[4]; u32x4 v[4][2];
#pragma unroll
        for (int j = 0; j < 4; ++j) { const int bk = m_bucket[t + j]; dst[j] = __shfl(excl, bk) * 256 + m_pos[t + j];
            const u32x4* src = (const u32x4*)(XB + (size_t)(t + j) * D) + lane; v[j][0] = src[0]; v[j][1] = src[64]; }
#pragma unroll
        for (int j = 0; j < 4; ++j) { u32x4* d = (u32x4*)(XS + (size_t)dst[j] * D) + lane; d[0] = v[j][0]; d[64] = v[j][1];
            if (lane == 0) { stok[dst[j]] = t + j; sgw0[dst[j]] = m_gw0[t + j]; sgw1[dst[j]] = m_gw1[t + j]; srs[dst[j]] = m_rs[t + j]; } }
    }
}

__device__ __forceinline__ void phase_prologue(const Ctx& C) {
    LAS float* scr = (LAS float*)(C.lds + C.wave * 16896);
    { const int l = 0; REPEAT(101, phase_prep_weights(C, scr)); }
    { const int l = 0; REPEAT(102, for (int it = C.gw; it < S5_ITEMS; it += C.ngw) s5_prep_item(C, it, scr)); }
    { bf16_t* rw = (bf16_t*)(C.ws + WS_ROUTEW);
      for (int i = C.gw * 64 + C.lane; i < DEPTH * 32 * D; i += C.ngw * 64) { const int l = i / (32 * D), n = (i / D) & 31, k = i & (D - 1);
          float v = 0.f;
          if (n < 4) v = gptr(C.in[22])[((size_t)l * D + k) * 4 + n]; else if (n < 20) v = gptr(C.in[24])[(((size_t)l * 4 + ((n - 4) >> 2)) * D + k) * 4 + ((n - 4) & 3)];
          v *= gptr(C.in[21])[l * D + k];
          const bf16_t h = f2bf(v); const size_t fo = (size_t)l * 65536 + (size_t)(((k >> 4) * 64 + ((k >> 3) & 1) * 32 + n) * 8 + (k & 7));
          rw[fo] = h; rw[fo + 32768] = f2bf(v - bf2f(h)); } }
    { const float* sw = gptr(C.in[4]); bf16_t* dw = (bf16_t*)(C.ws + WS_SGUW);
      for (int i = C.gw * 64 + C.lane; i < DEPTH * 65536 / 2; i += C.ngw * 64) ((unsigned*)dw)[i] = pk2(sw[2 * i], sw[2 * i + 1]); }
    { const int l = 0; REPEAT(103, phase_conv(C, gptr(C.in[0]))); }
}


#define XB_TMO      128
#define XB_XCNT(j)  (256  + 64 * (j))
#define XB_XSUB(j)  (1280 + 64 * (j))
#define XB_XGEN(j)  (2304 + 64 * (j))
#define XB_TOP      3328
#define XB_TOPGEN   3392
#define XCD_BAR_WORDS 3456
#define XB_SPIN_CAP (1u << 18)

__device__ __forceinline__ unsigned xb_ld(unsigned* p)              { return __hip_atomic_load(p, __ATOMIC_RELAXED, __HIP_MEMORY_SCOPE_AGENT); }
__device__ __forceinline__ unsigned xb_add(unsigned* p, unsigned v) { return __hip_atomic_fetch_add(p, v, __ATOMIC_RELAXED, __HIP_MEMORY_SCOPE_AGENT); }
__device__ __forceinline__ unsigned xb_xcc_id() { return (unsigned)__builtin_amdgcn_s_getreg((3 << 11) | 20) & 0xFu; }
#define XB_SPIN(cond, bar) do { unsigned _sp = 0; while (cond) { __builtin_amdgcn_s_sleep(1); \
    if ((++_sp & 255u) == 0u) { if (xb_ld(&(bar)[XB_TMO])) break; if (_sp > XB_SPIN_CAP) { atomicAdd(&(bar)[XB_TMO], 1u); break; } } } } while (0)

struct XcdBarrier {
    unsigned* bar; unsigned x;
    volatile LAS unsigned* st;
};

__device__ __forceinline__ XcdBarrier xcd_barrier_post(unsigned* bar, volatile LAS unsigned* st) {
    XcdBarrier b; b.bar = bar; b.x = xb_xcc_id(); b.st = st;
    if (threadIdx.x == 0) (void)xb_add(&bar[XB_XCNT(b.x)], 1u);
    return b;
}
__device__ __forceinline__ void xcd_barrier_complete(unsigned* bar, unsigned x, unsigned& nloc, unsigned& nx) {
    const unsigned G = gridDim.x * gridDim.y * gridDim.z;
    unsigned sum, cnt, mine, sp = 0u;
    for (;;) {
        sum = 0u; cnt = 0u; mine = 0u;
#pragma unroll
        for (unsigned j = 0; j < 16; ++j) { const unsigned c = xb_ld(&bar[XB_XCNT(j)]); sum += c; cnt += (c > 0u) ? 1u : 0u; mine = (j == x) ? c : mine; }
        if (sum == G) break;
        __builtin_amdgcn_s_sleep(1);
        if ((++sp & 255u) == 0u) { if (xb_ld(&bar[XB_TMO])) break; if (sp > XB_SPIN_CAP) { atomicAdd(&bar[XB_TMO], 1u); break; } }
    }
    nloc = mine > 0u ? mine : 1u; nx = cnt > 0u ? cnt : 1u;
}

__device__ __forceinline__ void xcd_barrier(const XcdBarrier& b) {
    asm volatile("s_waitcnt vmcnt(0)" ::: "memory");
    __syncthreads();
    if (threadIdx.x == 0) {
        unsigned* bar = b.bar;
        __builtin_amdgcn_s_waitcnt(0);
        unsigned nloc = b.st[0], nx = b.st[1];
        if (nloc == 0u) { xcd_barrier_complete(bar, b.x, nloc, nx); b.st[0] = nloc; b.st[1] = nx; }
        const unsigned old = xb_add(&bar[XB_XSUB(b.x)], 1u);
        const unsigned gen = old / nloc;
        if (old + 1u == (gen + 1u) * nloc) {
            __builtin_amdgcn_fence(__ATOMIC_RELEASE, "agent");
            asm volatile("s_waitcnt vmcnt(0)" ::: "memory");
            const unsigned og = xb_add(&bar[XB_TOP], 1u);
            const unsigned tg = og / nx;
            if (og + 1u == (tg + 1u) * nx) xb_add(&bar[XB_TOPGEN], 1u);
            else XB_SPIN(xb_ld(&bar[XB_TOPGEN]) == tg, bar);
            __builtin_amdgcn_fence(__ATOMIC_ACQUIRE, "agent");
            xb_add(&bar[XB_XGEN(b.x)], 1u);
            asm volatile("s_waitcnt vmcnt(0)" ::: "memory");
        } else {
            XB_SPIN(xb_ld(&bar[XB_XGEN(b.x)]) == gen, bar);
            __builtin_amdgcn_fence(__ATOMIC_ACQUIRE, "agent");
            asm volatile("s_waitcnt vmcnt(0)" ::: "memory");
        }
    }
    __syncthreads();
}

constexpr int PH_PER_LAYER = 6, N_PHASES = 1 + DEPTH * PH_PER_LAYER;
__global__ void __launch_bounds__(NTHREADS, 2) mk_fwd(KArgs args) {
    extern __shared__ __attribute__((aligned(16))) unsigned char lds_raw[];
    const int lo = args.ph_lo, hi = args.ph_hi;
    const int wave_s = __builtin_amdgcn_readfirstlane(threadIdx.x >> 6);
    if (threadIdx.x < 16) ((LAS unsigned*)(lds_raw + LDS_BARW))[threadIdx.x] = 0u;
    __syncthreads();
    cg::this_grid().sync();
    XcdBarrier bar = xcd_barrier_post((unsigned*)(args.ws + WS_CTL) + CW_BAR, (volatile LAS unsigned*)((LAS unsigned char*)lds_raw + LDS_BARW));
    int reps_left = REP_N - 1;
    for (int ph = lo; ph < hi; ++ph) {
        unsigned ones = ~0u; asm volatile("" : "+s"(ones));
        int tid = wave_s * 64 + (int)__builtin_amdgcn_mbcnt_hi(ones, __builtin_amdgcn_mbcnt_lo(ones, 0u)); asm volatile("" : "+v"(tid));
        GAS unsigned char* wsg = (GAS unsigned char*)args.ws; asm volatile("" : "+s"(wsg)); unsigned char* ws = (unsigned char*)wsg;
        Ctx C;
        C.lds = (LAS unsigned char*)lds_raw;
        C.in = args.in; { GAS float* og = (GAS float*)args.out; asm volatile("" : "+s"(og)); C.out = (float*)og; } C.ws = ws;
        C.tid = tid; C.lane = tid & 63; C.wave = __builtin_amdgcn_readfirstlane(tid >> 6);
        C.G = gridDim.x; C.gw = blockIdx.x * NWAVES + C.wave; C.ngw = C.G * NWAVES; C.dry = (ph == REP_PH && reps_left > 0);
        if (ph == 0) { const int l = 0; REPEAT(100, phase_prologue(C)); }
        else {
            const int l = (ph - 1) / PH_PER_LAYER, k = (ph - 1) % PH_PER_LAYER;
            const float* xres = (l == 0) ? gptr(args.in[0]) : (const float*)C.out;
            const unsigned* tileb = (const unsigned*)(ws + WS_CTL) + CW_TILEB + l * 160;
            if (k == 0) {
                if (l > 0) {
                    const float* ssqp = (const float*)(ws + WS_SSQP); float* rstd = (float*)(ws + WS_META + MT_RSTD);
                    for (int r0 = C.gw * 4; r0 < T; r0 += C.ngw * 4) { const int row = r0 + (C.lane >> 4); float v = ssqp[(size_t)row * 16 + (C.lane & 15)];
#pragma unroll
                        for (int o = 1; o < 16; o <<= 1) v += __shfl_xor(v, o);
                        if ((C.lane & 15) == 0) rstd[row] = 1.0f / sqrtf(v * (1.f / D) + EPS); }
                    xcd_barrier(bar);
                }
                DenseSched S; S.init(ws + WS_XB, (const bf16_t*)(ws + WS_WIN) + (size_t)l * NIN * D, T, NIN, D, C.G, (int)blockIdx.x);
                EpiIn E{(const float*)(ws + WS_META + MT_RSTD), (bf16_t*)(ws + WS_U), (bf16_t*)(ws + WS_QH), gptr(args.in[16]) + l * 64, gptr(args.in[17]) + l * 64};
                REPEAT(0, (pg8::gemm_phase<EpiIn, DenseSched, true, true>(C.lds, D, S, E, C.tid)));
            } else if (k == 1) {
                for (int it = C.gw; it < BATCH * 32 * 16; it += C.ngw) s5a_item(C, l, it);
                unsigned* s5cnt = (unsigned*)(ws + WS_CTL) + CW_S5A + l;
                asm volatile("s_waitcnt vmcnt(0)" ::: "memory");
                __syncthreads();
                if (threadIdx.x == 0) { __builtin_amdgcn_fence(__ATOMIC_RELEASE, "agent"); asm volatile("s_waitcnt vmcnt(0)" ::: "memory"); (void)xb_add(s5cnt, 1u); }
                const int half = C.G >> 1, nit = BATCH * NH * (SEQ / 256), nA = (nit * 5) >> 3;
                const bool sblk = (int)blockIdx.x < half; const int bx = sblk ? (int)blockIdx.x : (int)blockIdx.x - half;
                if (!sblk) { for (int it = bx; it < T / 128; it += half) sgu_item(C, l, it); }
                const int bxv = ((half & 7) == 0) ? (bx & 7) * (half >> 3) + (bx >> 3) : bx;
                phase_attn(C, l, sblk ? nA + bxv : bxv, half, sblk ? nit : nA);
                if (sblk) {
                    if (threadIdx.x == 0) { XB_SPIN(xb_ld(s5cnt) < (unsigned)C.G, (unsigned*)(ws + WS_CTL) + CW_BAR); __builtin_amdgcn_fence(__ATOMIC_ACQUIRE, "agent"); asm volatile("s_waitcnt vmcnt(0)" ::: "memory"); }
                    __syncthreads();
                    for (int it = blockIdx.x; it < BATCH * 32; it += half) s5c_item(C, l, it); }
            } else if (k == 2) {
                DenseSched S; S.init(ws + WS_O, (const bf16_t*)(ws + WS_WOUT) + (size_t)l * D * D, T, D, D, C.G, (int)blockIdx.x);
                EpiOut E{(bf16_t*)(ws + WS_XB), (float*)(ws + WS_SSQB), C.dry ? (size_t)((WS_XS - WS_XB) / 2) : (size_t)0};
                REPEAT(3, (pg8::gemm_phase<EpiOut, DenseSched, true, true>(C.lds, D, S, E, C.tid)));
            } else if (k == 3) {
                for (int it = blockIdx.x; it < T / 128; it += C.G) route_block(C, l, it);
            } else if (k == 4) {
                build_tile_table(C, l);
                TileTab tt{(const LAS int*)(C.lds + TB_OFF)};
                GroupSched S{(const char*)(ws + WS_XB), (const char*)((const bf16_t*)(ws + WS_WGU) + (size_t)l * 16 * 512 * D), tt, (const int*)(ws + WS_BLIST), tt.ntiles(), C.G, (int)blockIdx.x, 1, (size_t)0};
                EpiG1 E{tt, (const float*)(ws + WS_BGW0), (const float*)(ws + WS_BGW1), (const float*)(ws + WS_BRS), (bf16_t*)(ws + WS_H)};
                REPEAT(6, (pg8::gemm_phase<EpiG1, GroupSched, true, true, true>(C.lds, D, S, E, C.tid)));
            } else {
                build_tile_table(C, l);
                TileTab tt{(const LAS int*)(C.lds + TB_OFF)};
                GroupSched S{(const char*)(ws + WS_H), (const char*)((const bf16_t*)(ws + WS_WDN) + (size_t)l * NBUCKET * D * 512), tt, (const int*)(ws + WS_BLIST), tt.ntiles(), C.G, (int)blockIdx.x, 2, (size_t)256 * 512 * 2};
                if (l + 1 < DEPTH) { EpiG2<true> E{tt, (const int*)(ws + WS_BLIST), C.out, (bf16_t*)(ws + WS_XB), (float*)(ws + WS_SSQP), C.dry ? (size_t)((WS_XS - WS_XB) / 2) : (size_t)0};
                    pg8::gemm_phase<EpiG2<true>, GroupSched, true, true>(C.lds, 512, S, E, C.tid); }
                else { EpiG2<false> E{tt, (const int*)(ws + WS_BLIST), C.out, (bf16_t*)(ws + WS_XB), nullptr, (size_t)0};
                    pg8::gemm_phase<EpiG2<false>, GroupSched, true, true>(C.lds, 512, S, E, C.tid); }
            }
        }
        if (ph == REP_PH && reps_left > 0) { --reps_left; --ph; }
        if (ph + 1 < hi) xcd_barrier(bar);
    }
}

extern "C" void kernel_launch(void* const* d_in, const int* in_sizes, int n_in, void* d_out, int out_size, void* d_ws, size_t ws_size, hipStream_t stream) {
    static int grid = 0;
    if (grid == 0) {
        if (n_in != 29 || ws_size < WS_END) { fprintf(stderr, "kernel_launch: unexpected inputs (n_in %d, ws %zu)\n", n_in, ws_size); grid = -1; return; }
        int dev = 0, cus = 0, per_cu = 0;
        (void)hipGetDevice(&dev); (void)hipDeviceGetAttribute(&cus, hipDeviceAttributeMultiprocessorCount, dev);
        if (hipFuncSetAttribute((const void*)mk_fwd, hipFuncAttributeMaxDynamicSharedMemorySize, LDS_BYTES) != hipSuccess) { fprintf(stderr, "kernel_launch: hipFuncSetAttribute failed\n"); grid = -1; return; }
        if (hipOccupancyMaxActiveBlocksPerMultiprocessor(&per_cu, (const void*)mk_fwd, NTHREADS, LDS_BYTES) != hipSuccess || per_cu < 1) { fprintf(stderr, "kernel_launch: occupancy query says %d blocks/CU\n", per_cu); per_cu = 1; }
        (void)hipGetLastError();
        grid = cus * (per_cu > 1 ? 1 : per_cu);
        fprintf(stderr, "kernel_launch: grid %d (cus %d, per_cu %d)\n", grid, cus, per_cu);
    }
    if (grid < 0) return;
    (void)hipMemsetAsync((char*)d_ws + WS_CTL, 0, 1 * MiB, stream);
    KArgs a{};
    for (int i = 0; i < 29; ++i) a.in[i] = (const float*)d_in[i];
    a.out = (float*)d_out; a.ws = (unsigned char*)d_ws;
#if MK_ONE_LAUNCH
    a.ph_lo = 0; a.ph_hi = N_PHASES;
    void* kargs[] = {&a};
    hipError_t e = hipLaunchCooperativeKernel((const void*)mk_fwd, dim3(grid), dim3(NTHREADS), kargs, LDS_BYTES, stream);
    if (e != hipSuccess) fprintf(stderr, "cooperative launch failed: %s (grid %d)\n", hipGetErrorString(e), grid);
#else
    for (int p = 0; p < N_PHASES - 1; ++p) { a.ph_lo = p; a.ph_hi = p + 1; hipLaunchKernelGGL(mk_fwd, dim3(grid), dim3(NTHREADS), LDS_BYTES, stream, a); }
#endif
}
```

```cpp
#include <hip/hip_runtime.h>
#include <hip/hip_cooperative_groups.h>
#include <cstdint>
#include <cstdio>
namespace cg = cooperative_groups;

#ifndef MK_ONE_LAUNCH
#define MK_ONE_LAUNCH 1
#endif

namespace pg8 {
#define PG8_LAS __attribute__((address_space(3)))
typedef unsigned short bf16_t;
typedef short bf16x8 __attribute__((ext_vector_type(8)));
typedef float f32x4 __attribute__((ext_vector_type(4)));
typedef unsigned u32x4 __attribute__((ext_vector_type(4)));
constexpr int BM = 256, BK = 64, HALF = 128, HTB = HALF * BK * 2  , STAGE_BYTES = 8 * HTB, NXCD = 8, WGM = 8;
__host__ __device__ __forceinline__ int lds_byte(int r, int c) { const int st = (r >> 4) * 2 + (c >> 5), rr = r & 15, cc = c & 31, ob = rr * 64 + cc * 2; return st * 1024 + (ob ^ (((ob >> 9) & 1) << 5)); }
__host__ __device__ __forceinline__ void stage_rc(int b, int& R, int& C) { const int st = b / 1024, sb = b % 1024, swz = sb ^ (((sb >> 9) & 1) << 5); R = (st >> 1) * 16 + swz / 64; C = (st & 1) * 32 + (swz % 64) / 2; }
__host__ __device__ __forceinline__ int perm32(int rho) { const int n = rho >> 4, i = rho & 15; return 8 * (i >> 2) + 4 * n + (i & 3); }
struct Unit { int pm, pn, hf; };
__device__ __forceinline__ unsigned cvt_pk_bf16(float lo, float hi) { unsigned r; asm volatile("v_cvt_pk_bf16_f32 %0, %1, %2" : "=v"(r) : "v"(lo), "v"(hi)); return r; }
template <class Epi, class Sched, bool ALIGN_EPI = false, bool SP2 = false, bool GATHER = false>
__device__ __forceinline__ void gemm_phase(PG8_LAS unsigned char* lds, const int gK, const Sched& S, const Epi& E, const int tid) {
    const int wid = __builtin_amdgcn_readfirstlane(tid >> 6), lane = tid & 63, wr = wid >> 2, wc = wid & 3, fr = lane & 15, fq = lane >> 4;
    const int K = gK, nt = K / BK;
    unsigned voffA[2], voffB[2];
#pragma unroll
    for (int i = 0; i < 2; ++i) { int R, C; stage_rc(tid * 16 + i * 8192, R, C); const int Rb = Epi::PERM ? ((R & ~31) + perm32(R & 31)) : R;
        voffA[i] = (unsigned)(R * K + C) * 2u; voffB[i] = (unsigned)(Rb * K + C) * 2u; }
    unsigned gA[2], gN[2], gcol[2];
    if constexpr (GATHER) { _Pragma("unroll") for (int i = 0; i < 2; ++i) { int R_, C_; stage_rc(tid * 16 + i * 8192, R_, C_); gcol[i] = (unsigned)C_ * 2u; } }
#define PG8_GLOAD(dst, unit) do { _Pragma("unroll") for (int _h = 0; _h < 2; ++_h) { int R0_, R1_, C_; stage_rc(tid * 16, R0_, C_); stage_rc(tid * 16 + 8192, R1_, C_); \
        dst[_h] = (unsigned)S.a_row(unit, R0_ + 128 * _h) | ((unsigned)S.a_row(unit, R1_ + 128 * _h) << 16); } } while (0)
#define PG8_STAGE_A(bufoff, gbase, half, isnext) do { if constexpr (GATHER) { const unsigned g_ = (isnext) ? gN[half] : gA[half]; \
            unsigned vv_[2] = {(g_ & 0xffffu) * (unsigned)(K * 2) + gcol[0], (g_ >> 16) * (unsigned)(K * 2) + gcol[1]}; PG8_STAGE(bufoff, gbase, vv_); } \
        else { PG8_STAGE(bufoff, (gbase) + (half) * hstep, voffA); } } while (0)
    const size_t kstep = (size_t)(BK * 2);
    const size_t hstep = (size_t)HALF * K * 2;
    const unsigned ldsw = (unsigned)wid * 1024u;
    const int aoff = lds_byte(wr * 64 + fr, fq * 8), boff = lds_byte(wc * 32 + fr, fq * 8);
#define PG8_SA(b, h) (((b) * 2 + (h)) * HTB)
#define PG8_SB(b, h) ((4 + (b) * 2 + (h)) * HTB)
#define PG8_STAGE(bufoff, gbase, voff) do { _Pragma("unroll") for (int _i = 0; _i < 2; ++_i) \
        __builtin_amdgcn_global_load_lds((const unsigned*)((const char*)(gbase) + (voff)[_i]), (PG8_LAS unsigned*)(lds + (bufoff) + ldsw + _i * 8192), 16, 0, 0); } while (0)
#define PG8_LDA(dst, b, h) do { _Pragma("unroll") for (int m = 0; m < 4; ++m) _Pragma("unroll") for (int k = 0; k < 2; ++k) dst[m][k] = *(const PG8_LAS bf16x8*)(lds + PG8_SA(b, h) + aoff + m * 2048 + k * 1024); } while (0)
#define PG8_LDB(dst, b, h) do { _Pragma("unroll") for (int n = 0; n < 2; ++n) _Pragma("unroll") for (int k = 0; k < 2; ++k) dst[n][k] = *(const PG8_LAS bf16x8*)(lds + PG8_SB(b, h) + boff + n * 2048 + k * 1024); } while (0)
#define PG8_MMA(ai, bj, At, Bt) do { __builtin_amdgcn_s_setprio(1); _Pragma("unroll") for (int m = 0; m < 4; ++m) _Pragma("unroll") for (int n = 0; n < 2; ++n) _Pragma("unroll") for (int k = 0; k < 2; ++k) \
        acc[ai][bj][m][n] = __builtin_amdgcn_mfma_f32_16x16x32_bf16(Bt[n][k], At[m][k], acc[ai][bj][m][n], 0, 0, 0); __builtin_amdgcn_s_setprio(0); } while (0)
#define PG8_WAIT_V(n) asm volatile("s_waitcnt vmcnt(" #n ")" ::: "memory")
#define PG8_WAIT_L(n) asm volatile("s_waitcnt lgkmcnt(" #n ")" ::: "memory")
#define PG8_BAR __builtin_amdgcn_s_barrier()
#define PG8_SCHED __builtin_amdgcn_sched_barrier(0)
    Unit cur, nxt; int ui = 0;
    if (!S.next(0, cur)) return;
    f32x4 acc[2][2][4][2];
#pragma unroll
    for (int a = 0; a < 2; ++a)
#pragma unroll
        for (int b = 0; b < 2; ++b)
#pragma unroll
            for (int m = 0; m < 4; ++m)
#pragma unroll
                for (int n = 0; n < 2; ++n) acc[a][b][m][n] = (f32x4){0.f, 0.f, 0.f, 0.f};
    bf16x8 At[4][2], B0[2][2], B1[2][2];
    const char* cA = S.a_base(cur); const char* cB = S.b_base(cur);
    S.a_ready(cur);
    if constexpr (GATHER) PG8_GLOAD(gA, cur);
    if constexpr (SP2) {
        PG8_STAGE(PG8_SB(0, 0), cB, voffB); PG8_STAGE(PG8_SB(0, 1), cB + hstep, voffB); PG8_STAGE_A(PG8_SA(0, 0), cA, 0, false); PG8_STAGE_A(PG8_SA(0, 1), cA, 1, false);
        if (wr == 1) PG8_BAR;
        PG8_WAIT_V(2); PG8_BAR;
        PG8_STAGE(PG8_SB(1, 0), cB + kstep, voffB); PG8_STAGE_A(PG8_SA(1, 0), cA + kstep, 0, false); PG8_STAGE(PG8_SB(1, 1), cB + hstep + kstep, voffB);
        PG8_WAIT_V(6); PG8_BAR;
    } else {
        PG8_STAGE(PG8_SB(0, 0), cB, voffB); PG8_STAGE(PG8_SA(0, 0), cA, voffA); PG8_STAGE(PG8_SB(0, 1), cB + hstep, voffB); PG8_STAGE(PG8_SA(0, 1), cA + hstep, voffA);
        if (wr == 1) PG8_BAR;
        PG8_WAIT_V(4); PG8_BAR;
        PG8_STAGE(PG8_SB(1, 0), cB + kstep, voffB); PG8_STAGE(PG8_SA(1, 0), cA + kstep, voffA); PG8_STAGE(PG8_SB(1, 1), cB + hstep + kstep, voffB);
        PG8_WAIT_V(6); PG8_BAR;
    }
    for (;;) {
        const bool has_next = S.next(ui + 1, nxt);
        if constexpr (GATHER) { if (has_next) { PG8_GLOAD(gN, nxt); asm volatile("s_waitcnt vmcnt(0)" ::: "memory");
            asm volatile("" : "+v"(gN[0]), "+v"(gN[1])); } }
        const char* nA = has_next ? S.a_base(nxt) : cA; const char* nB = has_next ? S.b_base(nxt) : cB;
        for (int t = 0; t < nt; t += 2) {
            const bool last = (t == nt - 2); const bool lastnext = last && has_next; (void)lastnext; const bool fullu = (cur.hf == 0);
            const char* a1 = cA + (size_t)(t + 1) * kstep;
            const char* a2 = last ? nA : cA + (size_t)(t + 2) * kstep; const char* b2 = last ? nB : cB + (size_t)(t + 2) * kstep;
            const char* a3 = a2 + kstep; const char* b3 = b2 + kstep;
            if (last && has_next) S.a_ready(nxt);
            if constexpr (SP2) {
            PG8_LDB(B0, 0, 0); PG8_LDB(B1, 0, 1); PG8_SCHED; PG8_LDA(At, 0, 0); PG8_STAGE_A(PG8_SA(1, 1), a1, 1, false);
            PG8_WAIT_V(8); PG8_WAIT_L(0); PG8_BAR; PG8_MMA(0, 0, At, B0); PG8_MMA(0, 1, At, B1); PG8_BAR; PG8_SCHED;
            PG8_LDA(At, 0, 1); PG8_STAGE(PG8_SB(0, 0), b2, voffB); PG8_STAGE(PG8_SB(0, 1), b2 + hstep, voffB); PG8_STAGE_A(PG8_SA(0, 0), a2, 0, lastnext);
            PG8_WAIT_V(8); PG8_WAIT_L(0); PG8_BAR; if (fullu) { PG8_MMA(1, 0, At, B0); PG8_MMA(1, 1, At, B1); } PG8_BAR; PG8_SCHED;
            PG8_LDB(B0, 1, 0); PG8_LDB(B1, 1, 1); PG8_SCHED; PG8_LDA(At, 1, 0); PG8_STAGE_A(PG8_SA(0, 1), a2, 1, lastnext);
            PG8_WAIT_V(8); PG8_WAIT_L(0); PG8_BAR; PG8_MMA(0, 0, At, B0); PG8_MMA(0, 1, At, B1); PG8_BAR; PG8_SCHED;
            PG8_LDA(At, 1, 1); PG8_STAGE(PG8_SB(1, 0), b3, voffB); PG8_STAGE(PG8_SB(1, 1), b3 + hstep, voffB); PG8_STAGE_A(PG8_SA(1, 0), a3, 0, lastnext);
            PG8_WAIT_V(8); PG8_WAIT_L(0); PG8_BAR; if (fullu) { PG8_MMA(1, 0, At, B0); PG8_MMA(1, 1, At, B1); } PG8_BAR; PG8_SCHED;
            } else {
            PG8_LDB(B0, 0, 0); PG8_SCHED; PG8_LDA(At, 0, 0); PG8_STAGE(PG8_SA(1, 1), a1 + hstep, voffA);
            PG8_WAIT_L(8); PG8_BAR; PG8_WAIT_L(0); PG8_MMA(0, 0, At, B0); PG8_BAR; PG8_SCHED;
            PG8_LDB(B1, 0, 1); PG8_STAGE(PG8_SB(0, 0), b2, voffB);
            PG8_BAR; PG8_WAIT_L(0); PG8_MMA(0, 1, At, B1); PG8_BAR;
            PG8_LDA(At, 0, 1); PG8_STAGE(PG8_SA(0, 0), a2, voffA);
            PG8_BAR; PG8_WAIT_L(0); PG8_MMA(1, 0, At, B0); PG8_BAR; PG8_SCHED;
            PG8_STAGE(PG8_SB(0, 1), b2 + hstep, voffB);
            PG8_WAIT_V(6); PG8_BAR; PG8_MMA(1, 1, At, B1); PG8_BAR;
            PG8_LDB(B0, 1, 0); PG8_SCHED; PG8_LDA(At, 1, 0); PG8_STAGE(PG8_SA(0, 1), a2 + hstep, voffA);
            PG8_WAIT_L(8); PG8_BAR; PG8_WAIT_L(0); PG8_MMA(0, 0, At, B0); PG8_BAR; PG8_SCHED;
            PG8_LDB(B1, 1, 1); PG8_STAGE(PG8_SB(1, 0), b3, voffB);
            PG8_BAR; PG8_WAIT_L(0); PG8_MMA(0, 1, At, B1); PG8_BAR;
            PG8_LDA(At, 1, 1); PG8_STAGE(PG8_SA(1, 0), a3, voffA);
            PG8_BAR; PG8_WAIT_L(0); PG8_MMA(1, 0, At, B0); PG8_BAR; PG8_SCHED;
            PG8_STAGE(PG8_SB(1, 1), b3 + hstep, voffB);
            PG8_WAIT_V(6); PG8_BAR; PG8_MMA(1, 1, At, B1); PG8_BAR;
            }
        }
        if constexpr (ALIGN_EPI) { if (wr == 0) PG8_BAR; }
        if constexpr (!Epi::AFTER_DRAIN) { E(acc, cur, wr, wc, fr, fq); S.done(cur); }
        if (!has_next) break;
#pragma unroll
        for (int a = 0; a < 2; ++a)
#pragma unroll
            for (int b = 0; b < 2; ++b)
#pragma unroll
                for (int m = 0; m < 4; ++m)
#pragma unroll
                    for (int n = 0; n < 2; ++n) acc[a][b][m][n] = (f32x4){0.f, 0.f, 0.f, 0.f};
        cur = nxt; cA = nA; cB = nB; ++ui;
        if constexpr (GATHER) { gA[0] = gN[0]; gA[1] = gN[1]; }
        if constexpr (ALIGN_EPI) { if (wr == 1) PG8_BAR; }
    }
    PG8_WAIT_V(0);
    if constexpr (!ALIGN_EPI) { if (wr == 0) PG8_BAR; }
    PG8_BAR;
    if constexpr (Epi::AFTER_DRAIN) { E.fused(acc, cur, wr, wc, fr, fq, lds, wid, lane); S.done(cur); }
#undef PG8_SA
#undef PG8_GLOAD
#undef PG8_STAGE_A
#undef PG8_SB
#undef PG8_STAGE
#undef PG8_LDA
#undef PG8_LDB
#undef PG8_MMA
#undef PG8_WAIT_V
#undef PG8_WAIT_L
#undef PG8_BAR
#undef PG8_SCHED
}
}

typedef unsigned short bf16_t;
typedef unsigned u32x4 __attribute__((ext_vector_type(4)));
typedef float f32x4 __attribute__((ext_vector_type(4)));
#define LAS __attribute__((address_space(3)))

constexpr int BATCH = 4, SEQ = 8192, T = BATCH * SEQ, D = 1024, NIN = 2304, DEPTH = 2;
constexpr int NH = 8;
constexpr int NBUCKET = 24, MAXTILES = 152, MAXROWS = MAXTILES * 256;
constexpr float EPS = 1e-6f;
constexpr float LOG2E = 1.4426950408889634f;
constexpr int NWAVES = 8, NTHREADS = 512;
constexpr int LDS_BYTES = 155648;
constexpr int LDS_BARW = LDS_BYTES - 64;

constexpr size_t MiB = 1u << 20;
constexpr size_t WS_CTL = 0;
constexpr size_t WS_WIN = 1 * MiB;
constexpr size_t WS_WOUT = 10 * MiB;
constexpr size_t WS_WGU = 14 * MiB;
constexpr size_t WS_WDN = 46 * MiB;
constexpr size_t WS_GLU = 94 * MiB;
constexpr size_t WS_S5 = 95 * MiB;
constexpr size_t S5_M1 = 0, S5_M2P = 1 * MiB, S5_TT = 2 * MiB, S5_AP16 = 2 * MiB + 256 * 1024, S5_AP256 = 2 * MiB + 512 * 1024, S5_LAYER = 4 * MiB;
constexpr size_t WS_S5F = WS_S5 + 8 * MiB;
constexpr size_t WS_SGUW = 94 * MiB + 512 * 1024;
constexpr size_t WS_ROUTEW = 105 * MiB;
constexpr size_t WS_XB = 106 * MiB;
constexpr size_t WS_META = 170 * MiB;
constexpr size_t WS_PROJ = 172 * MiB;
constexpr size_t WS_U = WS_PROJ, WS_V = WS_PROJ + 16 * MiB, WS_ZS = WS_PROJ + 32 * MiB;
constexpr size_t WS_QH = WS_PROJ + 48 * MiB, WS_KH = WS_PROJ + 80 * MiB, WS_VH = WS_PROJ + 112 * MiB;
constexpr size_t WS_XS = WS_PROJ;
constexpr size_t WS_H = WS_PROJ + 76 * MiB;
constexpr size_t WS_O = 316 * MiB;
constexpr size_t WS_YG = 380 * MiB;
constexpr size_t WS_SSQP = 380 * MiB;
constexpr size_t WS_SSQB = 382 * MiB;
constexpr size_t WS_BLIST = 384 * MiB;
constexpr size_t WS_BGW0 = 388 * MiB, WS_BGW1 = 392 * MiB, WS_BRS = 396 * MiB;
constexpr size_t WS_END = 412 * MiB;
constexpr size_t MT_RSTD = 0;
constexpr size_t MT_VR = 128 * 1024;
constexpr size_t MT_BUCKET = 256 * 1024;
constexpr size_t MT_POS = 384 * 1024;
constexpr size_t MT_GW0 = 512 * 1024;
constexpr size_t MT_GW1 = 640 * 1024;
constexpr size_t MT_RS2 = 768 * 1024;
constexpr size_t MT_STOK = 896 * 1024;
constexpr size_t MT_SGW0 = 1216 * 1024;
constexpr size_t MT_SGW1 = 1408 * 1024;
constexpr size_t MT_SRS = 1600 * 1024;
constexpr int CW_S5A = 48;
constexpr int CW_CNT = 64;
constexpr int CW_BAR = 4096;
constexpr int CW_TILEB = 256;

__device__ __forceinline__ float bf2f(bf16_t v) { return __uint_as_float(((unsigned)v) << 16); }
__device__ __forceinline__ bf16_t f2bf(float f) { unsigned u = __float_as_uint(f); return (bf16_t)((u + 0x7fffu + ((u >> 16) & 1u)) >> 16); }
__device__ __forceinline__ unsigned pk2(float lo, float hi) { return pg8::cvt_pk_bf16(lo, hi); }
__device__ __forceinline__ float fast_sigmoid_mul(float x, float z) { return x * __builtin_amdgcn_rcpf(1.f + __expf(-z)); }
__device__ __forceinline__ float gelu_tanh(float x) { const float u = 0.7978845608028654f * (x + 0.044715f * x * x * x); return fast_sigmoid_mul(x, 2.f * u); }
__device__ __forceinline__ float wave_sum(float v) {
#pragma unroll
    for (int o = 1; o < 64; o <<= 1) v += __shfl_xor(v, o);
    return v;
}
__device__ __forceinline__ float wave_max(float v) {
#pragma unroll
    for (int o = 1; o < 64; o <<= 1) v = fmaxf(v, __shfl_xor(v, o));
    return v;
}
#define GAS __attribute__((address_space(1)))
template <class Tp> __device__ __forceinline__ Tp* opaque(Tp* q) { GAS Tp* g = (GAS Tp*)q; asm volatile("" : "+v"(g)); return (Tp*)g; }
__device__ __forceinline__ const float* gptr(const float* q) { const GAS float* g = (const GAS float*)q; asm("" : "+s"(g)); return (const float*)g; }
__device__ __forceinline__ int pair_lo(int pi) { return pi < 3 ? 0 : (pi < 5 ? 1 : 2); }
__device__ __forceinline__ int pair_hi(int pi) { return pi < 3 ? pi + 1 : (pi < 5 ? pi - 1 : 3); }

#ifndef REP_ID
#define REP_ID -1
#endif
#ifndef REP_N
#define REP_N 4
#endif
#ifndef REP_PH
#define REP_PH -1
#endif
#define REPEAT(id, body) do { const int nrep_ = (REP_ID == (id) && l == 0) ? REP_N : 1; for (int rep_ = 0; rep_ < nrep_; ++rep_) { body; } } while (0)

struct KArgs { const float* in[29]; float* out; unsigned char* ws; int ph_lo, ph_hi; };

struct Ctx {
    LAS unsigned char* lds;
    const float* const* in; float* out; unsigned char* ws;
    int tid, lane, wave, gw, ngw, G;
    bool dry;
};

__host__ __device__ __forceinline__ int inproj_row_of_col(int n) {
    if (n < 768) return n;
    const int pn = n >> 8, r = n & 255, wc = r >> 6, bj = (r >> 5) & 1, i = r & 31;
    return pn * 256 + bj * 128 + wc * 32 + i;
}
struct TDesc { const float* W; const float* scale; bf16_t* WT; int N, ldk, koff, k0, n0, rowmode; };
struct TRegs { f32x4 v[16]; float s[16]; };
__device__ __forceinline__ void tr_load(const TDesc& d, TRegs& r, int lane) {
    const int kr = lane >> 4, c4 = (lane & 15) * 4;
#pragma unroll
    for (int i = 0; i < 16; ++i) { r.v[i] = *(const f32x4*)(d.W + (size_t)(d.k0 + 4 * i + kr) * d.N + d.n0 + c4); r.s[i] = d.scale ? d.scale[d.k0 + 4 * i + kr] : 1.f; }
}
__device__ __forceinline__ void tr_finish(const TDesc& d, const TRegs& r, LAS float* scr, int lane) {
    const int kr = lane >> 4, c4 = (lane & 15) * 4;
#pragma unroll
    for (int i = 0; i < 16; ++i) { const int kk = 4 * i + kr; const float s = r.s[i];
        LAS float* q = scr + kk * 65 + c4; q[0] = r.v[i].x * s; q[1] = r.v[i].y * s; q[2] = r.v[i].z * s; q[3] = r.v[i].w * s; }
    asm volatile("s_waitcnt lgkmcnt(0)" ::: "memory");
    const int c = lane & 7;
#pragma unroll
    for (int j = 0; j < 8; ++j) {
        const int nl = (lane >> 3) + 8 * j; const LAS float* s = scr + (8 * c) * 65 + nl;
        u32x4 o; o.x = pk2(s[0 * 65], s[1 * 65]); o.y = pk2(s[2 * 65], s[3 * 65]); o.z = pk2(s[4 * 65], s[5 * 65]); o.w = pk2(s[6 * 65], s[7 * 65]);
        const int n = d.n0 + nl; int row;
        if (d.rowmode == 0) row = n;
        else if (d.rowmode == 1) row = inproj_row_of_col(n);
        else if (d.rowmode == 2) row = 256 * (n >> 7) + (n & 127);
        else row = 256 * (n >> 7) + 128 + (n & 127);
        if (d.rowmode == 4) { const int k8 = (d.k0 >> 3) + c;
            *(u32x4*)(d.WT + ((size_t)(((n >> 5) * 16 + (k8 >> 1)) * 64 + (k8 & 1) * 32 + (n & 31))) * 8) = o; }
        else *(u32x4*)(d.WT + (size_t)row * d.ldk + d.koff + d.k0 + 8 * c) = o;
    }
    asm volatile("s_waitcnt lgkmcnt(0)" ::: "memory");
}
constexpr int IT_WIN = 16 * 36, IT_WOUT = 16 * 16, IT_WGU1 = 16 * 4, IT_WDN1 = 4 * 16, IT_GLU = 4 * 4;
constexpr int IT_L = IT_WIN + IT_WOUT + 16 * 2 * IT_WGU1 + NBUCKET * 2 * IT_WDN1 + IT_GLU;
constexpr int IT_TOTAL = DEPTH * IT_L;
__device__ __forceinline__ TDesc prep_desc(const Ctx& C, int it) {
    const int l = it / IT_L; int r = it % IT_L;
    unsigned char* ws = C.ws; TDesc d;
    if (r < IT_WIN) { const int kb = r / 36, nb = r % 36;
        d = TDesc{gptr(C.in[2]) + (size_t)l * D * NIN, gptr(C.in[1]) + l * D, (bf16_t*)(ws + WS_WIN) + (size_t)l * NIN * D, NIN, D, 0, kb * 64, nb * 64, 1}; return d; }
    r -= IT_WIN;
    if (r < IT_WOUT) { const int kb = r / 16, nb = r % 16;
        d = TDesc{gptr(C.in[20]) + (size_t)l * D * D, gptr(C.in[19]) + l * D, (bf16_t*)(ws + WS_WOUT) + (size_t)l * D * D, D, D, 0, kb * 64, nb * 64, 0}; return d; }
    r -= IT_WOUT;
    if (r < 16 * 2 * IT_WGU1) { const int e = r / (2 * IT_WGU1), q = r % (2 * IT_WGU1), isup = q / IT_WGU1, t = q % IT_WGU1, kb = t / 4, nb = t % 4;
        const float* W = (isup ? gptr(C.in[27]) : gptr(C.in[26])) + ((size_t)l * 16 + e) * D * 256;
        d = TDesc{W, gptr(C.in[21]) + l * D, (bf16_t*)(ws + WS_WGU) + ((size_t)l * 16 + e) * 512 * D, 256, D, 0, kb * 64, nb * 64, isup ? 3 : 2}; return d; }
    r -= 16 * 2 * IT_WGU1;
    if (r < NBUCKET * 2 * IT_WDN1) { const int bk = r / (2 * IT_WDN1), q = r % (2 * IT_WDN1), slot = q / IT_WDN1, t = q % IT_WDN1, kb = t / 16, nb = t % 16;
        const int g = bk / 6, pi = bk % 6, e = 4 * g + (slot ? pair_hi(pi) : pair_lo(pi));
        d = TDesc{gptr(C.in[28]) + ((size_t)l * 16 + e) * 256 * D, nullptr, (bf16_t*)(ws + WS_WDN) + ((size_t)l * NBUCKET + bk) * D * 512, D, 512, slot * 256, kb * 64, nb * 64, 0}; return d; }
    r -= NBUCKET * 2 * IT_WDN1;
    { const int kb = r / 4, nb = r % 4;
        d = TDesc{gptr(C.in[14]) + (size_t)l * 256 * 256, nullptr, (bf16_t*)(ws + WS_GLU) + (size_t)l * 256 * 256, 256, 256, 0, kb * 64, nb * 64, 4}; return d; }
}
__device__ __forceinline__ void phase_prep_weights(const Ctx& C, LAS float* scr) {
    TDesc d0, d1; TRegs r0, r1;
    int it = C.gw; bool h0 = it < IT_TOTAL;
    if (h0) { d0 = prep_desc(C, it); tr_load(d0, r0, C.lane); }
    while (h0) {
        const int it1 = it + C.ngw; const bool h1 = it1 < IT_TOTAL;
        if (h1) { d1 = prep_desc(C, it1); tr_load(d1, r1, C.lane); }
        tr_finish(d0, r0, scr, C.lane);
        if (!h1) break;
        const int it2 = it1 + C.ngw; h0 = it2 < IT_TOTAL;
        if (h0) { d0 = prep_desc(C, it2); tr_load(d0, r0, C.lane); }
        tr_finish(d1, r1, scr, C.lane);
        it = it2;
    }
}
__device__ __forceinline__ void conv_row(const float* xrow, bf16_t* orow, float* rstd_out, int lane) {
    const f32x4* xr = (const f32x4*)xrow + lane;
    f32x4 v[4]; float s = 0.f;
#pragma unroll
    for (int j = 0; j < 4; ++j) { v[j] = xr[64 * j]; s += (v[j].x * v[j].x + v[j].y * v[j].y) + (v[j].z * v[j].z + v[j].w * v[j].w); }
    s = wave_sum(s);
    if (lane == 0) *rstd_out = 1.0f / sqrtf(s * (1.f / D) + EPS);
    unsigned long long* o8 = (unsigned long long*)orow + lane;
#pragma unroll
    for (int j = 0; j < 4; ++j) o8[64 * j] = (unsigned long long)pk2(v[j].x, v[j].y) | ((unsigned long long)pk2(v[j].z, v[j].w) << 32);
}
__device__ __forceinline__ void phase_conv(const Ctx& C, const float* x) {
    bf16_t* XB = (bf16_t*)(C.ws + WS_XB); float* RSTD = (float*)(C.ws + WS_META + MT_RSTD);
    for (int m = C.gw * 4; m < T; m += C.ngw * 4) {
        f32x4 v[4][4]; float s[4];
#pragma unroll
        for (int r = 0; r < 4; ++r) { const f32x4* xr = (const f32x4*)(x + (size_t)(m + r) * D) + C.lane;
#pragma unroll
            for (int j = 0; j < 4; ++j) v[r][j] = xr[64 * j]; }
#pragma unroll
        for (int r = 0; r < 4; ++r) { float a = 0.f;
#pragma unroll
            for (int j = 0; j < 4; ++j) a += (v[r][j].x * v[r][j].x + v[r][j].y * v[r][j].y) + (v[r][j].z * v[r][j].z + v[r][j].w * v[r][j].w);
            s[r] = wave_sum(a);
            unsigned long long* o8 = (unsigned long long*)(XB + (size_t)(m + r) * D) + C.lane;
#pragma unroll
            for (int j = 0; j < 4; ++j) o8[64 * j] = (unsigned long long)pk2(v[r][j].x, v[r][j].y) | ((unsigned long long)pk2(v[r][j].z, v[r][j].w) << 32); }
        if (C.lane < 4) RSTD[m + C.lane] = 1.0f / sqrtf((C.lane == 0 ? s[0] : C.lane == 1 ? s[1] : C.lane == 2 ? s[2] : s[3]) * (1.f / D) + EPS);
    }
}
struct DenseSched {
    const char* A; const char* Bt; int nM, nN, nwg, G, c; size_t tstep;
    __device__ __forceinline__ void init(const void* A_, const void* Bt_, int M, int N, int K, int G_, int c_) { A = (const char*)A_; Bt = (const char*)Bt_; nM = M / 256; nN = N / 256; nwg = nM * nN; G = G_; c = c_; tstep = (size_t)256 * K * 2; }
    __device__ __forceinline__ bool next(int i, pg8::Unit& u) const {
        const int R = nwg / G, r = nwg - R * G; long L; u.hf = 0;
        if (i < R) L = (long)i * G + c;
        else if (i == R && r > 0) { if (2 * r <= G) { if (c >= 2 * r) return false; L = (long)R * G + (c % r); u.hf = 1 + c / r; } else { if (c >= r) return false; L = (long)R * G + c; } }
        else return false;
        int wgid = (int)L; { const int q = nwg / 8, rr = nwg % 8, xcd = wgid % 8, off = wgid / 8; wgid = (xcd < rr ? xcd * (q + 1) : rr * (q + 1) + (xcd - rr) * q) + off; }
        const int nig = 8 * nN, gid = wgid / nig, fm = gid * 8, gsz = (nM - fm) < 8 ? (nM - fm) : 8;
        u.pm = fm + ((wgid % nig) % gsz); u.pn = (wgid % nig) / gsz; return true;
    }
    __device__ __forceinline__ const char* a_base(const pg8::Unit& u) const { return A + (size_t)u.pm * tstep + (u.hf == 2 ? tstep / 2 : 0); }
    __device__ __forceinline__ const char* b_base(const pg8::Unit& u) const { return Bt + (size_t)u.pn * tstep; }
    __device__ __forceinline__ int a_row(const pg8::Unit&, int) const { return 0; }
    __device__ __forceinline__ void a_ready(const pg8::Unit&) const {}
    __device__ __forceinline__ void done(const pg8::Unit&) const {}
};
constexpr int TB_OFF = 131072;
struct TileTab { const LAS int* t;
    __device__ __forceinline__ int bucket(int pm) const { return t[pm]; }
    __device__ __forceinline__ int row0(int pm, int bk) const { return (pm - t[160 + bk]) * 256; }
    __device__ __forceinline__ int count(int bk) const { return t[192 + bk]; }
    __device__ __forceinline__ int ntiles() const { return t[224]; } };
__device__ __forceinline__ void build_tile_table(const Ctx& C, int l) {
    LAS int* t = (LAS int*)(C.lds + TB_OFF); const unsigned* cnt = (const unsigned*)(C.ws + WS_CTL) + CW_CNT + l * 32;
    if (C.tid < 64) { const int lane = C.tid; const int c = (lane < NBUCKET) ? (int)cnt[lane] : 0; const int nt = (c + 255) >> 8; int incl = nt;
#pragma unroll
        for (int o = 1; o < 32; o <<= 1) { const int v = __shfl_up(incl, o); if (lane >= o) incl += v; }
        const int excl = incl - nt;
        if (lane < 32) { t[160 + lane] = excl; t[192 + lane] = c; }
        if (lane < NBUCKET) for (int i = 0; i < nt; ++i) t[excl + i] = lane;
        if (lane == NBUCKET - 1) t[224] = incl; }
    __syncthreads();
}
struct GroupSched {
    const char* A; const char* B; TileTab tt; const int* blist; int ntiles, G, c, mode; size_t a_tile_bytes;
    __device__ __forceinline__ bool next(int i, pg8::Unit& u) const {
        const int NU = ntiles * 4, R = NU / G, r = NU - R * G; int L; u.hf = 0;
        const int cv = ((G & 7) == 0) ? (c & 7) * (G >> 3) + (c >> 3) : c;
        if (i < R) L = i * G + cv;
        else if (i == R && r > 0) { if (2 * r <= G) { if (cv >= 2 * r) return false; L = R * G + (cv % r); u.hf = 1 + cv / r; } else { if (cv >= r) return false; L = R * G + cv; } }
        else return false;
        u.pm = L >> 2; u.pn = L & 3; return true; }
    __device__ __forceinline__ const char* a_base(const pg8::Unit& u) const { return mode == 1 ? A : A + (size_t)u.pm * a_tile_bytes + (u.hf == 2 ? a_tile_bytes / 2 : 0); }
    __device__ __forceinline__ int a_row(const pg8::Unit& u, int row) const {
        const int bk = tt.bucket(u.pm), r = tt.row0(u.pm, bk) + row + (u.hf == 2 ? 128 : 0); return blist[bk * T + (r < tt.count(bk) ? r : 0)]; }
    __device__ __forceinline__ const char* b_base(const pg8::Unit& u) const {
        const int bk = tt.bucket(u.pm);
        if (mode == 1) { const int g = bk / 6, pi = bk % 6, e = 4 * g + ((u.pn >> 1) ? pair_hi(pi) : pair_lo(pi)); return B + ((size_t)e * 512 + (u.pn & 1) * 256) * (size_t)(D * 2); }
        return B + ((size_t)bk * D + u.pn * 256) * (size_t)(512 * 2);
    }
    __device__ __forceinline__ void a_ready(const pg8::Unit&) const {}
    __device__ __forceinline__ void done(const pg8::Unit&) const {}
};

__device__ __forceinline__ float row_rstd(const float* ssqp, int row) {
    const f32x4* q = (const f32x4*)(ssqp + (size_t)row * 16); const f32x4 a = q[0], b = q[1], c = q[2], d = q[3];
    const float s = (((a.x + a.y) + (a.z + a.w)) + ((b.x + b.y) + (b.z + b.w))) + (((c.x + c.y) + (c.z + c.w)) + ((d.x + d.y) + (d.z + d.w)));
    return 1.0f / sqrtf(s * (1.f / D) + EPS);
}
struct EpiIn {
    static constexpr bool PERM = true, AFTER_DRAIN = false;
    const float* rstd; bf16_t *U, *QH; const float *qg, *kg;
    __device__ __forceinline__ void operator()(const f32x4 (&acc)[2][2][4][2], const pg8::Unit& u, int wr, int wc, int fr, int fq) const {
        const int pn = u.pn; const int row0 = u.pm * 256 + (u.hf == 2 ? 128 : 0) + wr * 64 + fr; const bool halfu = u.hf != 0;
        if (pn < 3) {
            bf16_t* base = U + (size_t)pn * (8u << 20) + wc * 32 + 8 * fq;
#pragma unroll
            for (int ai = 0; ai < 2; ++ai)
#pragma unroll
                for (int m = 0; m < 4; ++m) { if (ai == 1 && halfu) continue; const int row = row0 + ai * 128 + m * 16; const float rs = rstd[row];
#pragma unroll
                    for (int bj = 0; bj < 2; ++bj) { f32x4 v0 = acc[ai][bj][m][0] * rs, v1 = acc[ai][bj][m][1] * rs;
                        if (pn < 2) { v0.x = gelu_tanh(v0.x); v0.y = gelu_tanh(v0.y); v0.z = gelu_tanh(v0.z); v0.w = gelu_tanh(v0.w); v1.x = gelu_tanh(v1.x); v1.y = gelu_tanh(v1.y); v1.z = gelu_tanh(v1.z); v1.w = gelu_tanh(v1.w); }
                        u32x4 w; w.x = pk2(v0.x, v0.y); w.y = pk2(v0.z, v0.w); w.z = pk2(v1.x, v1.y); w.w = pk2(v1.z, v1.w);
                        *(u32x4*)(base + (size_t)row * 256 + bj * 128) = w; } }
        } else {
            const int typ = (pn - 3) >> 1, head = 4 * ((pn - 3) & 1) + wc;
            bf16_t* dstb = QH + (size_t)typ * (16u << 20) + 8 * fq;
            f32x4 gv[2][2];
            const float* gsrc = qg + (kg - qg) * (typ == 1 ? 1 : 0) + 8 * fq; const float sc = (typ == 0) ? 0.125f * LOG2E : 1.f;
#pragma unroll
            for (int bj = 0; bj < 2; ++bj)
#pragma unroll
                for (int n = 0; n < 2; ++n) gv[bj][n] = (typ < 2) ? *(const f32x4*)(gsrc + 32 * bj + 4 * n) * sc : (f32x4){1.f, 1.f, 1.f, 1.f};
#pragma unroll
            for (int ai = 0; ai < 2; ++ai)
#pragma unroll
                for (int m = 0; m < 4; ++m) { if (ai == 1 && halfu) continue; const int row = row0 + ai * 128 + m * 16; const float rs = rstd[row];
                    f32x4 v[2][2]; float ss = 0.f;
#pragma unroll
                    for (int bj = 0; bj < 2; ++bj)
#pragma unroll
                        for (int n = 0; n < 2; ++n) { v[bj][n] = acc[ai][bj][m][n] * rs; ss += (v[bj][n].x * v[bj][n].x + v[bj][n].y * v[bj][n].y) + (v[bj][n].z * v[bj][n].z + v[bj][n].w * v[bj][n].w); }
                    ss += __shfl_xor(ss, 16); ss += __shfl_xor(ss, 32);
                    const float r = (typ < 2) ? 1.0f / sqrtf(ss * (1.f / 64.f) + EPS) : 1.f;
                    const int b = row >> 13, s = row & (SEQ - 1);
                    bf16_t* dst = dstb + ((size_t)(b * NH + head) * SEQ + s) * 64;
#pragma unroll
                    for (int bj = 0; bj < 2; ++bj) { const f32x4 v0 = v[bj][0] * r * gv[bj][0], v1 = v[bj][1] * r * gv[bj][1];
                        u32x4 w; w.x = pk2(v0.x, v0.y); w.y = pk2(v0.z, v0.w); w.z = pk2(v1.x, v1.y); w.w = pk2(v1.z, v1.w);
                        *(u32x4*)(dst + 32 * bj) = w; } }
        }
    }
};
__device__ __forceinline__ f32x4 bf_lo4(unsigned a, unsigned b) { return (f32x4){__uint_as_float(a << 16), __uint_as_float(a & 0xffff0000u), __uint_as_float(b << 16), __uint_as_float(b & 0xffff0000u)}; }
struct EpiOut {
    static constexpr bool PERM = true, AFTER_DRAIN = false;
    bf16_t* xb; float* ssq; size_t wofs;
    __device__ __forceinline__ void operator()(const f32x4 (&acc)[2][2][4][2], const pg8::Unit& u, int wr, int wc, int fr, int fq) const {
        const int row0 = u.pm * 256 + wr * 64 + fr, col0 = u.pn * 256 + wc * 32 + 8 * fq;
#pragma unroll
        for (int ai = 0; ai < 2; ++ai)
#pragma unroll
            for (int m = 0; m < 4; ++m) { const int row = row0 + ai * 128 + m * 16; bf16_t* xp = xb + (size_t)row * D + col0; float ss = 0.f;
#pragma unroll
                for (int bj = 0; bj < 2; ++bj) { const u32x4 w = *(const u32x4*)(xp + bj * 128);
                    const f32x4 v0 = bf_lo4(w.x, w.y) + acc[ai][bj][m][0], v1 = bf_lo4(w.z, w.w) + acc[ai][bj][m][1];
                    u32x4 o; o.x = pk2(v0.x, v0.y); o.y = pk2(v0.z, v0.w); o.z = pk2(v1.x, v1.y); o.w = pk2(v1.z, v1.w); *(u32x4*)(xp + wofs + bj * 128) = o;
                    const f32x4 r0 = bf_lo4(o.x, o.y), r1 = bf_lo4(o.z, o.w);
                    ss += (r0.x * r0.x + r0.y * r0.y) + (r0.z * r0.z + r0.w * r0.w) + (r1.x * r1.x + r1.y * r1.y) + (r1.z * r1.z + r1.w * r1.w); }
                ss += __shfl_xor(ss, 16); ss += __shfl_xor(ss, 32); if (fq == 0) ssq[(size_t)row * 16 + u.pn * 4 + wc] = ss; }
    }
};
struct EpiG1 {
    static constexpr bool PERM = true, AFTER_DRAIN = false;
    TileTab tt; const float *bgw0, *bgw1, *brs; bf16_t* H;
    __device__ __forceinline__ void operator()(const f32x4 (&acc)[2][2][4][2], const pg8::Unit& u, int wr, int wc, int fr, int fq) const {
        const int rl0 = (u.hf == 2 ? 128 : 0) + wr * 64 + fr; const int slot = u.pn >> 1, hh = u.pn & 1; const bool halfu = u.hf != 0;
        const int bk = tt.bucket(u.pm); const size_t lbase = (size_t)bk * T + tt.row0(u.pm, bk);
        const float* bgw = slot ? bgw1 : bgw0;
        bf16_t* hb = H + (size_t)u.pm * 256 * 512 + slot * 256 + hh * 128 + wc * 32 + 8 * fq;
#pragma unroll
        for (int ai = 0; ai < 2; ++ai)
#pragma unroll
            for (int m = 0; m < 4; ++m) { if (ai == 1 && halfu) continue; const int rl = rl0 + ai * 128 + m * 16; const float rs = brs[lbase + rl], gw = bgw[lbase + rl];
                float h[8];
#pragma unroll
                for (int n = 0; n < 2; ++n) { const f32x4 g = acc[ai][0][m][n] * rs, up = acc[ai][1][m][n] * (rs * gw);
                    h[4 * n] = fast_sigmoid_mul(g.x, g.x) * up.x; h[4 * n + 1] = fast_sigmoid_mul(g.y, g.y) * up.y; h[4 * n + 2] = fast_sigmoid_mul(g.z, g.z) * up.z; h[4 * n + 3] = fast_sigmoid_mul(g.w, g.w) * up.w; }
                u32x4 w; w.x = pk2(h[0], h[1]); w.y = pk2(h[2], h[3]); w.z = pk2(h[4], h[5]); w.w = pk2(h[6], h[7]);
                *(u32x4*)(hb + (size_t)rl * 512) = w; }
    }
};
template <bool NEXT> struct EpiG2 {
    static constexpr bool PERM = true, AFTER_DRAIN = false;
    TileTab tt; const int* blist; float* out; bf16_t* xb; float* ssq; size_t wofs;
    __device__ __forceinline__ void operator()(const f32x4 (&acc)[2][2][4][2], const pg8::Unit& u, int wr, int wc, int fr, int fq) const {
        const int rl0 = (u.hf == 2 ? 128 : 0) + wr * 64 + fr, col0 = u.pn * 256 + wc * 32 + 8 * fq; const bool halfu = u.hf != 0;
        const int bk = tt.bucket(u.pm), r0 = tt.row0(u.pm, bk), bc = tt.count(bk); const int* bl = blist + (size_t)bk * T;
#pragma unroll
        for (int ai = 0; ai < 2; ++ai)
#pragma unroll
            for (int m = 0; m < 4; ++m) { if (ai == 1 && halfu) continue; const int r = r0 + rl0 + ai * 128 + m * 16; const int tok = (r < bc) ? bl[r] : -1;
                float ss = 0.f;
                if (tok >= 0) { bf16_t* xp = xb + (size_t)tok * D + col0;
#pragma unroll
                    for (int bj = 0; bj < 2; ++bj) { const u32x4 w = *(const u32x4*)(xp + bj * 128);
                        const f32x4 v0 = bf_lo4(w.x, w.y) + acc[ai][bj][m][0], v1 = bf_lo4(w.z, w.w) + acc[ai][bj][m][1];
                        if (NEXT) { u32x4 o; o.x = pk2(v0.x, v0.y); o.y = pk2(v0.z, v0.w); o.z = pk2(v1.x, v1.y); o.w = pk2(v1.z, v1.w); *(u32x4*)(xp + wofs + bj * 128) = o;
                            const f32x4 r0 = bf_lo4(o.x, o.y), r1 = bf_lo4(o.z, o.w);
                            ss += (r0.x * r0.x + r0.y * r0.y) + (r0.z * r0.z + r0.w * r0.w) + (r1.x * r1.x + r1.y * r1.y) + (r1.z * r1.z + r1.w * r1.w); }
                        else { f32x4* op = (f32x4*)(out + (size_t)tok * D + col0 + bj * 128); __builtin_nontemporal_store(v0, op); __builtin_nontemporal_store(v1, op + 1); } } }
                if (NEXT) { ss += __shfl_xor(ss, 16); ss += __shfl_xor(ss, 32); if (fq == 0 && tok >= 0) ssq[(size_t)tok * 16 + u.pn * 4 + wc] = ss; } }
    }
};

__device__ __forceinline__ void phase_vrstd(const Ctx& C) {
    const bf16_t* V = (const bf16_t*)(C.ws + WS_V); float* vr = (float*)(C.ws + WS_META + MT_VR);
    for (int m = C.gw; m < T; m += C.ngw) {
        const unsigned long long w = ((const unsigned long long*)(V + (size_t)m * 256))[C.lane];
        const float a = __uint_as_float((unsigned)(w << 16)), b = __uint_as_float((unsigned)w & 0xffff0000u), c = __uint_as_float((unsigned)(w >> 32) << 16), d = __uint_as_float((unsigned)(w >> 32) & 0xffff0000u);
        const float s = wave_sum(a * a + b * b + c * c + d * d);
        if (C.lane == 0) vr[m] = 1.0f / sqrtf(s * (1.f / 256.f) + EPS);
    }
}
__device__ __forceinline__ void phase_sgu_naive(const Ctx& C, int l) {
    const bf16_t* U = (const bf16_t*)(C.ws + WS_U); const bf16_t* V = (const bf16_t*)(C.ws + WS_V); const float* vr = (const float*)(C.ws + WS_META + MT_VR);
    const float* sgu_norm = gptr(C.in[3]) + l * 256; const float* sgu_w = gptr(C.in[4]) + (size_t)l * 4 * 128 * 128; const float* sgu_b = gptr(C.in[5]) + l * 512;
    bf16_t* O = (bf16_t*)(C.ws + WS_O);
    const int half = C.tid >> 8, ch = C.tid & 255, h = ch >> 6;
    const float gn = sgu_norm[ch];
    for (int t = blockIdx.x * 2 + half; t < T; t += C.G * 2) {
        const int s = t & (SEQ - 1), i = s & 127, t0 = t - i;
        const int jmax = (i < 64) ? 64 : 128;
        const float* w = sgu_w + ((size_t)h * 128 + i) * 128;
        float acc = 0.f;
        for (int j = 0; j < jmax; ++j) acc += w[j] * (bf2f(V[(size_t)(t0 + j) * 256 + ch]) * vr[t0 + j] * gn);
        acc += sgu_b[h * 128 + i];
        const float oa = bf2f(U[(size_t)t * 256 + ch]) * acc;
        const float ss = wave_sum(oa * oa);
        O[(size_t)t * D + ch] = f2bf(oa * (1.0f / sqrtf(ss * (1.f / 64.f) + EPS)));
    }
}

typedef short bf16x8 __attribute__((ext_vector_type(8)));
typedef short s16x4 __attribute__((ext_vector_type(4)));
typedef float f32x16 __attribute__((ext_vector_type(16)));
constexpr int ATT_BX = 640;
constexpr int ATT_VBUF = 16384;
constexpr int ATT_BX_OFF = NWAVES * ATT_VBUF;
__device__ __forceinline__ void glds16(const void* gsrc, unsigned lds_dst) { unsigned keep;
    asm volatile("s_mov_b32 %0, m0\n\ts_mov_b32 m0, %2\n\ts_nop 0\n\tglobal_load_lds_dwordx4 %1, off\n\ts_mov_b32 m0, %0" : "=&s"(keep) : "v"(gsrc), "s"(lds_dst) : "memory"); }
__device__ __forceinline__ float max3f(float a, float b, float c) { float r; asm("v_max3_f32 %0, %1, %2, %3" : "=v"(r) : "v"(a), "v"(b), "v"(c)); return r; }
__device__ __forceinline__ s16x4 ds_tr(const LAS unsigned char* p) { return __builtin_bit_cast(s16x4, __builtin_amdgcn_ds_read_tr16_b64_v4i16((LAS s16x4*)p)); }
__device__ __forceinline__ void attn_load_bias(const Ctx& C, int l) {
    LAS float* Bx = (LAS float*)(C.lds + ATT_BX_OFF);
    const float* rb = gptr(C.in[18]) + (size_t)l * NH * 513;
    for (int i = C.tid; i < NH * ATT_BX; i += NTHREADS) { const int h = i / ATT_BX, j = i % ATT_BX; int rel = j - 64; rel = rel > 256 ? 256 : rel; Bx[h * ATT_BX + (ATT_BX - 1 - j)] = rb[h * 513 + rel + 256] * LOG2E; }
}
constexpr int ATT_KOFF = 0, ATT_VOFF = 16384;
struct AttnState { float m_run, l_run; f32x16 o0, o1; };
__device__ __forceinline__ void attn_step(const Ctx& C, AttnState& S, const bf16x8 (&qf)[4], const LAS unsigned char* kb, const LAS unsigned char* vbt, const LAS float* Bx, int jbase) {
    const int lane = C.lane, r32 = lane & 31, hi = lane >> 5;
    typedef float f32x2 __attribute__((ext_vector_type(2)));
    f32x16 p0, p1;
#pragma unroll
    for (int r = 0; r < 16; ++r) { const int kk = (r & 3) + 8 * (r >> 2); p0[r] = Bx[(ATT_BX - 1 - jbase) + kk]; p1[r] = Bx[(ATT_BX - 1 - jbase) + kk + 32]; }
    bf16x8 kf[8];
#pragma unroll
    for (int t = 0; t < 2; ++t)
#pragma unroll
        for (int ks = 0; ks < 4; ++ks) kf[t * 4 + ks] = *(const LAS bf16x8*)(kb + (32 * t + r32) * 128 + 16 * ((2 * ks + hi) ^ (r32 & 7)));
    __builtin_amdgcn_sched_barrier(0);
#pragma unroll
    for (int ks = 0; ks < 4; ++ks) { p0 = __builtin_amdgcn_mfma_f32_32x32x16_bf16(kf[ks], qf[ks], p0, 0, 0, 0); p1 = __builtin_amdgcn_mfma_f32_32x32x16_bf16(kf[4 + ks], qf[ks], p1, 0, 0, 0); }
    __builtin_amdgcn_sched_barrier(0);
    bf16x8 vf[8];
#pragma unroll
    for (int ts = 0; ts < 4; ++ts)
#pragma unroll
        for (int dt = 0; dt < 2; ++dt) { const s16x4 lo = ds_tr(vbt + ((2 * ts) * 2 + dt) * 512), hi4 = ds_tr(vbt + ((2 * ts + 1) * 2 + dt) * 512);
            vf[2 * ts + dt] = (bf16x8){lo[0], lo[1], lo[2], lo[3], hi4[0], hi4[1], hi4[2], hi4[3]}; }
    __builtin_amdgcn_sched_barrier(0);
    asm volatile("s_nop 15\n\ts_nop 7" : "+v"(p0), "+v"(p1));
    float mx = max3f(p0[0], p1[0], p0[1]), my = max3f(p1[1], p0[2], p1[2]);
#pragma unroll
    for (int r = 3; r < 15; r += 2) { mx = max3f(mx, p0[r], p1[r]); my = max3f(my, p0[r + 1], p1[r + 1]); }
    mx = max3f(mx, p0[15], p1[15]); mx = max3f(mx, my, my);
    { const auto sw = __builtin_amdgcn_permlane32_swap(__float_as_uint(mx), __float_as_uint(mx), false, false); mx = fmaxf(__uint_as_float(sw[0]), __uint_as_float(sw[1])); }
    const float m_new = max3f(S.m_run, mx, mx);
    const float alpha = __builtin_amdgcn_exp2f(S.m_run - m_new);
    S.m_run = m_new;
    const f32x2 m2 = {m_new, m_new}; f32x2 ps2 = {0.f, 0.f};
#pragma unroll
    for (int r = 0; r < 16; r += 2) {
        f32x2 x = (f32x2){p0[r], p0[r + 1]} - m2, y = (f32x2){p1[r], p1[r + 1]} - m2;
        x.x = __builtin_amdgcn_exp2f(x.x); x.y = __builtin_amdgcn_exp2f(x.y); y.x = __builtin_amdgcn_exp2f(y.x); y.y = __builtin_amdgcn_exp2f(y.y);
        p0[r] = x.x; p0[r + 1] = x.y; p1[r] = y.x; p1[r + 1] = y.y; ps2 += x + y; }
    S.l_run = S.l_run * alpha + (ps2.x + ps2.y);
#pragma unroll
    for (int r = 0; r < 16; ++r) { S.o0[r] *= alpha; S.o1[r] *= alpha; }
    bf16x8 pf[4];
#pragma unroll
    for (int s = 0; s < 2; ++s) { u32x4 w0, w1;
        w0.x = pk2(p0[8 * s], p0[8 * s + 1]); w0.y = pk2(p0[8 * s + 2], p0[8 * s + 3]); w0.z = pk2(p0[8 * s + 4], p0[8 * s + 5]); w0.w = pk2(p0[8 * s + 6], p0[8 * s + 7]);
        w1.x = pk2(p1[8 * s], p1[8 * s + 1]); w1.y = pk2(p1[8 * s + 2], p1[8 * s + 3]); w1.z = pk2(p1[8 * s + 4], p1[8 * s + 5]); w1.w = pk2(p1[8 * s + 6], p1[8 * s + 7]);
        pf[s] = __builtin_bit_cast(bf16x8, w0); pf[2 + s] = __builtin_bit_cast(bf16x8, w1); }
#pragma unroll
    for (int ts = 0; ts < 4; ++ts) { S.o0 = __builtin_amdgcn_mfma_f32_32x32x16_bf16(vf[2 * ts], pf[ts], S.o0, 0, 0, 0); S.o1 = __builtin_amdgcn_mfma_f32_32x32x16_bf16(vf[2 * ts + 1], pf[ts], S.o1, 0, 0, 0); }
}
__device__ __forceinline__ void attn_block_item(const Ctx& C, int b, int h, int c0) {
    const bf16_t* QH = (const bf16_t*)(C.ws + WS_QH); const bf16_t* KH = (const bf16_t*)(C.ws + WS_KH); const bf16_t* VH = (const bf16_t*)(C.ws + WS_VH);
    bf16_t* O = (bf16_t*)(C.ws + WS_O);
    const int lane = C.lane, r32 = lane & 31, hi = lane >> 5, tid = C.tid, j = C.wave >> 1, half = C.wave & 1, qc = c0 + j;
    const unsigned lds0 = (unsigned)(uintptr_t)C.lds;
    const LAS float* Bx = (const LAS float*)(C.lds + ATT_BX_OFF) + h * ATT_BX;
    const size_t bh = (size_t)(b * NH + h) * SEQ;
    bf16x8 qf[4];
    { const bf16_t* Qp = QH + (bh + qc * 64 + half * 32 + r32) * 64 + 8 * hi;
#pragma unroll
      for (int ks = 0; ks < 4; ++ks) qf[ks] = *(const bf16x8*)(Qp + 16 * ks); }
    const bf16_t* Ksrc = KH + (bh + (tid >> 3)) * 64 + 8 * ((tid & 7) ^ ((tid >> 3) & 7));
    const bf16_t* Vsrc = VH + (bh + 8 * C.wave + ((lane & 31) >> 2)) * 64 + (4 * (lane >> 5) + (lane & 3)) * 8;
    const unsigned kdst = lds0 + ATT_KOFF + C.wave * 1024, vdst = lds0 + ATT_VOFF + C.wave * 1024;
    const int i16 = lane & 15;
    const int trbase = (4 * hi + (i16 >> 2)) * 64 + (16 * ((lane >> 4) & 1) + 4 * (i16 & 3)) * 2;
    const int qi = 32 * half + r32;
    AttnState S; S.m_run = -INFINITY; S.l_run = 0.f;
#pragma unroll
    for (int r = 0; r < 16; ++r) { S.o0[r] = 0.f; S.o1[r] = 0.f; }
    const int s0 = c0 >= 8 ? 0 : 8 - c0;
    { const size_t ko = (size_t)(c0 - 8 + s0) * 64 * 64;
      glds16(Ksrc + ko, (unsigned)__builtin_amdgcn_readfirstlane((int)(kdst + (s0 & 1) * 8192))); glds16(Vsrc + ko, (unsigned)__builtin_amdgcn_readfirstlane((int)(vdst + (s0 & 1) * 8192))); }
    asm volatile("s_waitcnt vmcnt(0) lgkmcnt(0)\n\ts_barrier" ::: "memory");
    asm volatile("" : "+v"(qf[0]), "+v"(qf[1]), "+v"(qf[2]), "+v"(qf[3]));
    for (int s = s0; s < 12; ++s) {
        if (s + 1 < 12) { const size_t ko = (size_t)(c0 - 8 + s + 1) * 64 * 64; const int nb = (s + 1) & 1;
            glds16(Ksrc + ko, (unsigned)__builtin_amdgcn_readfirstlane((int)(kdst + nb * 8192))); glds16(Vsrc + ko, (unsigned)__builtin_amdgcn_readfirstlane((int)(vdst + nb * 8192))); }
        const int jb = s - j;
        if (jb >= 0 && jb < 9) attn_step(C, S, qf, C.lds + ATT_KOFF + (s & 1) * 8192, C.lds + ATT_VOFF + (s & 1) * 8192 + trbase, Bx, 512 - 64 * jb + qi + 64 - 4 * hi);
        asm volatile("s_waitcnt vmcnt(0) lgkmcnt(0)\n\ts_barrier" ::: "memory");
    }
    float lt = S.l_run + __shfl_xor(S.l_run, 32);
    const float inv = 1.0f / lt;
    float ss = 0.f;
#pragma unroll
    for (int r = 0; r < 16; ++r) { S.o0[r] *= inv; S.o1[r] *= inv; ss += S.o0[r] * S.o0[r] + S.o1[r] * S.o1[r]; }
    ss += __shfl_xor(ss, 32);
    const float rn = 1.0f / sqrtf(ss * (1.f / 64.f) + EPS);
    bf16_t* op = O + (size_t)(b * SEQ + qc * 64 + half * 32 + r32) * D + 512 + h * 64 + 4 * hi;
#pragma unroll
    for (int g = 0; g < 4; ++g) {
        *(unsigned long long*)(op + 8 * g) = (unsigned long long)pk2(S.o0[4 * g] * rn, S.o0[4 * g + 1] * rn) | ((unsigned long long)pk2(S.o0[4 * g + 2] * rn, S.o0[4 * g + 3] * rn) << 32);
        *(unsigned long long*)(op + 32 + 8 * g) = (unsigned long long)pk2(S.o1[4 * g] * rn, S.o1[4 * g + 1] * rn) | ((unsigned long long)pk2(S.o1[4 * g + 2] * rn, S.o1[4 * g + 3] * rn) << 32);
    }
}
__device__ __forceinline__ void phase_attn(const Ctx& C, int l, int first, int stride, int limit) {
    attn_load_bias(C, l);
    __syncthreads();
    for (int it = first; it < limit; it += stride) { const int qq = it % (SEQ / 256), bh = it / (SEQ / 256), b = bh / NH, h = bh % NH;
        attn_block_item(C, b, h, qq * 4); }
    __syncthreads();
}

struct S5C { float x; double y; float fr, fi; };
__device__ __forceinline__ void s5_sincos_d(double ang, float& sn, float& cs) {
    ang -= 6.283185307179586476925 * rint(ang * 0.15915494309189533577);
    const float a = (float)ang; sn = __sinf(a); cs = __cosf(a);
}
__device__ __forceinline__ S5C s5_consts(const Ctx& C, int l, int g, int p) {
    const float lr = gptr(C.in[6])[l * 1024 + g * 64 + p], li = gptr(C.in[7])[l * 1024 + g * 64 + p], dt = __expf(gptr(C.in[8])[l * 16 + g]);
    S5C c; c.x = lr * dt; c.y = (double)li * (double)dt;
    float sn, cs, sh, ch; s5_sincos_d(c.y, sn, cs); s5_sincos_d(0.5 * c.y, sh, ch);
    const float x = c.x;
    const float ex1 = x * (1.f + x * (0.5f + x * (0.16666667f + x * (0.041666668f + x * (0.0083333338f + x * 0.0013888889f))))), er = ex1 + 1.f;
    const float nr = ex1 * cs - 2.f * sh * sh, ni = er * sn, den = lr * lr + li * li;
    c.fr = (nr * lr + ni * li) / den; c.fi = (ni * lr - nr * li) / den;
    return c;
}
__device__ __forceinline__ void s5_cpow(const S5C& c, int n, float& re, float& im) {
    const float e = __expf(c.x * (float)n);
    float sn, cs; s5_sincos_d(c.y * (double)n, sn, cs); re = e * cs; im = e * sn;
}
__device__ __forceinline__ int s5_m2col(int sg) { const int ks = sg >> 5, rem = sg & 31; return 32 * ks + 8 * ((rem >> 2) & 3) + 4 * (rem >> 4) + (rem & 3); }
constexpr int S5_ITEMS_LG = 19, S5_ITEMS = DEPTH * 16 * S5_ITEMS_LG;
constexpr int S5_APS = 19 * 128;
__device__ __forceinline__ void s5_prep_item(const Ctx& C, int it, LAS float* scr) {
    const int lg = it / S5_ITEMS_LG, r = it % S5_ITEMS_LG, l = lg >> 4, g = lg & 15, lane = C.lane;
    unsigned char* base = C.ws + WS_S5 + (size_t)l * S5_LAYER;
    const float* bre = gptr(C.in[9]) + l * 16384 + g * 1024; const float* bim = gptr(C.in[10]) + l * 16384 + g * 1024;
    const float* cre = gptr(C.in[11]) + l * 16384 + g * 1024; const float* cim = gptr(C.in[12]) + l * 16384 + g * 1024;
    if (r < 16) {
        const int delta = r;
        { const int p = lane; const S5C c = s5_consts(C, l, g, p);
#pragma unroll
          for (int ts = 0; ts < 2; ++ts) { float pr = 0.f, pi = 0.f; if (delta - ts >= 0) s5_cpow(c, delta - ts, pr, pi);
              scr[(ts * 64 + p) * 2] = (delta - ts >= 0) ? pr * c.fr - pi * c.fi : 0.f; scr[(ts * 64 + p) * 2 + 1] = (delta - ts >= 0) ? pr * c.fi + pi * c.fr : 0.f; } }
        { LAS f32x4* sb = (LAS f32x4*)(scr + 256);
#pragma unroll
          for (int q = 0; q < 4; ++q) { sb[lane + 64 * q] = ((const f32x4*)bre)[lane + 64 * q]; sb[256 + lane + 64 * q] = ((const f32x4*)bim)[lane + 64 * q]; } }
        asm volatile("s_waitcnt lgkmcnt(0)" ::: "memory");
        const int h = lane & 15, kq = lane >> 4, ts = kq >> 1, tau = delta - ts;
        float acc[8];
#pragma unroll
        for (int j = 0; j < 8; ++j) acc[j] = 0.f;
        const LAS f32x4* sbr = (const LAS f32x4*)(scr + 256) + 2 * (kq & 1); const LAS f32x4* sbi = sbr + 256;
        float cr[64 / 16], ci[64 / 16];
#pragma unroll 1
        for (int p0 = 0; p0 < 64; p0 += 4) {
#pragma unroll
            for (int q = 0; q < 4; ++q) { cr[q] = cre[h * 64 + p0 + q]; ci[q] = cim[h * 64 + p0 + q]; }
#pragma unroll
            for (int q = 0; q < 4; ++q) { const int p = p0 + q;
                const float pr = scr[(ts * 64 + p) * 2], pi = scr[(ts * 64 + p) * 2 + 1];
                const float wr = cr[q] * pr - ci[q] * pi, wi = cr[q] * pi + ci[q] * pr;
                const f32x4 b0 = sbr[4 * p], b1 = sbr[4 * p + 1], c0 = sbi[4 * p], c1 = sbi[4 * p + 1];
                acc[0] += wr * b0.x - wi * c0.x; acc[1] += wr * b0.y - wi * c0.y; acc[2] += wr * b0.z - wi * c0.z; acc[3] += wr * b0.w - wi * c0.w;
                acc[4] += wr * b1.x - wi * c1.x; acc[5] += wr * b1.y - wi * c1.y; acc[6] += wr * b1.z - wi * c1.z; acc[7] += wr * b1.w - wi * c1.w; }
        }
        if (tau == 0) {
#pragma unroll
            for (int j = 0; j < 8; ++j) if (8 * (kq & 1) + j == h) acc[j] += gptr(C.in[13])[l * 256 + g * 16 + h];
        }
        u32x4 o; o.x = pk2(acc[0], acc[1]); o.y = pk2(acc[2], acc[3]); o.z = pk2(acc[4], acc[5]); o.w = pk2(acc[6], acc[7]);
        *(u32x4*)((bf16_t*)(base + S5_TT) + ((size_t)(g * 16 + delta) * 64 + lane) * 8) = o;
        asm volatile("s_waitcnt lgkmcnt(0)" ::: "memory");
    } else if (r == 16) {
        const int p = lane; const S5C c = s5_consts(C, l, g, p);
        float ar, ai; s5_cpow(c, 1, ar, ai);
        const float w1r = ar * c.fr - ai * c.fi, w1i = ar * c.fi + ai * c.fr;
        bf16_t* BB = (bf16_t*)(base + S5_M1) + (size_t)g * 128 * 32;
        unsigned re[16], im[16];
#pragma unroll
        for (int h2 = 0; h2 < 8; ++h2) {
            const float x0 = bre[p * 16 + 2 * h2], y0 = bim[p * 16 + 2 * h2], x1 = bre[p * 16 + 2 * h2 + 1], y1 = bim[p * 16 + 2 * h2 + 1];
            re[h2] = pk2(w1r * x0 - w1i * y0, w1r * x1 - w1i * y1); im[h2] = pk2(w1r * y0 + w1i * x0, w1r * y1 + w1i * x1);
            re[8 + h2] = pk2(c.fr * x0 - c.fi * y0, c.fr * x1 - c.fi * y1); im[8 + h2] = pk2(c.fr * y0 + c.fi * x0, c.fr * y1 + c.fi * x1);
        }
        u32x4* d0 = (u32x4*)(BB + (size_t)p * 32); u32x4* d1 = (u32x4*)(BB + (size_t)(64 + p) * 32);
#pragma unroll
        for (int q = 0; q < 4; ++q) { d0[q] = (u32x4){re[4 * q], re[4 * q + 1], re[4 * q + 2], re[4 * q + 3]}; d1[q] = (u32x4){im[4 * q], im[4 * q + 1], im[4 * q + 2], im[4 * q + 3]}; }
    } else if (r == 17) {
        const int p = lane;
        bf16_t* CMp = (bf16_t*)(base + S5_M2P) + (size_t)g * 16 * 128;
        const int c0 = s5_m2col(p), c1 = s5_m2col(64 + p);
#pragma unroll
        for (int h = 0; h < 16; ++h) { CMp[h * 128 + c0] = f2bf(cre[h * 64 + p]); CMp[h * 128 + c1] = f2bf(-cim[h * 64 + p]); }
    } else {
        const int p = lane; const S5C c = s5_consts(C, l, g, p);
        float* A16 = (float*)(base + S5_AP16) + (size_t)g * S5_APS; float* A256 = (float*)(base + S5_AP256) + (size_t)g * 32 * 128;
        for (int cc = 0; cc <= 18; ++cc) { float pr, pi; s5_cpow(c, cc <= 16 ? 16 * cc : cc - 16, pr, pi); A16[cc * 128 + p] = pr; A16[cc * 128 + 64 + p] = pi; }
        for (int m = 0; m < 32; ++m) { float pr, pi; s5_cpow(c, 256 * m, pr, pi); A256[m * 128 + p] = pr; A256[m * 128 + 64 + p] = pi; }
    }
}

__device__ __forceinline__ float dpp_shr(float v, int d) {
    int r;
    if (d == 1) r = __builtin_amdgcn_update_dpp(0, __float_as_int(v), 0x111, 0xf, 0xf, true);
    else if (d == 2) r = __builtin_amdgcn_update_dpp(0, __float_as_int(v), 0x112, 0xf, 0xf, true);
    else if (d == 4) r = __builtin_amdgcn_update_dpp(0, __float_as_int(v), 0x114, 0xf, 0xf, true);
    else r = __builtin_amdgcn_update_dpp(0, __float_as_int(v), 0x118, 0xf, 0xf, true);
    return __int_as_float(r);
}
struct S5Wave { bf16x8 uf[8]; f32x4 X[8]; f32x4 ar[4], ai[4], wr[4], wi[4]; };
#define S5_CSQR(pr, pi) do { _Pragma("unroll") for (int mt_ = 0; mt_ < 4; ++mt_) { const f32x4 r_ = pr[mt_] * pr[mt_] - pi[mt_] * pi[mt_], i_ = 2.f * (pr[mt_] * pi[mt_]); pr[mt_] = r_; pi[mt_] = i_; } } while (0)
template <bool NEEDW> __device__ __forceinline__ void s5_E_scan(const Ctx& C, int l, int b, int k, int g, S5Wave& W) {
    const int lane = C.lane, cc = lane & 15, kq = lane >> 4;
    const unsigned char* base = C.ws + WS_S5 + (size_t)l * S5_LAYER;
    const bf16_t* ZS = (const bf16_t*)(C.ws + WS_ZS);
    const bf16_t* up = ZS + ((size_t)b * SEQ + 256 * k + 16 * cc + (kq >> 1)) * 256 + 16 * g + 8 * (kq & 1);
#pragma unroll
    for (int ks = 0; ks < 8; ++ks) W.uf[ks] = *(const bf16x8*)(up + (size_t)(2 * ks) * 256);
    const bf16_t* bbp = opaque((const bf16_t*)(base + S5_M1) + (size_t)g * 128 * 32 + (size_t)cc * 32 + 8 * kq);
    bf16x8 bb[8];
#pragma unroll
    for (int mt = 0; mt < 8; ++mt) bb[mt] = *(const bf16x8*)(bbp + (size_t)(16 * mt) * 32);
    const float* A1 = opaque((const float*)(base + S5_AP16) + (size_t)g * S5_APS + 17 * 128 + 4 * kq);
#pragma unroll
    for (int mt = 0; mt < 4; ++mt) { W.ar[mt] = *(const f32x4*)(A1 + 16 * mt); W.ai[mt] = *(const f32x4*)(A1 + 64 + 16 * mt); }
    f32x4 pr[4], pi[4];
#pragma unroll
    for (int mt = 0; mt < 4; ++mt) { pr[mt] = W.ar[mt]; pi[mt] = W.ai[mt]; }
    S5_CSQR(pr, pi);
#pragma unroll
    for (int mt = 0; mt < 8; ++mt) W.X[mt] = (f32x4){0.f, 0.f, 0.f, 0.f};
#pragma unroll
    for (int ks = 0; ks < 8; ++ks) {
        if (ks) {
#pragma unroll
            for (int mt = 0; mt < 4; ++mt) { const f32x4 re = W.X[mt], im = W.X[mt + 4]; W.X[mt] = pr[mt] * re - pi[mt] * im; W.X[mt + 4] = pr[mt] * im + pi[mt] * re; }
        }
#pragma unroll
        for (int mt = 0; mt < 8; ++mt) W.X[mt] = __builtin_amdgcn_mfma_f32_16x16x32_bf16(bb[mt], W.uf[ks], W.X[mt], 0, 0, 0);
    }
    S5_CSQR(pr, pi); S5_CSQR(pr, pi); S5_CSQR(pr, pi);
    if (NEEDW) {
#pragma unroll
        for (int mt = 0; mt < 4; ++mt) { W.wr[mt] = (f32x4){1.f, 1.f, 1.f, 1.f}; W.wi[mt] = (f32x4){0.f, 0.f, 0.f, 0.f}; } }
#pragma unroll
    for (int d = 1; d < 16; d <<= 1) {
#pragma unroll
        for (int mt = 0; mt < 4; ++mt) {
#pragma unroll
            for (int r = 0; r < 4; ++r) { const float sr = dpp_shr(W.X[mt][r], d), si = dpp_shr(W.X[mt + 4][r], d);
                W.X[mt][r] += pr[mt][r] * sr - pi[mt][r] * si; W.X[mt + 4][r] += pr[mt][r] * si + pi[mt][r] * sr; }
        }
        if (NEEDW) { const bool sel = (cc & d) != 0;
#pragma unroll
            for (int mt = 0; mt < 4; ++mt) { const f32x4 nr = W.wr[mt] * pr[mt] - W.wi[mt] * pi[mt], ni = W.wr[mt] * pi[mt] + W.wi[mt] * pr[mt];
#pragma unroll
                for (int r = 0; r < 4; ++r) { W.wr[mt][r] = sel ? nr[r] : W.wr[mt][r]; W.wi[mt][r] = sel ? ni[r] : W.wi[mt][r]; } } }
        if (d < 8) S5_CSQR(pr, pi);
    }
}
__device__ __forceinline__ void s5a_item(const Ctx& C, int l, int it) {
    const int g = it & 15, k = (it >> 4) & 31, b = it >> 9;
    S5Wave W; s5_E_scan<false>(C, l, b, k, g, W);
    if ((C.lane & 15) == 15) { float* F = (float*)(C.ws + WS_S5F) + ((size_t)((b * 32 + k) * 16 + g)) * 128 + 4 * (C.lane >> 4);
#pragma unroll
        for (int mt = 0; mt < 8; ++mt) *(f32x4*)(F + 16 * mt) = W.X[mt]; }
}
constexpr int S5_YSTRIDE = 528;
__device__ __forceinline__ void s5c_group(const Ctx& C0, int l, int b, int k, int g) {
    Ctx C = C0; asm volatile("; S5C_GROUP_BEGIN\n" : "+v"(C.lane));
    const int lane = C.lane, cc = lane & 15, kq = lane >> 4;
    const unsigned char* base = C.ws + WS_S5 + (size_t)l * S5_LAYER;
    f32x4 gr[4], gi[4];
#pragma unroll
    for (int mt = 0; mt < 4; ++mt) { gr[mt] = (f32x4){0.f, 0.f, 0.f, 0.f}; gi[mt] = (f32x4){0.f, 0.f, 0.f, 0.f}; }
    if (k > 0) {
        const float* F = opaque((const float*)(C.ws + WS_S5F) + ((size_t)(b * 32) * 16 + g) * 128 + 4 * kq);
        const float* A256 = opaque((const float*)(base + S5_AP256) + (size_t)g * 32 * 128 + 4 * kq);
#pragma unroll
        for (int rep = 0; rep < 2; ++rep) { const int kp = cc + 16 * rep;
            if (kp < k) { const float* f = opaque(F + (size_t)kp * 16 * 128); const float* w = opaque(A256 + (size_t)(k - 1 - kp) * 128);
#pragma unroll
                for (int mt = 0; mt < 4; ++mt) { const f32x4 fr = *(const f32x4*)(f + 16 * mt), fi = *(const f32x4*)(f + 64 + 16 * mt), wr = *(const f32x4*)(w + 16 * mt), wi = *(const f32x4*)(w + 64 + 16 * mt);
                    gr[mt] += wr * fr - wi * fi; gi[mt] += wr * fi + wi * fr; } } }
#pragma unroll
        for (int mt = 0; mt < 4; ++mt)
#pragma unroll
            for (int r = 0; r < 4; ++r) {
#pragma unroll
                for (int o = 1; o < 16; o <<= 1) { gr[mt][r] += __shfl_xor(gr[mt][r], o); gi[mt][r] += __shfl_xor(gi[mt][r], o); } }
    }
    S5Wave W; s5_E_scan<true>(C, l, b, k, g, W);
#pragma unroll
    for (int mt = 0; mt < 8; ++mt)
#pragma unroll
        for (int r = 0; r < 4; ++r) W.X[mt][r] = dpp_shr(W.X[mt][r], 1);
#pragma unroll
    for (int mt = 0; mt < 4; ++mt) { W.X[mt] += W.wr[mt] * gr[mt] - W.wi[mt] * gi[mt]; W.X[mt + 4] += W.wr[mt] * gi[mt] + W.wi[mt] * gr[mt]; }
    bf16x8 tt[16];
    const bf16_t* ttp = opaque((const bf16_t*)(base + S5_TT) + ((size_t)(g * 16) * 64 + lane) * 8);
#pragma unroll
    for (int d4 = 0; d4 < 4; ++d4) { if (d4) ttp = opaque(ttp + 4 * 64 * 8);
#pragma unroll
        for (int d = 0; d < 4; ++d) tt[4 * d4 + d] = *(const bf16x8*)(ttp + (size_t)d * 64 * 8); }
    bf16x8 cm[4];
    const bf16_t* cmp = opaque((const bf16_t*)(base + S5_M2P) + (size_t)g * 16 * 128 + (size_t)cc * 128 + 8 * kq);
#pragma unroll
    for (int ks = 0; ks < 4; ++ks) cm[ks] = *(const bf16x8*)(cmp + 32 * ks);
    f32x4 a1r[4], a1i[4];
    { const float* A1 = opaque((const float*)(base + S5_AP16) + (size_t)g * S5_APS + 17 * 128 + 4 * kq);
#pragma unroll
      for (int mt = 0; mt < 4; ++mt) { a1r[mt] = *(const f32x4*)(A1 + 16 * mt); a1i[mt] = *(const f32x4*)(A1 + 64 + 16 * mt); } }
    LAS unsigned char* yt = C.lds + (size_t)(16 * cc) * S5_YSTRIDE + (16 * g + 4 * kq) * 2;
#pragma unroll
    for (int jj = 0; jj < 16; jj += 2) {
        bf16x8 sf1[4], sf2[4];
#pragma unroll
        for (int mt = 0; mt < 4; ++mt) { const f32x4 re = W.X[mt], im = W.X[mt + 4]; W.X[mt] = a1r[mt] * re - a1i[mt] * im; W.X[mt + 4] = a1r[mt] * im + a1i[mt] * re; }
#pragma unroll
        for (int ks = 0; ks < 4; ++ks) { u32x4 w; w.x = pk2(W.X[2 * ks][0], W.X[2 * ks][1]); w.y = pk2(W.X[2 * ks][2], W.X[2 * ks][3]); w.z = pk2(W.X[2 * ks + 1][0], W.X[2 * ks + 1][1]); w.w = pk2(W.X[2 * ks + 1][2], W.X[2 * ks + 1][3]); sf1[ks] = __builtin_bit_cast(bf16x8, w); }
#pragma unroll
        for (int mt = 0; mt < 4; ++mt) { const f32x4 re = W.X[mt], im = W.X[mt + 4]; W.X[mt] = a1r[mt] * re - a1i[mt] * im; W.X[mt + 4] = a1r[mt] * im + a1i[mt] * re; }
#pragma unroll
        for (int ks = 0; ks < 4; ++ks) { u32x4 w; w.x = pk2(W.X[2 * ks][0], W.X[2 * ks][1]); w.y = pk2(W.X[2 * ks][2], W.X[2 * ks][3]); w.z = pk2(W.X[2 * ks + 1][0], W.X[2 * ks + 1][1]); w.w = pk2(W.X[2 * ks + 1][2], W.X[2 * ks + 1][3]); sf2[ks] = __builtin_bit_cast(bf16x8, w); }
        f32x4 acc1 = {0.f, 0.f, 0.f, 0.f}, acc2 = {0.f, 0.f, 0.f, 0.f};
#pragma unroll
        for (int ks = 0; ks < 4; ++ks) { acc1 = __builtin_amdgcn_mfma_f32_16x16x32_bf16(cm[ks], sf1[ks], acc1, 0, 0, 0); acc2 = __builtin_amdgcn_mfma_f32_16x16x32_bf16(cm[ks], sf2[ks], acc2, 0, 0, 0); }
#pragma unroll
        for (int ks = 0; ks <= jj / 2; ++ks) { acc1 = __builtin_amdgcn_mfma_f32_16x16x32_bf16(tt[jj - 2 * ks], W.uf[ks], acc1, 0, 0, 0); acc2 = __builtin_amdgcn_mfma_f32_16x16x32_bf16(tt[jj + 1 - 2 * ks], W.uf[ks], acc2, 0, 0, 0); }
        const unsigned long long w1 = (unsigned long long)pk2(gelu_tanh(acc1[0]), gelu_tanh(acc1[1])) | ((unsigned long long)pk2(gelu_tanh(acc1[2]), gelu_tanh(acc1[3])) << 32);
        const unsigned long long w2 = (unsigned long long)pk2(gelu_tanh(acc2[0]), gelu_tanh(acc2[1])) | ((unsigned long long)pk2(gelu_tanh(acc2[2]), gelu_tanh(acc2[3])) << 32);
        *(LAS unsigned long long*)(yt + jj * S5_YSTRIDE) = w1; *(LAS unsigned long long*)(yt + (jj + 1) * S5_YSTRIDE) = w2;
    }
}
__device__ __forceinline__ void s5c_glu(const Ctx& C0, int l, int b, int k) {
    Ctx C = C0; asm volatile("; S5C_GLU_BEGIN\n" : "+v"(C.lane));
    const int lane = C.lane, r32 = lane & 31, hi = lane >> 5, tok = 32 * C.wave + r32;
    const bf16_t* gtp = opaque((const bf16_t*)(C.ws + WS_GLU) + (size_t)l * 65536 + (size_t)lane * 8);
    const float* gb = gptr(C.in[15]) + l * 256;
    const LAS unsigned char* yrow = C.lds + (size_t)tok * S5_YSTRIDE;
    bf16x8 yf[16];
#pragma unroll
    for (int ks = 0; ks < 16; ++ks) yf[ks] = *(const LAS bf16x8*)(yrow + (16 * ks + 8 * hi) * 2);
    bf16_t* op = (bf16_t*)(C.ws + WS_O) + ((size_t)b * SEQ + 256 * k + tok) * D + 256 + 4 * hi;
    bf16x8 wa[16], wb[16];
#pragma unroll
    for (int ks = 0; ks < 16; ++ks) wa[ks] = *(const bf16x8*)(gtp + 512 * ks);
#pragma unroll
    for (int ng = 0; ng < 4; ++ng) {
        f32x16 z[2];
#pragma unroll
        for (int r = 0; r < 16; ++r) { z[0][r] = 0.f; z[1][r] = 0.f; }
        gtp = opaque(gtp + 16 * 512);
#pragma unroll
        for (int ks = 0; ks < 16; ++ks) wb[ks] = *(const bf16x8*)(gtp + 512 * ks);
#pragma unroll
        for (int ks = 0; ks < 16; ++ks) z[0] = __builtin_amdgcn_mfma_f32_32x32x16_bf16(wa[ks], yf[ks], z[0], 0, 0, 0);
        if (ng < 3) { gtp = opaque(gtp + 16 * 512);
#pragma unroll
            for (int ks = 0; ks < 16; ++ks) wa[ks] = *(const bf16x8*)(gtp + 512 * ks); }
#pragma unroll
        for (int ks = 0; ks < 16; ++ks) z[1] = __builtin_amdgcn_mfma_f32_32x32x16_bf16(wb[ks], yf[ks], z[1], 0, 0, 0);
        float ob[2][16]; float ss = 0.f;
#pragma unroll
        for (int m2 = 0; m2 < 2; ++m2)
#pragma unroll
            for (int q4 = 0; q4 < 4; ++q4) { const int ch = 32 * (2 * ng + m2) + 8 * q4 + 4 * hi;
                const unsigned long long yw = *(const LAS unsigned long long*)(yrow + ch * 2); const f32x4 bb = *(const f32x4*)(gb + ch);
                const float y0 = __uint_as_float((unsigned)yw << 16), y1 = __uint_as_float((unsigned)yw & 0xffff0000u), y2 = __uint_as_float((unsigned)(yw >> 32) << 16), y3 = __uint_as_float((unsigned)(yw >> 32) & 0xffff0000u);
                const float o0 = fast_sigmoid_mul(y0, z[m2][4 * q4] + bb[0]), o1 = fast_sigmoid_mul(y1, z[m2][4 * q4 + 1] + bb[1]), o2 = fast_sigmoid_mul(y2, z[m2][4 * q4 + 2] + bb[2]), o3 = fast_sigmoid_mul(y3, z[m2][4 * q4 + 3] + bb[3]);
                ob[m2][4 * q4] = o0; ob[m2][4 * q4 + 1] = o1; ob[m2][4 * q4 + 2] = o2; ob[m2][4 * q4 + 3] = o3; ss += (o0 * o0 + o1 * o1) + (o2 * o2 + o3 * o3); }
        ss += __shfl_xor(ss, 32);
        const float rn = 1.0f / sqrtf(ss * (1.f / 64.f) + EPS);
#pragma unroll
        for (int m2 = 0; m2 < 2; ++m2)
#pragma unroll
            for (int q4 = 0; q4 < 4; ++q4)
                *(unsigned long long*)(op + 64 * ng + 32 * m2 + 8 * q4) = (unsigned long long)pk2(ob[m2][4 * q4] * rn, ob[m2][4 * q4 + 1] * rn) | ((unsigned long long)pk2(ob[m2][4 * q4 + 2] * rn, ob[m2][4 * q4 + 3] * rn) << 32);
    }
}
__device__ __forceinline__ void s5c_item(const Ctx& C, int l, int it) {
    const int b = it >> 5, k = it & 31;
    REPEAT(22, s5c_group(C, l, b, k, 2 * C.wave); s5c_group(C, l, b, k, 2 * C.wave + 1));
    __syncthreads();
    REPEAT(23, s5c_glu(C, l, b, k));
    __syncthreads();
}

constexpr int SGU_VS = 576;
__device__ __forceinline__ void sgu_item(const Ctx& C, int l, int it) {
    const bf16_t* U = (const bf16_t*)(C.ws + WS_U); const bf16_t* V = (const bf16_t*)(C.ws + WS_V); bf16_t* O = (bf16_t*)(C.ws + WS_O);
    const float* gain = gptr(C.in[3]) + l * 256; const float* sgu_b = gptr(C.in[5]) + l * 512;
    const bf16_t* Wb = (const bf16_t*)(C.ws + WS_SGUW) + (size_t)l * 65536;
    const int tid = C.tid, lane = C.lane, r32 = lane & 31, hi = lane >> 5;
    const size_t t0 = (size_t)it * 128;
    {
        const int row = tid >> 2, qt = tid & 3;
        const u32x4* src = (const u32x4*)(V + (t0 + row) * 256 + qt * 64);
        u32x4 w[8]; float ss = 0.f;
#pragma unroll
        for (int i = 0; i < 8; ++i) { w[i] = src[i];
#pragma unroll
            for (int e = 0; e < 4; ++e) { const float a = __uint_as_float(w[i][e] << 16), b = __uint_as_float(w[i][e] & 0xffff0000u); ss += a * a + b * b; } }
        ss += __shfl_xor(ss, 1); ss += __shfl_xor(ss, 2);
        const float rs = 1.0f / sqrtf(ss * (1.f / 256.f) + EPS);
        LAS unsigned char* dst = C.lds + row * SGU_VS + qt * 128;
#pragma unroll
        for (int i = 0; i < 8; ++i) { const f32x4 g0 = *(const f32x4*)(gain + qt * 64 + 8 * i), g1 = *(const f32x4*)(gain + qt * 64 + 8 * i + 4);
            u32x4 o;
            o.x = pk2(__uint_as_float(w[i].x << 16) * rs * g0.x, __uint_as_float(w[i].x & 0xffff0000u) * rs * g0.y); o.y = pk2(__uint_as_float(w[i].y << 16) * rs * g0.z, __uint_as_float(w[i].y & 0xffff0000u) * rs * g0.w);
            o.z = pk2(__uint_as_float(w[i].z << 16) * rs * g1.x, __uint_as_float(w[i].z & 0xffff0000u) * rs * g1.y); o.w = pk2(__uint_as_float(w[i].w << 16) * rs * g1.z, __uint_as_float(w[i].w & 0xffff0000u) * rs * g1.w);
            *(LAS u32x4*)(dst + 16 * i) = o; }
    }
    __syncthreads();
    const int h = C.wave >> 1, ih = C.wave & 1;
    const int nks = ih ? 8 : 4;
    f32x16 acc[2][2];
#pragma unroll
    for (int mt = 0; mt < 2; ++mt)
#pragma unroll
        for (int nt = 0; nt < 2; ++nt)
#pragma unroll
            for (int r = 0; r < 16; ++r) acc[mt][nt][r] = 0.f;
    const int i16 = lane & 15;
    const LAS unsigned char* vb = C.lds + (8 * hi + (i16 >> 2)) * SGU_VS + (64 * h + 16 * ((lane >> 4) & 1) + 4 * (i16 & 3)) * 2;
    const bf16_t* wp = Wb + ((size_t)h * 128 + 64 * ih + r32) * 128 + 8 * hi;
    for (int ks = 0; ks < nks; ++ks) {
        bf16x8 af[2], bfr[2];
#pragma unroll
        for (int mt = 0; mt < 2; ++mt) { const s16x4 lo = ds_tr(vb + (16 * ks) * SGU_VS + 64 * mt), hi4 = ds_tr(vb + (16 * ks + 4) * SGU_VS + 64 * mt);
            af[mt] = (bf16x8){lo[0], lo[1], lo[2], lo[3], hi4[0], hi4[1], hi4[2], hi4[3]}; }
#pragma unroll
        for (int nt = 0; nt < 2; ++nt) bfr[nt] = *(const bf16x8*)(wp + (size_t)(32 * nt) * 128 + 16 * ks);
#pragma unroll
        for (int mt = 0; mt < 2; ++mt)
#pragma unroll
            for (int nt = 0; nt < 2; ++nt) acc[mt][nt] = __builtin_amdgcn_mfma_f32_32x32x16_bf16(af[mt], bfr[nt], acc[mt][nt], 0, 0, 0);
    }
#pragma unroll
    for (int nt = 0; nt < 2; ++nt) {
        const int i = 64 * ih + 32 * nt + r32; const float bias = sgu_b[h * 128 + i];
        const bf16_t* up = U + (t0 + i) * 256 + 64 * h + 4 * hi; bf16_t* op = O + (t0 + i) * D + 64 * h + 4 * hi;
        float ov[2][16]; float ss = 0.f;
#pragma unroll
        for (int mt = 0; mt < 2; ++mt)
#pragma unroll
            for (int q4 = 0; q4 < 4; ++q4) { const unsigned long long uw = *(const unsigned long long*)(up + 32 * mt + 8 * q4);
                const float u0 = __uint_as_float((unsigned)uw << 16), u1 = __uint_as_float((unsigned)uw & 0xffff0000u), u2 = __uint_as_float((unsigned)(uw >> 32) << 16), u3 = __uint_as_float((unsigned)(uw >> 32) & 0xffff0000u);
                const float o0 = u0 * (acc[mt][nt][4 * q4] + bias), o1 = u1 * (acc[mt][nt][4 * q4 + 1] + bias), o2 = u2 * (acc[mt][nt][4 * q4 + 2] + bias), o3 = u3 * (acc[mt][nt][4 * q4 + 3] + bias);
                ov[mt][4 * q4] = o0; ov[mt][4 * q4 + 1] = o1; ov[mt][4 * q4 + 2] = o2; ov[mt][4 * q4 + 3] = o3; ss += (o0 * o0 + o1 * o1) + (o2 * o2 + o3 * o3); }
        ss += __shfl_xor(ss, 32);
        const float rn = 1.0f / sqrtf(ss * (1.f / 64.f) + EPS);
#pragma unroll
        for (int mt = 0; mt < 2; ++mt)
#pragma unroll
            for (int q4 = 0; q4 < 4; ++q4)
                *(unsigned long long*)(op + 32 * mt + 8 * q4) = (unsigned long long)pk2(ov[mt][4 * q4] * rn, ov[mt][4 * q4 + 1] * rn) | ((unsigned long long)pk2(ov[mt][4 * q4 + 2] * rn, ov[mt][4 * q4 + 3] * rn) << 32);
    }
    __syncthreads();
}

__device__ __forceinline__ void route_block(const Ctx& C, int l, int it) {
    const float* bg = gptr(C.in[23]) + l * 4; const float* be = gptr(C.in[25]) + l * 16;
    unsigned* cnt = (unsigned*)(C.ws + WS_CTL) + (C.dry ? 2048 : CW_CNT + l * 32);
    int* m_bucket = (int*)(C.ws + WS_META + MT_BUCKET); int* m_pos = (int*)(C.ws + WS_META + MT_POS);
    float* m_gw0 = (float*)(C.ws + WS_META + MT_GW0); float* m_gw1 = (float*)(C.ws + WS_META + MT_GW1); float* m_rs = (float*)(C.ws + WS_META + MT_RS2);
    bf16_t* XB = (bf16_t*)(C.ws + WS_XB);
    LAS unsigned* hist = (LAS unsigned*)C.lds; LAS unsigned* hbase = hist + 32;
    const int lane = C.lane, r32 = lane & 31, hi = lane >> 5;
    if (C.tid < 32) hist[C.tid] = 0u;
    __syncthreads();
    int bk = 0, rank = 0; float glo = 0.f, ghi = 0.f, rs = 0.f; const int t = it * 128 + C.wave * 32 + r32;
    if (C.wave < 4) {
        const bf16_t* xbr = XB + (size_t)t * D + 8 * hi;
        const bf16_t* whp = opaque((const bf16_t*)(C.ws + WS_ROUTEW) + (size_t)l * 65536 + (size_t)lane * 8);
        f32x16 acc;
#pragma unroll
        for (int r = 0; r < 16; ++r) acc[r] = 0.f;
        for (int kb = 0; kb < 8; ++kb) {
            bf16x8 xh[8], wh[8], wl[8];
#pragma unroll
            for (int i = 0; i < 8; ++i) { const int ks = 8 * kb + i; xh[i] = *(const bf16x8*)(xbr + 16 * ks); wh[i] = *(const bf16x8*)(whp + 512 * ks); wl[i] = *(const bf16x8*)(whp + 32768 + 512 * ks); }
#pragma unroll
            for (int i = 0; i < 8; ++i) { acc = __builtin_amdgcn_mfma_f32_32x32x16_bf16(wh[i], xh[i], acc, 0, 0, 0); acc = __builtin_amdgcn_mfma_f32_32x32x16_bf16(wl[i], xh[i], acc, 0, 0, 0); }
        }
        rs = row_rstd((const float*)(C.ws + WS_SSQB), t);
        float mine[12], oth[12];
#pragma unroll
        for (int r = 0; r < 12; ++r) { mine[r] = acc[r]; oth[r] = __shfl_xor(acc[r], 32); }
        float lg[20];
#pragma unroll
        for (int q = 0; q < 5; ++q)
#pragma unroll
            for (int e = 0; e < 4; ++e) { const int n = 4 * q + e;
                const float v0 = ((q & 1) == 0) ? mine[4 * (q >> 1) + e] : oth[4 * (q >> 1) + e], v1 = ((q & 1) == 0) ? oth[4 * (q >> 1) + e] : mine[4 * (q >> 1) + e];
                lg[n] = (hi == 0 ? v0 : v1) * rs; }
        float gl[4]; int gt = 0;
#pragma unroll
        for (int i = 0; i < 4; ++i) gl[i] = lg[i] + bg[i];
        float gm = gl[0];
#pragma unroll
        for (int i = 1; i < 4; ++i) if (gl[i] > gm) { gm = gl[i]; gt = i; }
        float gs = 0.f;
#pragma unroll
        for (int i = 0; i < 4; ++i) gs += __expf(gl[i] - gm);
        const float pg = 1.f / gs;
        float el[4];
#pragma unroll
        for (int i = 0; i < 4; ++i) { float v = 0.f;
#pragma unroll
            for (int gi = 0; gi < 4; ++gi) v = (gi == gt) ? lg[4 + 4 * gi + i] + be[gi * 4 + i] : v;
            el[i] = v; }
        int i1 = 0; float m1 = el[0];
#pragma unroll
        for (int i = 1; i < 4; ++i) if (el[i] > m1) { m1 = el[i]; i1 = i; }
        int i2 = -1; float m2 = -3.0e38f;
#pragma unroll
        for (int i = 0; i < 4; ++i) if (i != i1 && el[i] > m2) { m2 = el[i]; i2 = i; }
        const float e2 = __expf(m2 - m1); const float w1 = 1.f / (1.f + e2), w2 = e2 / (1.f + e2);
        const int lo = i1 < i2 ? i1 : i2, hi2 = i1 < i2 ? i2 : i1;
        const int pi = (lo == 0) ? (hi2 - 1) : (lo == 1 ? hi2 + 1 : 5);
        bk = gt * 6 + pi;
        glo = pg * (i1 < i2 ? w1 : w2); ghi = pg * (i1 < i2 ? w2 : w1);
        if (hi == 0) rank = (int)atomicAdd((unsigned*)(hist + bk), 1u);
    }
    __syncthreads();
    if (C.tid < NBUCKET) { const unsigned n = hist[C.tid]; hbase[C.tid] = n ? atomicAdd(cnt + C.tid, n) : 0u; }
    __syncthreads();
    if (C.wave < 4 && hi == 0) { const size_t li = C.dry ? (size_t)(T * 24) + (size_t)(t & 1023) : (size_t)bk * T + hbase[bk] + rank;
        ((int*)(C.ws + WS_BLIST))[li] = t; ((float*)(C.ws + WS_BGW0))[li] = glo; ((float*)(C.ws + WS_BGW1))[li] = ghi; ((float*)(C.ws + WS_BRS))[li] = rs; }
    __syncthreads();
}
__device__ __forceinline__ void phase_perm(const Ctx& C, int l) {
    const unsigned* cnt = (const unsigned*)(C.ws + WS_CTL) + CW_CNT + l * 32; unsigned* tileb = (unsigned*)(C.ws + WS_CTL) + CW_TILEB + l * 160;
    const int* m_bucket = (const int*)(C.ws + WS_META + MT_BUCKET); const int* m_pos = (const int*)(C.ws + WS_META + MT_POS);
    const float* m_gw0 = (const float*)(C.ws + WS_META + MT_GW0); const float* m_gw1 = (const float*)(C.ws + WS_META + MT_GW1); const float* m_rs = (const float*)(C.ws + WS_META + MT_RS2);
    const bf16_t* XB = (const bf16_t*)(C.ws + WS_XB); bf16_t* XS = (bf16_t*)(C.ws + WS_XS); int* stok = (int*)(C.ws + WS_META + MT_STOK) + l * MAXROWS;
    float* sgw0 = (float*)(C.ws + WS_META + MT_SGW0); float* sgw1 = (float*)(C.ws + WS_META + MT_SGW1); float* srs = (float*)(C.ws + WS_META + MT_SRS);
    const int lane = C.lane;
    int nt = (lane < NBUCKET) ? (((int)cnt[lane] + 255) >> 8) : 0, incl = nt;
#pragma unroll
    for (int o = 1; o < 32; o <<= 1) { const int v = __shfl_up(incl, o); if (lane >= o) incl += v; }
    const int excl = incl - nt;
    if (C.gw == 0) { if (lane < NBUCKET) for (int i = 0; i < nt; ++i) tileb[excl + i] = (unsigned)lane; if (lane == NBUCKET - 1) tileb[159] = (unsigned)incl; }
    for (int t = C.gw * 4; t < T; t += C.ngw * 4) {
        int dst[4]; u32x4 v[4][2];
#pragma unroll
        for (int j = 0; j < 4; ++j) { const int bk = m_bucket[t + j]; dst[j] = __shfl(excl, bk) * 256 + m_pos[t + j];
            const u32x4* src = (const u32x4*)(XB + (size_t)(t + j) * D) + lane; v[j][0] = src[0]; v[j][1] = src[64]; }
#pragma unroll
        for (int j = 0; j < 4; ++j) { u32x4* d = (u32x4*)(XS + (size_t)dst[j] * D) + lane; d[0] = v[j][0]; d[64] = v[j][1];
            if (lane == 0) { stok[dst[j]] = t + j; sgw0[dst[j]] = m_gw0[t + j]; sgw1[dst[j]] = m_gw1[t + j]; srs[dst[j]] = m_rs[t + j]; } }
    }
}

__device__ __forceinline__ void phase_prologue(const Ctx& C) {
    LAS float* scr = (LAS float*)(C.lds + C.wave * 16896);
    { const int l = 0; REPEAT(101, phase_prep_weights(C, scr)); }
    { const int l = 0; REPEAT(102, for (int it = C.gw; it < S5_ITEMS; it += C.ngw) s5_prep_item(C, it, scr)); }
    { bf16_t* rw = (bf16_t*)(C.ws + WS_ROUTEW);
      for (int i = C.gw * 64 + C.lane; i < DEPTH * 32 * D; i += C.ngw * 64) { const int l = i / (32 * D), n = (i / D) & 31, k = i & (D - 1);
          float v = 0.f;
          if (n < 4) v = gptr(C.in[22])[((size_t)l * D + k) * 4 + n]; else if (n < 20) v = gptr(C.in[24])[(((size_t)l * 4 + ((n - 4) >> 2)) * D + k) * 4 + ((n - 4) & 3)];
          v *= gptr(C.in[21])[l * D + k];
          const bf16_t h = f2bf(v); const size_t fo = (size_t)l * 65536 + (size_t)(((k >> 4) * 64 + ((k >> 3) & 1) * 32 + n) * 8 + (k & 7));
          rw[fo] = h; rw[fo + 32768] = f2bf(v - bf2f(h)); } }
    { const float* sw = gptr(C.in[4]); bf16_t* dw = (bf16_t*)(C.ws + WS_SGUW);
      for (int i = C.gw * 64 + C.lane; i < DEPTH * 65536 / 2; i += C.ngw * 64) ((unsigned*)dw)[i] = pk2(sw[2 * i], sw[2 * i + 1]); }
    { const int l = 0; REPEAT(103, phase_conv(C, gptr(C.in[0]))); }
}


#define XB_TMO      128
#define XB_XCNT(j)  (256  + 64 * (j))
#define XB_XSUB(j)  (1280 + 64 * (j))
#define XB_XGEN(j)  (2304 + 64 * (j))
#define XB_TOP      3328
#define XB_TOPGEN   3392
#define XCD_BAR_WORDS 3456
#define XB_SPIN_CAP (1u << 18)

__device__ __forceinline__ unsigned xb_ld(unsigned* p)              { return __hip_atomic_load(p, __ATOMIC_RELAXED, __HIP_MEMORY_SCOPE_AGENT); }
__device__ __forceinline__ unsigned xb_add(unsigned* p, unsigned v) { return __hip_atomic_fetch_add(p, v, __ATOMIC_RELAXED, __HIP_MEMORY_SCOPE_AGENT); }
__device__ __forceinline__ unsigned xb_xcc_id() { return (unsigned)__builtin_amdgcn_s_getreg((3 << 11) | 20) & 0xFu; }
#define XB_SPIN(cond, bar) do { unsigned _sp = 0; while (cond) { __builtin_amdgcn_s_sleep(1); \
    if ((++_sp & 255u) == 0u) { if (xb_ld(&(bar)[XB_TMO])) break; if (_sp > XB_SPIN_CAP) { atomicAdd(&(bar)[XB_TMO], 1u); break; } } } } while (0)

struct XcdBarrier {
    unsigned* bar; unsigned x;
    volatile LAS unsigned* st;
};

__device__ __forceinline__ XcdBarrier xcd_barrier_post(unsigned* bar, volatile LAS unsigned* st) {
    XcdBarrier b; b.bar = bar; b.x = xb_xcc_id(); b.st = st;
    if (threadIdx.x == 0) (void)xb_add(&bar[XB_XCNT(b.x)], 1u);
    return b;
}
__device__ __forceinline__ void xcd_barrier_complete(unsigned* bar, unsigned x, unsigned& nloc, unsigned& nx) {
    const unsigned G = gridDim.x * gridDim.y * gridDim.z;
    unsigned sum, cnt, mine, sp = 0u;
    for (;;) {
        sum = 0u; cnt = 0u; mine = 0u;
#pragma unroll
        for (unsigned j = 0; j < 16; ++j) { const unsigned c = xb_ld(&bar[XB_XCNT(j)]); sum += c; cnt += (c > 0u) ? 1u : 0u; mine = (j == x) ? c : mine; }
        if (sum == G) break;
        __builtin_amdgcn_s_sleep(1);
        if ((++sp & 255u) == 0u) { if (xb_ld(&bar[XB_TMO])) break; if (sp > XB_SPIN_CAP) { atomicAdd(&bar[XB_TMO], 1u); break; } }
    }
    nloc = mine > 0u ? mine : 1u; nx = cnt > 0u ? cnt : 1u;
}

__device__ __forceinline__ void xcd_barrier(const XcdBarrier& b) {
    asm volatile("s_waitcnt vmcnt(0)" ::: "memory");
    __syncthreads();
    if (threadIdx.x == 0) {
        unsigned* bar = b.bar;
        __builtin_amdgcn_s_waitcnt(0);
        unsigned nloc = b.st[0], nx = b.st[1];
        if (nloc == 0u) { xcd_barrier_complete(bar, b.x, nloc, nx); b.st[0] = nloc; b.st[1] = nx; }
        const unsigned old = xb_add(&bar[XB_XSUB(b.x)], 1u);
        const unsigned gen = old / nloc;
        if (old + 1u == (gen + 1u) * nloc) {
            __builtin_amdgcn_fence(__ATOMIC_RELEASE, "agent");
            asm volatile("s_waitcnt vmcnt(0)" ::: "memory");
            const unsigned og = xb_add(&bar[XB_TOP], 1u);
            const unsigned tg = og / nx;
            if (og + 1u == (tg + 1u) * nx) xb_add(&bar[XB_TOPGEN], 1u);
            else XB_SPIN(xb_ld(&bar[XB_TOPGEN]) == tg, bar);
            __builtin_amdgcn_fence(__ATOMIC_ACQUIRE, "agent");
            xb_add(&bar[XB_XGEN(b.x)], 1u);
            asm volatile("s_waitcnt vmcnt(0)" ::: "memory");
        } else {
            XB_SPIN(xb_ld(&bar[XB_XGEN(b.x)]) == gen, bar);
            __builtin_amdgcn_fence(__ATOMIC_ACQUIRE, "agent");
            asm volatile("s_waitcnt vmcnt(0)" ::: "memory");
        }
    }
    __syncthreads();
}

constexpr int PH_PER_LAYER = 6, N_PHASES = 1 + DEPTH * PH_PER_LAYER;
__global__ void __launch_bounds__(NTHREADS, 2) mk_fwd(KArgs args) {
    extern __shared__ __attribute__((aligned(16))) unsigned char lds_raw[];
    const int lo = args.ph_lo, hi = args.ph_hi;
    const int wave_s = __builtin_amdgcn_readfirstlane(threadIdx.x >> 6);
    if (threadIdx.x < 16) ((LAS unsigned*)(lds_raw + LDS_BARW))[threadIdx.x] = 0u;
    __syncthreads();
    cg::this_grid().sync();
    XcdBarrier bar = xcd_barrier_post((unsigned*)(args.ws + WS_CTL) + CW_BAR, (volatile LAS unsigned*)((LAS unsigned char*)lds_raw + LDS_BARW));
    int reps_left = REP_N - 1;
    for (int ph = lo; ph < hi; ++ph) {
        unsigned ones = ~0u; asm volatile("" : "+s"(ones));
        int tid = wave_s * 64 + (int)__builtin_amdgcn_mbcnt_hi(ones, __builtin_amdgcn_mbcnt_lo(ones, 0u)); asm volatile("" : "+v"(tid));
        GAS unsigned char* wsg = (GAS unsigned char*)args.ws; asm volatile("" : "+s"(wsg)); unsigned char* ws = (unsigned char*)wsg;
        Ctx C;
        C.lds = (LAS unsigned char*)lds_raw;
        C.in = args.in; { GAS float* og = (GAS float*)args.out; asm volatile("" : "+s"(og)); C.out = (float*)og; } C.ws = ws;
        C.tid = tid; C.lane = tid & 63; C.wave = __builtin_amdgcn_readfirstlane(tid >> 6);
        C.G = gridDim.x; C.gw = blockIdx.x * NWAVES + C.wave; C.ngw = C.G * NWAVES; C.dry = (ph == REP_PH && reps_left > 0);
        if (ph == 0) { const int l = 0; REPEAT(100, phase_prologue(C)); }
        else {
            const int l = (ph - 1) / PH_PER_LAYER, k = (ph - 1) % PH_PER_LAYER;
            const float* xres = (l == 0) ? gptr(args.in[0]) : (const float*)C.out;
            const unsigned* tileb = (const unsigned*)(ws + WS_CTL) + CW_TILEB + l * 160;
            if (k == 0) {
                if (l > 0) {
                    const float* ssqp = (const float*)(ws + WS_SSQP); float* rstd = (float*)(ws + WS_META + MT_RSTD);
                    for (int r0 = C.gw * 4; r0 < T; r0 += C.ngw * 4) { const int row = r0 + (C.lane >> 4); float v = ssqp[(size_t)row * 16 + (C.lane & 15)];
#pragma unroll
                        for (int o = 1; o < 16; o <<= 1) v += __shfl_xor(v, o);
                        if ((C.lane & 15) == 0) rstd[row] = 1.0f / sqrtf(v * (1.f / D) + EPS); }
                    xcd_barrier(bar);
                }
                DenseSched S; S.init(ws + WS_XB, (const bf16_t*)(ws + WS_WIN) + (size_t)l * NIN * D, T, NIN, D, C.G, (int)blockIdx.x);
                EpiIn E{(const float*)(ws + WS_META + MT_RSTD), (bf16_t*)(ws + WS_U), (bf16_t*)(ws + WS_QH), gptr(args.in[16]) + l * 64, gptr(args.in[17]) + l * 64};
                REPEAT(0, (pg8::gemm_phase<EpiIn, DenseSched, true, true>(C.lds, D, S, E, C.tid)));
            } else if (k == 1) {
                for (int it = C.gw; it < BATCH * 32 * 16; it += C.ngw) s5a_item(C, l, it);
                unsigned* s5cnt = (unsigned*)(ws + WS_CTL) + CW_S5A + l;
                asm volatile("s_waitcnt vmcnt(0)" ::: "memory");
                __syncthreads();
                if (threadIdx.x == 0) { __builtin_amdgcn_fence(__ATOMIC_RELEASE, "agent"); asm volatile("s_waitcnt vmcnt(0)" ::: "memory"); (void)xb_add(s5cnt, 1u); }
                const int half = C.G >> 1, nit = BATCH * NH * (SEQ / 256), nA = (nit * 5) >> 3;
                const bool sblk = (int)blockIdx.x < half; const int bx = sblk ? (int)blockIdx.x : (int)blockIdx.x - half;
                if (!sblk) { for (int it = bx; it < T / 128; it += half) sgu_item(C, l, it); }
                const int bxv = ((half & 7) == 0) ? (bx & 7) * (half >> 3) + (bx >> 3) : bx;
                phase_attn(C, l, sblk ? nA + bxv : bxv, half, sblk ? nit : nA);
                if (sblk) {
                    if (threadIdx.x == 0) { XB_SPIN(xb_ld(s5cnt) < (unsigned)C.G, (unsigned*)(ws + WS_CTL) + CW_BAR); __builtin_amdgcn_fence(__ATOMIC_ACQUIRE, "agent"); asm volatile("s_waitcnt vmcnt(0)" ::: "memory"); }
                    __syncthreads();
                    for (int it = blockIdx.x; it < BATCH * 32; it += half) s5c_item(C, l, it); }
            } else if (k == 2) {
                DenseSched S; S.init(ws + WS_O, (const bf16_t*)(ws + WS_WOUT) + (size_t)l * D * D, T, D, D, C.G, (int)blockIdx.x);
                EpiOut E{(bf16_t*)(ws + WS_XB), (float*)(ws + WS_SSQB), C.dry ? (size_t)((WS_XS - WS_XB) / 2) : (size_t)0};
                REPEAT(3, (pg8::gemm_phase<EpiOut, DenseSched, true, true>(C.lds, D, S, E, C.tid)));
            } else if (k == 3) {
                for (int it = blockIdx.x; it < T / 128; it += C.G) route_block(C, l, it);
            } else if (k == 4) {
                build_tile_table(C, l);
                TileTab tt{(const LAS int*)(C.lds + TB_OFF)};
                GroupSched S{(const char*)(ws + WS_XB), (const char*)((const bf16_t*)(ws + WS_WGU) + (size_t)l * 16 * 512 * D), tt, (const int*)(ws + WS_BLIST), tt.ntiles(), C.G, (int)blockIdx.x, 1, (size_t)0};
                EpiG1 E{tt, (const float*)(ws + WS_BGW0), (const float*)(ws + WS_BGW1), (const float*)(ws + WS_BRS), (bf16_t*)(ws + WS_H)};
                REPEAT(6, (pg8::gemm_phase<EpiG1, GroupSched, true, true, true>(C.lds, D, S, E, C.tid)));
            } else {
                build_tile_table(C, l);
                TileTab tt{(const LAS int*)(C.lds + TB_OFF)};
                GroupSched S{(const char*)(ws + WS_H), (const char*)((const bf16_t*)(ws + WS_WDN) + (size_t)l * NBUCKET * D * 512), tt, (const int*)(ws + WS_BLIST), tt.ntiles(), C.G, (int)blockIdx.x, 2, (size_t)256 * 512 * 2};
                if (l + 1 < DEPTH) { EpiG2<true> E{tt, (const int*)(ws + WS_BLIST), C.out, (bf16_t*)(ws + WS_XB), (float*)(ws + WS_SSQP), C.dry ? (size_t)((WS_XS - WS_XB) / 2) : (size_t)0};
                    pg8::gemm_phase<EpiG2<true>, GroupSched, true, true>(C.lds, 512, S, E, C.tid); }
                else { EpiG2<false> E{tt, (const int*)(ws + WS_BLIST), C.out, (bf16_t*)(ws + WS_XB), nullptr, (size_t)0};
                    pg8::gemm_phase<EpiG2<false>, GroupSched, true, true>(C.lds, 512, S, E, C.tid); }
            }
        }
        if (ph == REP_PH && reps_left > 0) { --reps_left; --ph; }
        if (ph + 1 < hi) xcd_barrier(bar);
    }
}

extern "C" void kernel_launch(void* const* d_in, const int* in_sizes, int n_in, void* d_out, int out_size, void* d_ws, size_t ws_size, hipStream_t stream) {
    static int grid = 0;
    if (grid == 0) {
        if (n_in != 29 || ws_size < WS_END) { fprintf(stderr, "kernel_launch: unexpected inputs (n_in %d, ws %zu)\n", n_in, ws_size); grid = -1; return; }
        int dev = 0, cus = 0, per_cu = 0;
        (void)hipGetDevice(&dev); (void)hipDeviceGetAttribute(&cus, hipDeviceAttributeMultiprocessorCount, dev);
        if (hipFuncSetAttribute((const void*)mk_fwd, hipFuncAttributeMaxDynamicSharedMemorySize, LDS_BYTES) != hipSuccess) { fprintf(stderr, "kernel_launch: hipFuncSetAttribute failed\n"); grid = -1; return; }
        if (hipOccupancyMaxActiveBlocksPerMultiprocessor(&per_cu, (const void*)mk_fwd, NTHREADS, LDS_BYTES) != hipSuccess || per_cu < 1) { fprintf(stderr, "kernel_launch: occupancy query says %d blocks/CU\n", per_cu); per_cu = 1; }
        (void)hipGetLastError();
        grid = cus * (per_cu > 1 ? 1 : per_cu);
        fprintf(stderr, "kernel_launch: grid %d (cus %d, per_cu %d)\n", grid, cus, per_cu);
    }
    if (grid < 0) return;
    (void)hipMemsetAsync((char*)d_ws + WS_CTL, 0, 1 * MiB, stream);
    KArgs a{};
    for (int i = 0; i < 29; ++i) a.in[i] = (const float*)d_in[i];
    a.out = (float*)d_out; a.ws = (unsigned char*)d_ws;
#if MK_ONE_LAUNCH
    a.ph_lo = 0; a.ph_hi = N_PHASES;
    void* kargs[] = {&a};
    hipError_t e = hipLaunchCooperativeKernel((const void*)mk_fwd, dim3(grid), dim3(NTHREADS), kargs, LDS_BYTES, stream);
    if (e != hipSuccess) fprintf(stderr, "cooperative launch failed: %s (grid %d)\n", hipGetErrorString(e), grid);
#else
    for (int p = 0; p < N_PHASES - 1; ++p) { a.ph_lo = p; a.ph_hi = p + 1; hipLaunchKernelGGL(mk_fwd, dim3(grid), dim3(NTHREADS), LDS_BYTES, stream, a); }
#endif
}
```

```cpp
#include <hip/hip_runtime.h>
#include <hip/hip_cooperative_groups.h>
#include <cstdint>
#include <cstdio>
namespace cg = cooperative_groups;

#ifndef MK_ONE_LAUNCH
#define MK_ONE_LAUNCH 1
#endif

namespace pg8 {
#define PG8_LAS __attribute__((address_space(3)))
typedef unsigned short bf16_t;
typedef short bf16x8 __attribute__((ext_vector_type(8)));
typedef float f32x4 __attribute__((ext_vector_type(4)));
typedef unsigned u32x4 __attribute__((ext_vector_type(4)));
constexpr int BM = 256, BK = 64, HALF = 128, HTB = HALF * BK * 2  , STAGE_BYTES = 8 * HTB, NXCD = 8, WGM = 8;
__host__ __device__ __forceinline__ int lds_byte(int r, int c) { const int st = (r >> 4) * 2 + (c >> 5), rr = r & 15, cc = c & 31, ob = rr * 64 + cc * 2; return st * 1024 + (ob ^ (((ob >> 9) & 1) << 5)); }
__host__ __device__ __forceinline__ void stage_rc(int b, int& R, int& C) { const int st = b / 1024, sb = b % 1024, swz = sb ^ (((sb >> 9) & 1) << 5); R = (st >> 1) * 16 + swz / 64; C = (st & 1) * 32 + (swz % 64) / 2; }
__host__ __device__ __forceinline__ int perm32(int rho) { const int n = rho >> 4, i = rho & 15; return 8 * (i >> 2) + 4 * n + (i & 3); }
struct Unit { int pm, pn, hf; };
__device__ __forceinline__ unsigned cvt_pk_bf16(float lo, float hi) { unsigned r; asm volatile("v_cvt_pk_bf16_f32 %0, %1, %2" : "=v"(r) : "v"(lo), "v"(hi)); return r; }
template <class Epi, class Sched, bool ALIGN_EPI = false, bool SP2 = false, bool GATHER = false>
__device__ __forceinline__ void gemm_phase(PG8_LAS unsigned char* lds, const int gK, const Sched& S, const Epi& E, const int tid) {
    const int wid = __builtin_amdgcn_readfirstlane(tid >> 6), lane = tid & 63, wr = wid >> 2, wc = wid & 3, fr = lane & 15, fq = lane >> 4;
    const int K = gK, nt = K / BK;
    unsigned voffA[2], voffB[2];
#pragma unroll
    for (int i = 0; i < 2; ++i) { int R, C; stage_rc(tid * 16 + i * 8192, R, C); const int Rb = Epi::PERM ? ((R & ~31) + perm32(R & 31)) : R;
        voffA[i] = (unsigned)(R * K + C) * 2u; voffB[i] = (unsigned)(Rb * K + C) * 2u; }
    unsigned gA[2], gN[2], gcol[2];
    if constexpr (GATHER) { _Pragma("unroll") for (int i = 0; i < 2; ++i) { int R_, C_; stage_rc(tid * 16 + i * 8192, R_, C_); gcol[i] = (unsigned)C_ * 2u; } }
#define PG8_GLOAD(dst, unit) do { _Pragma("unroll") for (int _h = 0; _h < 2; ++_h) { int R0_, R1_, C_; stage_rc(tid * 16, R0_, C_); stage_rc(tid * 16 + 8192, R1_, C_); \
        dst[_h] = (unsigned)S.a_row(unit, R0_ + 128 * _h) | ((unsigned)S.a_row(unit, R1_ + 128 * _h) << 16); } } while (0)
#define PG8_STAGE_A(bufoff, gbase, half, isnext) do { if constexpr (GATHER) { const unsigned g_ = (isnext) ? gN[half] : gA[half]; \
            unsigned vv_[2] = {(g_ & 0xffffu) * (unsigned)(K * 2) + gcol[0], (g_ >> 16) * (unsigned)(K * 2) + gcol[1]}; PG8_STAGE(bufoff, gbase, vv_); } \
        else { PG8_STAGE(bufoff, (gbase) + (half) * hstep, voffA); } } while (0)
    const size_t kstep = (size_t)(BK * 2);
    const size_t hstep = (size_t)HALF * K * 2;
    const unsigned ldsw = (unsigned)wid * 1024u;
    const int aoff = lds_byte(wr * 64 + fr, fq * 8), boff = lds_byte(wc * 32 + fr, fq * 8);
#define PG8_SA(b, h) (((b) * 2 + (h)) * HTB)
#define PG8_SB(b, h) ((4 + (b) * 2 + (h)) * HTB)
#define PG8_STAGE(bufoff, gbase, voff) do { _Pragma("unroll") for (int _i = 0; _i < 2; ++_i) \
        __builtin_amdgcn_global_load_lds((const unsigned*)((const char*)(gbase) + (voff)[_i]), (PG8_LAS unsigned*)(lds + (bufoff) + ldsw + _i * 8192), 16, 0, 0); } while (0)
#define PG8_LDA(dst, b, h) do { _Pragma("unroll") for (int m = 0; m < 4; ++m) _Pragma("unroll") for (int k = 0; k < 2; ++k) dst[m][k] = *(const PG8_LAS bf16x8*)(lds + PG8_SA(b, h) + aoff + m * 2048 + k * 1024); } while (0)
#define PG8_LDB(dst, b, h) do { _Pragma("unroll") for (int n = 0; n < 2; ++n) _Pragma("unroll") for (int k = 0; k < 2; ++k) dst[n][k] = *(const PG8_LAS bf16x8*)(lds + PG8_SB(b, h) + boff + n * 2048 + k * 1024); } while (0)
#define PG8_MMA(ai, bj, At, Bt) do { __builtin_amdgcn_s_setprio(1); _Pragma("unroll") for (int m = 0; m < 4; ++m) _Pragma("unroll") for (int n = 0; n < 2; ++n) _Pragma("unroll") for (int k = 0; k < 2; ++k) \
        acc[ai][bj][m][n] = __builtin_amdgcn_mfma_f32_16x16x32_bf16(Bt[n][k], At[m][k], acc[ai][bj][m][n], 0, 0, 0); __builtin_amdgcn_s_setprio(0); } while (0)
#define PG8_WAIT_V(n) asm volatile("s_waitcnt vmcnt(" #n ")" ::: "memory")
#define PG8_WAIT_L(n) asm volatile("s_waitcnt lgkmcnt(" #n ")" ::: "memory")
#define PG8_BAR __builtin_amdgcn_s_barrier()
#define PG8_SCHED __builtin_amdgcn_sched_barrier(0)
    Unit cur, nxt; int ui = 0;
    if (!S.next(0, cur)) return;
    f32x4 acc[2][2][4][2];
#pragma unroll
    for (int a = 0; a < 2; ++a)
#pragma unroll
        for (int b = 0; b < 2; ++b)
#pragma unroll
            for (int m = 0; m < 4; ++m)
#pragma unroll
                for (int n = 0; n < 2; ++n) acc[a][b][m][n] = (f32x4){0.f, 0.f, 0.f, 0.f};
    bf16x8 At[4][2], B0[2][2], B1[2][2];
    const char* cA = S.a_base(cur); const char* cB = S.b_base(cur);
    S.a_ready(cur);
    if constexpr (GATHER) PG8_GLOAD(gA, cur);
    if constexpr (SP2) {
        PG8_STAGE(PG8_SB(0, 0), cB, voffB); PG8_STAGE(PG8_SB(0, 1), cB + hstep, voffB); PG8_STAGE_A(PG8_SA(0, 0), cA, 0, false); PG8_STAGE_A(PG8_SA(0, 1), cA, 1, false);
        if (wr == 1) PG8_BAR;
        PG8_WAIT_V(2); PG8_BAR;
        PG8_STAGE(PG8_SB(1, 0), cB + kstep, voffB); PG8_STAGE_A(PG8_SA(1, 0), cA + kstep, 0, false); PG8_STAGE(PG8_SB(1, 1), cB + hstep + kstep, voffB);
        PG8_WAIT_V(6); PG8_BAR;
    } else {
        PG8_STAGE(PG8_SB(0, 0), cB, voffB); PG8_STAGE(PG8_SA(0, 0), cA, voffA); PG8_STAGE(PG8_SB(0, 1), cB + hstep, voffB); PG8_STAGE(PG8_SA(0, 1), cA + hstep, voffA);
        if (wr == 1) PG8_BAR;
        PG8_WAIT_V(4); PG8_BAR;
        PG8_STAGE(PG8_SB(1, 0), cB + kstep, voffB); PG8_STAGE(PG8_SA(1, 0), cA + kstep, voffA); PG8_STAGE(PG8_SB(1, 1), cB + hstep + kstep, voffB);
        PG8_WAIT_V(6); PG8_BAR;
    }
    for (;;) {
        const bool has_next = S.next(ui + 1, nxt);
        if constexpr (GATHER) { if (has_next) { PG8_GLOAD(gN, nxt); asm volatile("s_waitcnt vmcnt(0)" ::: "memory");
            asm volatile("" : "+v"(gN[0]), "+v"(gN[1])); } }
        const char* nA = has_next ? S.a_base(nxt) : cA; const char* nB = has_next ? S.b_base(nxt) : cB;
        for (int t = 0; t < nt; t += 2) {
            const bool last = (t == nt - 2); const bool lastnext = last && has_next; (void)lastnext; const bool fullu = (cur.hf == 0);
            const char* a1 = cA + (size_t)(t + 1) * kstep;
            const char* a2 = last ? nA : cA + (size_t)(t + 2) * kstep; const char* b2 = last ? nB : cB + (size_t)(t + 2) * kstep;
            const char* a3 = a2 + kstep; const char* b3 = b2 + kstep;
            if (last && has_next) S.a_ready(nxt);
            if constexpr (SP2) {
            PG8_LDB(B0, 0, 0); PG8_LDB(B1, 0, 1); PG8_SCHED; PG8_LDA(At, 0, 0); PG8_STAGE_A(PG8_SA(1, 1), a1, 1, false);
            PG8_WAIT_V(8); PG8_WAIT_L(0); PG8_BAR; PG8_MMA(0, 0, At, B0); PG8_MMA(0, 1, At, B1); PG8_BAR; PG8_SCHED;
            PG8_LDA(At, 0, 1); PG8_STAGE(PG8_SB(0, 0), b2, voffB); PG8_STAGE(PG8_SB(0, 1), b2 + hstep, voffB); PG8_STAGE_A(PG8_SA(0, 0), a2, 0, lastnext);
            PG8_WAIT_V(8); PG8_WAIT_L(0); PG8_BAR; if (fullu) { PG8_MMA(1, 0, At, B0); PG8_MMA(1, 1, At, B1); } PG8_BAR; PG8_SCHED;
            PG8_LDB(B0, 1, 0); PG8_LDB(B1, 1, 1); PG8_SCHED; PG8_LDA(At, 1, 0); PG8_STAGE_A(PG8_SA(0, 1), a2, 1, lastnext);
            PG8_WAIT_V(8); PG8_WAIT_L(0); PG8_BAR; PG8_MMA(0, 0, At, B0); PG8_MMA(0, 1, At, B1); PG8_BAR; PG8_SCHED;
            PG8_LDA(At, 1, 1); PG8_STAGE(PG8_SB(1, 0), b3, voffB); PG8_STAGE(PG8_SB(1, 1), b3 + hstep, voffB); PG8_STAGE_A(PG8_SA(1, 0), a3, 0, lastnext);
            PG8_WAIT_V(8); PG8_WAIT_L(0); PG8_BAR; if (fullu) { PG8_MMA(1, 0, At, B0); PG8_MMA(1, 1, At, B1); } PG8_BAR; PG8_SCHED;
            } else {
            PG8_LDB(B0, 0, 0); PG8_SCHED; PG8_LDA(At, 0, 0); PG8_STAGE(PG8_SA(1, 1), a1 + hstep, voffA);
            PG8_WAIT_L(8); PG8_BAR; PG8_WAIT_L(0); PG8_MMA(0, 0, At, B0); PG8_BAR; PG8_SCHED;
            PG8_LDB(B1, 0, 1); PG8_STAGE(PG8_SB(0, 0), b2, voffB);
            PG8_BAR; PG8_WAIT_L(0); PG8_MMA(0, 1, At, B1); PG8_BAR;
            PG8_LDA(At, 0, 1); PG8_STAGE(PG8_SA(0, 0), a2, voffA);
            PG8_BAR; PG8_WAIT_L(0); PG8_MMA(1, 0, At, B0); PG8_BAR; PG8_SCHED;
            PG8_STAGE(PG8_SB(0, 1), b2 + hstep, voffB);
            PG8_WAIT_V(6); PG8_BAR; PG8_MMA(1, 1, At, B1); PG8_BAR;
            PG8_LDB(B0, 1, 0); PG8_SCHED; PG8_LDA(At, 1, 0); PG8_STAGE(PG8_SA(0, 1), a2 + hstep, voffA);
            PG8_WAIT_L(8); PG8_BAR; PG8_WAIT_L(0); PG8_MMA(0, 0, At, B0); PG8_BAR; PG8_SCHED;
            PG8_LDB(B1, 1, 1); PG8_STAGE(PG8_SB(1, 0), b3, voffB);
            PG8_BAR; PG8_WAIT_L(0); PG8_MMA(0, 1, At, B1); PG8_BAR;
            PG8_LDA(At, 1, 1); PG8_STAGE(PG8_SA(1, 0), a3, voffA);
            PG8_BAR; PG8_WAIT_L(0); PG8_MMA(1, 0, At, B0); PG8_BAR; PG8_SCHED;
            PG8_STAGE(PG8_SB(1, 1), b3 + hstep, voffB);
            PG8_WAIT_V(6); PG8_BAR; PG8_MMA(1, 1, At, B1); PG8_BAR;
            }
        }
        if constexpr (ALIGN_EPI) { if (wr == 0) PG8_BAR; }
        if constexpr (!Epi::AFTER_DRAIN) { E(acc, cur, wr, wc, fr, fq); S.done(cur); }
        if (!has_next) break;
#pragma unroll
        for (int a = 0; a < 2; ++a)
#pragma unroll
            for (int b = 0; b < 2; ++b)
#pragma unroll
                for (int m = 0; m < 4; ++m)
#pragma unroll
                    for (int n = 0; n < 2; ++n) acc[a][b][m][n] = (f32x4){0.f, 0.f, 0.f, 0.f};
        cur = nxt; cA = nA; cB = nB; ++ui;
        if constexpr (GATHER) { gA[0] = gN[0]; gA[1] = gN[1]; }
        if constexpr (ALIGN_EPI) { if (wr == 1) PG8_BAR; }
    }
    PG8_WAIT_V(0);
    if constexpr (!ALIGN_EPI) { if (wr == 0) PG8_BAR; }
    PG8_BAR;
    if constexpr (Epi::AFTER_DRAIN) { E.fused(acc, cur, wr, wc, fr, fq, lds, wid, lane); S.done(cur); }
#undef PG8_SA
#undef PG8_GLOAD
#undef PG8_STAGE_A
#undef PG8_SB
#undef PG8_STAGE
#undef PG8_LDA
#undef PG8_LDB
#undef PG8_MMA
#undef PG8_WAIT_V
#undef PG8_WAIT_L
#undef PG8_BAR
#undef PG8_SCHED
}
}

typedef unsigned short bf16_t;
typedef unsigned u32x4 __attribute__((ext_vector_type(4)));
typedef float f32x4 __attribute__((ext_vector_type(4)));
#define LAS __attribute__((address_space(3)))

constexpr int BATCH = 4, SEQ = 8192, T = BATCH * SEQ, D = 1024, NIN = 2304, DEPTH = 2;
constexpr int NH = 8;
constexpr int NBUCKET = 24, MAXTILES = 152, MAXROWS = MAXTILES * 256;
constexpr float EPS = 1e-6f;
constexpr float LOG2E = 1.4426950408889634f;
constexpr int NWAVES = 8, NTHREADS = 512;
constexpr int LDS_BYTES = 155648;
constexpr int LDS_BARW = LDS_BYTES - 64;

constexpr size_t MiB = 1u << 20;
constexpr size_t WS_CTL = 0;
constexpr size_t WS_WIN = 1 * MiB;
constexpr size_t WS_WOUT = 10 * MiB;
constexpr size_t WS_WGU = 14 * MiB;
constexpr size_t WS_WDN = 46 * MiB;
constexpr size_t WS_GLU = 94 * MiB;
constexpr size_t WS_S5 = 95 * MiB;
constexpr size_t S5_M1 = 0, S5_M2P = 1 * MiB, S5_TT = 2 * MiB, S5_AP16 = 2 * MiB + 256 * 1024, S5_AP256 = 2 * MiB + 512 * 1024, S5_LAYER = 4 * MiB;
constexpr size_t WS_S5F = WS_S5 + 8 * MiB;
constexpr size_t WS_SGUW = 94 * MiB + 512 * 1024;
constexpr size_t WS_ROUTEW = 105 * MiB;
constexpr size_t WS_XB = 106 * MiB;
constexpr size_t WS_META = 170 * MiB;
constexpr size_t WS_PROJ = 172 * MiB;
constexpr size_t WS_U = WS_PROJ, WS_V = WS_PROJ + 16 * MiB, WS_ZS = WS_PROJ + 32 * MiB;
constexpr size_t WS_QH = WS_PROJ + 48 * MiB, WS_KH = WS_PROJ + 80 * MiB, WS_VH = WS_PROJ + 112 * MiB;
constexpr size_t WS_XS = WS_PROJ;
constexpr size_t WS_H = WS_PROJ + 76 * MiB;
constexpr size_t WS_O = 316 * MiB;
constexpr size_t WS_YG = 380 * MiB;
constexpr size_t WS_SSQP = 380 * MiB;
constexpr size_t WS_SSQB = 382 * MiB;
constexpr size_t WS_BLIST = 384 * MiB;
constexpr size_t WS_BGW0 = 388 * MiB, WS_BGW1 = 392 * MiB, WS_BRS = 396 * MiB;
constexpr size_t WS_END = 412 * MiB;
constexpr size_t MT_RSTD = 0;
constexpr size_t MT_VR = 128 * 1024;
constexpr size_t MT_BUCKET = 256 * 1024;
constexpr size_t MT_POS = 384 * 1024;
constexpr size_t MT_GW0 = 512 * 1024;
constexpr size_t MT_GW1 = 640 * 1024;
constexpr size_t MT_RS2 = 768 * 1024;
constexpr size_t MT_STOK = 896 * 1024;
constexpr size_t MT_SGW0 = 1216 * 1024;
constexpr size_t MT_SGW1 = 1408 * 1024;
constexpr size_t MT_SRS = 1600 * 1024;
constexpr int CW_S5A = 48;
constexpr int CW_CNT = 64;
constexpr int CW_BAR = 4096;
constexpr int CW_TILEB = 256;

__device__ __forceinline__ float bf2f(bf16_t v) { return __uint_as_float(((unsigned)v) << 16); }
__device__ __forceinline__ bf16_t f2bf(float f) { unsigned u = __float_as_uint(f); return (bf16_t)((u + 0x7fffu + ((u >> 16) & 1u)) >> 16); }
__device__ __forceinline__ unsigned pk2(float lo, float hi) { return pg8::cvt_pk_bf16(lo, hi); }
__device__ __forceinline__ float fast_sigmoid_mul(float x, float z) { return x * __builtin_amdgcn_rcpf(1.f + __expf(-z)); }
__device__ __forceinline__ float gelu_tanh(float x) { const float u = 0.7978845608028654f * (x + 0.044715f * x * x * x); return fast_sigmoid_mul(x, 2.f * u); }
__device__ __forceinline__ float wave_sum(float v) {
#pragma unroll
    for (int o = 1; o < 64; o <<= 1) v += __shfl_xor(v, o);
    return v;
}
__device__ __forceinline__ float wave_max(float v) {
#pragma unroll
    for (int o = 1; o < 64; o <<= 1) v = fmaxf(v, __shfl_xor(v, o));
    return v;
}
#define GAS __attribute__((address_space(1)))
template <class Tp> __device__ __forceinline__ Tp* opaque(Tp* q) { GAS Tp* g = (GAS Tp*)q; asm volatile("" : "+v"(g)); return (Tp*)g; }
__device__ __forceinline__ const float* gptr(const float* q) { const GAS float* g = (const GAS float*)q; asm("" : "+s"(g)); return (const float*)g; }
__device__ __forceinline__ int pair_lo(int pi) { return pi < 3 ? 0 : (pi < 5 ? 1 : 2); }
__device__ __forceinline__ int pair_hi(int pi) { return pi < 3 ? pi + 1 : (pi < 5 ? pi - 1 : 3); }

#ifndef REP_ID
#define REP_ID -1
#endif
#ifndef REP_N
#define REP_N 4
#endif
#ifndef REP_PH
#define REP_PH -1
#endif
#define REPEAT(id, body) do { const int nrep_ = (REP_ID == (id) && l == 0) ? REP_N : 1; for (int rep_ = 0; rep_ < nrep_; ++rep_) { body; } } while (0)

struct KArgs { const float* in[29]; float* out; unsigned char* ws; int ph_lo, ph_hi; };

struct Ctx {
    LAS unsigned char* lds;
    const float* const* in; float* out; unsigned char* ws;
    int tid, lane, wave, gw, ngw, G;
    bool dry;
};

__host__ __device__ __forceinline__ int inproj_row_of_col(int n) {
    if (n < 768) return n;
    const int pn = n >> 8, r = n & 255, wc = r >> 6, bj = (r >> 5) & 1, i = r & 31;
    return pn * 256 + bj * 128 + wc * 32 + i;
}
struct TDesc { const float* W; const float* scale; bf16_t* WT; int N, ldk, koff, k0, n0, rowmode; };
struct TRegs { f32x4 v[16]; float s[16]; };
__device__ __forceinline__ void tr_load(const TDesc& d, TRegs& r, int lane) {
    const int kr = lane >> 4, c4 = (lane & 15) * 4;
#pragma unroll
    for (int i = 0; i < 16; ++i) { r.v[i] = *(const f32x4*)(d.W + (size_t)(d.k0 + 4 * i + kr) * d.N + d.n0 + c4); r.s[i] = d.scale ? d.scale[d.k0 + 4 * i + kr] : 1.f; }
}
__device__ __forceinline__ void tr_finish(const TDesc& d, const TRegs& r, LAS float* scr, int lane) {
    const int kr = lane >> 4, c4 = (lane & 15) * 4;
#pragma unroll
    for (int i = 0; i < 16; ++i) { const int kk = 4 * i + kr; const float s = r.s[i];
        LAS float* q = scr + kk * 65 + c4; q[0] = r.v[i].x * s; q[1] = r.v[i].y * s; q[2] = r.v[i].z * s; q[3] = r.v[i].w * s; }
    asm volatile("s_waitcnt lgkmcnt(0)" ::: "memory");
    const int c = lane & 7;
#pragma unroll
    for (int j = 0; j < 8; ++j) {
        const int nl = (lane >> 3) + 8 * j; const LAS float* s = scr + (8 * c) * 65 + nl;
        u32x4 o; o.x = pk2(s[0 * 65], s[1 * 65]); o.y = pk2(s[2 * 65], s[3 * 65]); o.z = pk2(s[4 * 65], s[5 * 65]); o.w = pk2(s[6 * 65], s[7 * 65]);
        const int n = d.n0 + nl; int row;
        if (d.rowmode == 0) row = n;
        else if (d.rowmode == 1) row = inproj_row_of_col(n);
        else if (d.rowmode == 2) row = 256 * (n >> 7) + (n & 127);
        else row = 256 * (n >> 7) + 128 + (n & 127);
        if (d.rowmode == 4) { const int k8 = (d.k0 >> 3) + c;
            *(u32x4*)(d.WT + ((size_t)(((n >> 5) * 16 + (k8 >> 1)) * 64 + (k8 & 1) * 32 + (n & 31))) * 8) = o; }
        else *(u32x4*)(d.WT + (size_t)row * d.ldk + d.koff + d.k0 + 8 * c) = o;
    }
    asm volatile("s_waitcnt lgkmcnt(0)" ::: "memory");
}
constexpr int IT_WIN = 16 * 36, IT_WOUT = 16 * 16, IT_WGU1 = 16 * 4, IT_WDN1 = 4 * 16, IT_GLU = 4 * 4;
constexpr int IT_L = IT_WIN + IT_WOUT + 16 * 2 * IT_WGU1 + NBUCKET * 2 * IT_WDN1 + IT_GLU;
constexpr int IT_TOTAL = DEPTH * IT_L;
__device__ __forceinline__ TDesc prep_desc(const Ctx& C, int it) {
    const int l = it / IT_L; int r = it % IT_L;
    unsigned char* ws = C.ws; TDesc d;
    if (r < IT_WIN) { const int kb = r / 36, nb = r % 36;
        d = TDesc{gptr(C.in[2]) + (size_t)l * D * NIN, gptr(C.in[1]) + l * D, (bf16_t*)(ws + WS_WIN) + (size_t)l * NIN * D, NIN, D, 0, kb * 64, nb * 64, 1}; return d; }
    r -= IT_WIN;
    if (r < IT_WOUT) { const int kb = r / 16, nb = r % 16;
        d = TDesc{gptr(C.in[20]) + (size_t)l * D * D, gptr(C.in[19]) + l * D, (bf16_t*)(ws + WS_WOUT) + (size_t)l * D * D, D, D, 0, kb * 64, nb * 64, 0}; return d; }
    r -= IT_WOUT;
    if (r < 16 * 2 * IT_WGU1) { const int e = r / (2 * IT_WGU1), q = r % (2 * IT_WGU1), isup = q / IT_WGU1, t = q % IT_WGU1, kb = t / 4, nb = t % 4;
        const float* W = (isup ? gptr(C.in[27]) : gptr(C.in[26])) + ((size_t)l * 16 + e) * D * 256;
        d = TDesc{W, gptr(C.in[21]) + l * D, (bf16_t*)(ws + WS_WGU) + ((size_t)l * 16 + e) * 512 * D, 256, D, 0, kb * 64, nb * 64, isup ? 3 : 2}; return d; }
    r -= 16 * 2 * IT_WGU1;
    if (r < NBUCKET * 2 * IT_WDN1) { const int bk = r / (2 * IT_WDN1), q = r % (2 * IT_WDN1), slot = q / IT_WDN1, t = q % IT_WDN1, kb = t / 16, nb = t % 16;
        const int g = bk / 6, pi = bk % 6, e = 4 * g + (slot ? pair_hi(pi) : pair_lo(pi));
        d = TDesc{gptr(C.in[28]) + ((size_t)l * 16 + e) * 256 * D, nullptr, (bf16_t*)(ws + WS_WDN) + ((size_t)l * NBUCKET + bk) * D * 512, D, 512, slot * 256, kb * 64, nb * 64, 0}; return d; }
    r -= NBUCKET * 2 * IT_WDN1;
    { const int kb = r / 4, nb = r % 4;
        d = TDesc{gptr(C.in[14]) + (size_t)l * 256 * 256, nullptr, (bf16_t*)(ws + WS_GLU) + (size_t)l * 256 * 256, 256, 256, 0, kb * 64, nb * 64, 4}; return d; }
}
__device__ __forceinline__ void phase_prep_weights(const Ctx& C, LAS float* scr) {
    TDesc d0, d1; TRegs r0, r1;
    int it = C.gw; bool h0 = it < IT_TOTAL;
    if (h0) { d0 = prep_desc(C, it); tr_load(d0, r0, C.lane); }
    while (h0) {
        const int it1 = it + C.ngw; const bool h1 = it1 < IT_TOTAL;
        if (h1) { d1 = prep_desc(C, it1); tr_load(d1, r1, C.lane); }
        tr_finish(d0, r0, scr, C.lane);
        if (!h1) break;
        const int it2 = it1 + C.ngw; h0 = it2 < IT_TOTAL;
        if (h0) { d0 = prep_desc(C, it2); tr_load(d0, r0, C.lane); }
        tr_finish(d1, r1, scr, C.lane);
        it = it2;
    }
}
__device__ __forceinline__ void conv_row(const float* xrow, bf16_t* orow, float* rstd_out, int lane) {
    const f32x4* xr = (const f32x4*)xrow + lane;
    f32x4 v[4]; float s = 0.f;
#pragma unroll
    for (int j = 0; j < 4; ++j) { v[j] = xr[64 * j]; s += (v[j].x * v[j].x + v[j].y * v[j].y) + (v[j].z * v[j].z + v[j].w * v[j].w); }
    s = wave_sum(s);
    if (lane == 0) *rstd_out = 1.0f / sqrtf(s * (1.f / D) + EPS);
    unsigned long long* o8 = (unsigned long long*)orow + lane;
#pragma unroll
    for (int j = 0; j < 4; ++j) o8[64 * j] = (unsigned long long)pk2(v[j].x, v[j].y) | ((unsigned long long)pk2(v[j].z, v[j].w) << 32);
}
__device__ __forceinline__ void phase_conv(const Ctx& C, const float* x) {
    bf16_t* XB = (bf16_t*)(C.ws + WS_XB); float* RSTD = (float*)(C.ws + WS_META + MT_RSTD);
    for (int m = C.gw * 4; m < T; m += C.ngw * 4) {
        f32x4 v[4][4]; float s[4];
#pragma unroll
        for (int r = 0; r < 4; ++r) { const f32x4* xr = (const f32x4*)(x + (size_t)(m + r) * D) + C.lane;
#pragma unroll
            for (int j = 0; j < 4; ++j) v[r][j] = xr[64 * j]; }
#pragma unroll
        for (int r = 0; r < 4; ++r) { float a = 0.f;
#pragma unroll
            for (int j = 0; j < 4; ++j) a += (v[r][j].x * v[r][j].x + v[r][j].y * v[r][j].y) + (v[r][j].z * v[r][j].z + v[r][j].w * v[r][j].w);
            s[r] = wave_sum(a);
            unsigned long long* o8 = (unsigned long long*)(XB + (size_t)(m + r) * D) + C.lane;
#pragma unroll
            for (int j = 0; j < 4; ++j) o8[64 * j] = (unsigned long long)pk2(v[r][j].x, v[r][j].y) | ((unsigned long long)pk2(v[r][j].z, v[r][j].w) << 32); }
        if (C.lane < 4) RSTD[m + C.lane] = 1.0f / sqrtf((C.lane == 0 ? s[0] : C.lane == 1 ? s[1] : C.lane == 2 ? s[2] : s[3]) * (1.f / D) + EPS);
    }
}
struct DenseSched {
    const char* A; const char* Bt; int nM, nN, nwg, G, c; size_t tstep;
    __device__ __forceinline__ void init(const void* A_, const void* Bt_, int M, int N, int K, int G_, int c_) { A = (const char*)A_; Bt = (const char*)Bt_; nM = M / 256; nN = N / 256; nwg = nM * nN; G = G_; c = c_; tstep = (size_t)256 * K * 2; }
    __device__ __forceinline__ bool next(int i, pg8::Unit& u) const {
        const int R = nwg / G, r = nwg - R * G; long L; u.hf = 0;
        if (i < R) L = (long)i * G + c;
        else if (i == R && r > 0) { if (2 * r <= G) { if (c >= 2 * r) return false; L = (long)R * G + (c % r); u.hf = 1 + c / r; } else { if (c >= r) return false; L = (long)R * G + c; } }
        else return false;
        int wgid = (int)L; { const int q = nwg / 8, rr = nwg % 8, xcd = wgid % 8, off = wgid / 8; wgid = (xcd < rr ? xcd * (q + 1) : rr * (q + 1) + (xcd - rr) * q) + off; }
        const int nig = 8 * nN, gid = wgid / nig, fm = gid * 8, gsz = (nM - fm) < 8 ? (nM - fm) : 8;
        u.pm = fm + ((wgid % nig) % gsz); u.pn = (wgid % nig) / gsz; return true;
    }
    __device__ __forceinline__ const char* a_base(const pg8::Unit& u) const { return A + (size_t)u.pm * tstep + (u.hf == 2 ? tstep / 2 : 0); }
    __device__ __forceinline__ const char* b_base(const pg8::Unit& u) const { return Bt + (size_t)u.pn * tstep; }
    __device__ __forceinline__ int a_row(const pg8::Unit&, int) const { return 0; }
    __device__ __forceinline__ void a_ready(const pg8::Unit&) const {}
    __device__ __forceinline__ void done(const pg8::Unit&) const {}
};
constexpr int TB_OFF = 131072;
struct TileTab { const LAS int* t;
    __device__ __forceinline__ int bucket(int pm) const { return t[pm]; }
    __device__ __forceinline__ int row0(int pm, int bk) const { return (pm - t[160 + bk]) * 256; }
    __device__ __forceinline__ int count(int bk) const { return t[192 + bk]; }
    __device__ __forceinline__ int ntiles() const { return t[224]; } };
__device__ __forceinline__ void build_tile_table(const Ctx& C, int l) {
    LAS int* t = (LAS int*)(C.lds + TB_OFF); const unsigned* cnt = (const unsigned*)(C.ws + WS_CTL) + CW_CNT + l * 32;
    if (C.tid < 64) { const int lane = C.tid; const int c = (lane < NBUCKET) ? (int)cnt[lane] : 0; const int nt = (c + 255) >> 8; int incl = nt;
#pragma unroll
        for (int o = 1; o < 32; o <<= 1) { const int v = __shfl_up(incl, o); if (lane >= o) incl += v; }
        const int excl = incl - nt;
        if (lane < 32) { t[160 + lane] = excl; t[192 + lane] = c; }
        if (lane < NBUCKET) for (int i = 0; i < nt; ++i) t[excl + i] = lane;
        if (lane == NBUCKET - 1) t[224] = incl; }
    __syncthreads();
}
struct GroupSched {
    const char* A; const char* B; TileTab tt; const int* blist; int ntiles, G, c, mode; size_t a_tile_bytes;
    __device__ __forceinline__ bool next(int i, pg8::Unit& u) const {
        const int NU = ntiles * 4, R = NU / G, r = NU - R * G; int L; u.hf = 0;
        const int cv = ((G & 7) == 0) ? (c & 7) * (G >> 3) + (c >> 3) : c;
        if (i < R) L = i * G + cv;
        else if (i == R && r > 0) { if (2 * r <= G) { if (cv >= 2 * r) return false; L = R * G + (cv % r); u.hf = 1 + cv / r; } else { if (cv >= r) return false; L = R * G + cv; } }
        else return false;
        u.pm = L >> 2; u.pn = L & 3; return true; }
    __device__ __forceinline__ const char* a_base(const pg8::Unit& u) const { return mode == 1 ? A : A + (size_t)u.pm * a_tile_bytes + (u.hf == 2 ? a_tile_bytes / 2 : 0); }
    __device__ __forceinline__ int a_row(const pg8::Unit& u, int row) const {
        const int bk = tt.bucket(u.pm), r = tt.row0(u.pm, bk) + row + (u.hf == 2 ? 128 : 0); return blist[bk * T + (r < tt.count(bk) ? r : 0)]; }
    __device__ __forceinline__ const char* b_base(const pg8::Unit& u) const {
        const int bk = tt.bucket(u.pm);
        if (mode == 1) { const int g = bk / 6, pi = bk % 6, e = 4 * g + ((u.pn >> 1) ? pair_hi(pi) : pair_lo(pi)); return B + ((size_t)e * 512 + (u.pn & 1) * 256) * (size_t)(D * 2); }
        return B + ((size_t)bk * D + u.pn * 256) * (size_t)(512 * 2);
    }
    __device__ __forceinline__ void a_ready(const pg8::Unit&) const {}
    __device__ __forceinline__ void done(const pg8::Unit&) const {}
};

__device__ __forceinline__ float row_rstd(const float* ssqp, int row) {
    const f32x4* q = (const f32x4*)(ssqp + (size_t)row * 16); const f32x4 a = q[0], b = q[1], c = q[2], d = q[3];
    const float s = (((a.x + a.y) + (a.z + a.w)) + ((b.x + b.y) + (b.z + b.w))) + (((c.x + c.y) + (c.z + c.w)) + ((d.x + d.y) + (d.z + d.w)));
    return 1.0f / sqrtf(s * (1.f / D) + EPS);
}
struct EpiIn {
    static constexpr bool PERM = true, AFTER_DRAIN = false;
    const float* rstd; bf16_t *U, *QH; const float *qg, *kg;
    __device__ __forceinline__ void operator()(const f32x4 (&acc)[2][2][4][2], const pg8::Unit& u, int wr, int wc, int fr, int fq) const {
        const int pn = u.pn; const int row0 = u.pm * 256 + (u.hf == 2 ? 128 : 0) + wr * 64 + fr; const bool halfu = u.hf != 0;
        if (pn < 3) {
            bf16_t* base = U + (size_t)pn * (8u << 20) + wc * 32 + 8 * fq;
#pragma unroll
            for (int ai = 0; ai < 2; ++ai)
#pragma unroll
                for (int m = 0; m < 4; ++m) { if (ai == 1 && halfu) continue; const int row = row0 + ai * 128 + m * 16; const float rs = rstd[row];
#pragma unroll
                    for (int bj = 0; bj < 2; ++bj) { f32x4 v0 = acc[ai][bj][m][0] * rs, v1 = acc[ai][bj][m][1] * rs;
                        if (pn < 2) { v0.x = gelu_tanh(v0.x); v0.y = gelu_tanh(v0.y); v0.z = gelu_tanh(v0.z); v0.w = gelu_tanh(v0.w); v1.x = gelu_tanh(v1.x); v1.y = gelu_tanh(v1.y); v1.z = gelu_tanh(v1.z); v1.w = gelu_tanh(v1.w); }
                        u32x4 w; w.x = pk2(v0.x, v0.y); w.y = pk2(v0.z, v0.w); w.z = pk2(v1.x, v1.y); w.w = pk2(v1.z, v1.w);
                        *(u32x4*)(base + (size_t)row * 256 + bj * 128) = w; } }
        } else {
            const int typ = (pn - 3) >> 1, head = 4 * ((pn - 3) & 1) + wc;
            bf16_t* dstb = QH + (size_t)typ * (16u << 20) + 8 * fq;
            f32x4 gv[2][2];
            const float* gsrc = qg + (kg - qg) * (typ == 1 ? 1 : 0) + 8 * fq; const float sc = (typ == 0) ? 0.125f * LOG2E : 1.f;
#pragma unroll
            for (int bj = 0; bj < 2; ++bj)
#pragma unroll
                for (int n = 0; n < 2; ++n) gv[bj][n] = (typ < 2) ? *(const f32x4*)(gsrc + 32 * bj + 4 * n) * sc : (f32x4){1.f, 1.f, 1.f, 1.f};
#pragma unroll
            for (int ai = 0; ai < 2; ++ai)
#pragma unroll
                for (int m = 0; m < 4; ++m) { if (ai == 1 && halfu) continue; const int row = row0 + ai * 128 + m * 16; const float rs = rstd[row];
                    f32x4 v[2][2]; float ss = 0.f;
#pragma unroll
                    for (int bj = 0; bj < 2; ++bj)
#pragma unroll
                        for (int n = 0; n < 2; ++n) { v[bj][n] = acc[ai][bj][m][n] * rs; ss += (v[bj][n].x * v[bj][n].x + v[bj][n].y * v[bj][n].y) + (v[bj][n].z * v[bj][n].z + v[bj][n].w * v[bj][n].w); }
                    ss += __shfl_xor(ss, 16); ss += __shfl_xor(ss, 32);
                    const float r = (typ < 2) ? 1.0f / sqrtf(ss * (1.f / 64.f) + EPS) : 1.f;
                    const int b = row >> 13, s = row & (SEQ - 1);
                    bf16_t* dst = dstb + ((size_t)(b * NH + head) * SEQ + s) * 64;
#pragma unroll
                    for (int bj = 0; bj < 2; ++bj) { const f32x4 v0 = v[bj][0] * r * gv[bj][0], v1 = v[bj][1] * r * gv[bj][1];
                        u32x4 w; w.x = pk2(v0.x, v0.y); w.y = pk2(v0.z, v0.w); w.z = pk2(v1.x, v1.y); w.w = pk2(v1.z, v1.w);
                        *(u32x4*)(dst + 32 * bj) = w; } }
        }
    }
};
__device__ __forceinline__ f32x4 bf_lo4(unsigned a, unsigned b) { return (f32x4){__uint_as_float(a << 16), __uint_as_float(a & 0xffff0000u), __uint_as_float(b << 16), __uint_as_float(b & 0xffff0000u)}; }
struct EpiOut {
    static constexpr bool PERM = true, AFTER_DRAIN = false;
    bf16_t* xb; float* ssq; size_t wofs;
    __device__ __forceinline__ void operator()(const f32x4 (&acc)[2][2][4][2], const pg8::Unit& u, int wr, int wc, int fr, int fq) const {
        const int row0 = u.pm * 256 + wr * 64 + fr, col0 = u.pn * 256 + wc * 32 + 8 * fq;
#pragma unroll
        for (int ai = 0; ai < 2; ++ai)
#pragma unroll
            for (int m = 0; m < 4; ++m) { const int row = row0 + ai * 128 + m * 16; bf16_t* xp = xb + (size_t)row * D + col0; float ss = 0.f;
#pragma unroll
                for (int bj = 0; bj < 2; ++bj) { const u32x4 w = *(const u32x4*)(xp + bj * 128);
                    const f32x4 v0 = bf_lo4(w.x, w.y) + acc[ai][bj][m][0], v1 = bf_lo4(w.z, w.w) + acc[ai][bj][m][1];
                    u32x4 o; o.x = pk2(v0.x, v0.y); o.y = pk2(v0.z, v0.w); o.z = pk2(v1.x, v1.y); o.w = pk2(v1.z, v1.w); *(u32x4*)(xp + wofs + bj * 128) = o;
                    const f32x4 r0 = bf_lo4(o.x, o.y), r1 = bf_lo4(o.z, o.w);
                    ss += (r0.x * r0.x + r0.y * r0.y) + (r0.z * r0.z + r0.w * r0.w) + (r1.x * r1.x + r1.y * r1.y) + (r1.z * r1.z + r1.w * r1.w); }
                ss += __shfl_xor(ss, 16); ss += __shfl_xor(ss, 32); if (fq == 0) ssq[(size_t)row * 16 + u.pn * 4 + wc] = ss; }
    }
};
struct EpiG1 {
    static constexpr bool PERM = true, AFTER_DRAIN = false;
    TileTab tt; const float *bgw0, *bgw1, *brs; bf16_t* H;
    __device__ __forceinline__ void operator()(const f32x4 (&acc)[2][2][4][2], const pg8::Unit& u, int wr, int wc, int fr, int fq) const {
        const int rl0 = (u.hf == 2 ? 128 : 0) + wr * 64 + fr; const int slot = u.pn >> 1, hh = u.pn & 1; const bool halfu = u.hf != 0;
        const int bk = tt.bucket(u.pm); const size_t lbase = (size_t)bk * T + tt.row0(u.pm, bk);
        const float* bgw = slot ? bgw1 : bgw0;
        bf16_t* hb = H + (size_t)u.pm * 256 * 512 + slot * 256 + hh * 128 + wc * 32 + 8 * fq;
#pragma unroll
        for (int ai = 0; ai < 2; ++ai)
#pragma unroll
            for (int m = 0; m < 4; ++m) { if (ai == 1 && halfu) continue; const int rl = rl0 + ai * 128 + m * 16; const float rs = brs[lbase + rl], gw = bgw[lbase + rl];
                float h[8];
#pragma unroll
                for (int n = 0; n < 2; ++n) { const f32x4 g = acc[ai][0][m][n] * rs, up = acc[ai][1][m][n] * (rs * gw);
                    h[4 * n] = fast_sigmoid_mul(g.x, g.x) * up.x; h[4 * n + 1] = fast_sigmoid_mul(g.y, g.y) * up.y; h[4 * n + 2] = fast_sigmoid_mul(g.z, g.z) * up.z; h[4 * n + 3] = fast_sigmoid_mul(g.w, g.w) * up.w; }
                u32x4 w; w.x = pk2(h[0], h[1]); w.y = pk2(h[2], h[3]); w.z = pk2(h[4], h[5]); w.w = pk2(h[6], h[7]);
                *(u32x4*)(hb + (size_t)rl * 512) = w; }
    }
};
template <bool NEXT> struct EpiG2 {
    static constexpr bool PERM = true, AFTER_DRAIN = false;
    TileTab tt; const int* blist; float* out; bf16_t* xb; float* ssq; size_t wofs;
    __device__ __forceinline__ void operator()(const f32x4 (&acc)[2][2][4][2], const pg8::Unit& u, int wr, int wc, int fr, int fq) const {
        const int rl0 = (u.hf == 2 ? 128 : 0) + wr * 64 + fr, col0 = u.pn * 256 + wc * 32 + 8 * fq; const bool halfu = u.hf != 0;
        const int bk = tt.bucket(u.pm), r0 = tt.row0(u.pm, bk), bc = tt.count(bk); const int* bl = blist + (size_t)bk * T;
#pragma unroll
        for (int ai = 0; ai < 2; ++ai)
#pragma unroll
            for (int m = 0; m < 4; ++m) { if (ai == 1 && halfu) continue; const int r = r0 + rl0 + ai * 128 + m * 16; const int tok = (r < bc) ? bl[r] : -1;
                float ss = 0.f;
                if (tok >= 0) { bf16_t* xp = xb + (size_t)tok * D + col0;
#pragma unroll
                    for (int bj = 0; bj < 2; ++bj) { const u32x4 w = *(const u32x4*)(xp + bj * 128);
                        const f32x4 v0 = bf_lo4(w.x, w.y) + acc[ai][bj][m][0], v1 = bf_lo4(w.z, w.w) + acc[ai][bj][m][1];
                        if (NEXT) { u32x4 o; o.x = pk2(v0.x, v0.y); o.y = pk2(v0.z, v0.w); o.z = pk2(v1.x, v1.y); o.w = pk2(v1.z, v1.w); *(u32x4*)(xp + wofs + bj * 128) = o;
                            const f32x4 r0 = bf_lo4(o.x, o.y), r1 = bf_lo4(o.z, o.w);
                            ss += (r0.x * r0.x + r0.y * r0.y) + (r0.z * r0.z + r0.w * r0.w) + (r1.x * r1.x + r1.y * r1.y) + (r1.z * r1.z + r1.w * r1.w); }
                        else { f32x4* op = (f32x4*)(out + (size_t)tok * D + col0 + bj * 128); __builtin_nontemporal_store(v0, op); __builtin_nontemporal_store(v1, op + 1); } } }
                if (NEXT) { ss += __shfl_xor(ss, 16); ss += __shfl_xor(ss, 32); if (fq == 0 && tok >= 0) ssq[(size_t)tok * 16 + u.pn * 4 + wc] = ss; } }
    }
};

__device__ __forceinline__ void phase_vrstd(const Ctx& C) {
    const bf16_t* V = (const bf16_t*)(C.ws + WS_V); float* vr = (float*)(C.ws + WS_META + MT_VR);
    for (int m = C.gw; m < T; m += C.ngw) {
        const unsigned long long w = ((const unsigned long long*)(V + (size_t)m * 256))[C.lane];
        const float a = __uint_as_float((unsigned)(w << 16)), b = __uint_as_float((unsigned)w & 0xffff0000u), c = __uint_as_float((unsigned)(w >> 32) << 16), d = __uint_as_float((unsigned)(w >> 32) & 0xffff0000u);
        const float s = wave_sum(a * a + b * b + c * c + d * d);
        if (C.lane == 0) vr[m] = 1.0f / sqrtf(s * (1.f / 256.f) + EPS);
    }
}
__device__ __forceinline__ void phase_sgu_naive(const Ctx& C, int l) {
    const bf16_t* U = (const bf16_t*)(C.ws + WS_U); const bf16_t* V = (const bf16_t*)(C.ws + WS_V); const float* vr = (const float*)(C.ws + WS_META + MT_VR);
    const float* sgu_norm = gptr(C.in[3]) + l * 256; const float* sgu_w = gptr(C.in[4]) + (size_t)l * 4 * 128 * 128; const float* sgu_b = gptr(C.in[5]) + l * 512;
    bf16_t* O = (bf16_t*)(C.ws + WS_O);
    const int half = C.tid >> 8, ch = C.tid & 255, h = ch >> 6;
    const float gn = sgu_norm[ch];
    for (int t = blockIdx.x * 2 + half; t < T; t += C.G * 2) {
        const int s = t & (SEQ - 1), i = s & 127, t0 = t - i;
        const int jmax = (i < 64) ? 64 : 128;
        const float* w = sgu_w + ((size_t)h * 128 + i) * 128;
        float acc = 0.f;
        for (int j = 0; j < jmax; ++j) acc += w[j] * (bf2f(V[(size_t)(t0 + j) * 256 + ch]) * vr[t0 + j] * gn);
        acc += sgu_b[h * 128 + i];
        const float oa = bf2f(U[(size_t)t * 256 + ch]) * acc;
        const float ss = wave_sum(oa * oa);
        O[(size_t)t * D + ch] = f2bf(oa * (1.0f / sqrtf(ss * (1.f / 64.f) + EPS)));
    }
}

typedef short bf16x8 __attribute__((ext_vector_type(8)));
typedef short s16x4 __attribute__((ext_vector_type(4)));
typedef float f32x16 __attribute__((ext_vector_type(16)));
constexpr int ATT_BX = 640;
constexpr int ATT_VBUF = 16384;
constexpr int ATT_BX_OFF = NWAVES * ATT_VBUF;
__device__ __forceinline__ void glds16(const void* gsrc, unsigned lds_dst) { unsigned keep;
    asm volatile("s_mov_b32 %0, m0\n\ts_mov_b32 m0, %2\n\ts_nop 0\n\tglobal_load_lds_dwordx4 %1, off\n\ts_mov_b32 m0, %0" : "=&s"(keep) : "v"(gsrc), "s"(lds_dst) : "memory"); }
__device__ __forceinline__ unsigned pk2c(float lo, float hi) { typedef __bf16 bf2_t __attribute__((ext_vector_type(2))); typedef float f2_t __attribute__((ext_vector_type(2)));
    const f2_t v = {lo, hi}; return __builtin_bit_cast(unsigned, __builtin_convertvector(v, bf2_t)); }
__device__ __forceinline__ float max3f(float a, float b, float c) { float r; asm("v_max3_f32 %0, %1, %2, %3" : "=v"(r) : "v"(a), "v"(b), "v"(c)); return r; }
__device__ __forceinline__ s16x4 ds_tr(const LAS unsigned char* p) { return __builtin_bit_cast(s16x4, __builtin_amdgcn_ds_read_tr16_b64_v4i16((LAS s16x4*)p)); }
constexpr int ATT_MH_OFF = ATT_BX_OFF + NH * ATT_BX * 4;
__device__ __forceinline__ void attn_load_bias(const Ctx& C, int l) {
    LAS float* Bx = (LAS float*)(C.lds + ATT_BX_OFF); LAS float* MH = (LAS float*)(C.lds + ATT_MH_OFF);
    const float* rb = gptr(C.in[18]) + (size_t)l * NH * 513;
    { const int h = C.wave;
      const float g = wave_max(fabsf(gptr(C.in[16])[l * 64 + C.lane] * gptr(C.in[17])[l * 64 + C.lane]));
      float bmx = -INFINITY, bmn = INFINITY;
      for (int i = C.lane; i < 513; i += 64) { const float v = rb[h * 513 + i]; bmx = fmaxf(bmx, v); bmn = fminf(bmn, v); }
      bmx = wave_max(bmx); bmn = -wave_max(-bmn);
      const float qk = 8.f * 1.02f * g; const bool ok = (2.f * qk + (bmx - bmn)) * LOG2E < 100.f;
      if (C.lane == 0) { MH[h] = ok ? qk + bmx : 0.f; MH[NH + h] = ok ? 1.f : 0.f; } }
    __syncthreads();
    for (int i = C.tid; i < NH * ATT_BX; i += NTHREADS) { const int h = i / ATT_BX, j = i % ATT_BX; int rel = j - 64; rel = rel > 256 ? 256 : rel;
        Bx[h * ATT_BX + (ATT_BX - 1 - j)] = (rb[h * 513 + rel + 256] - MH[h]) * LOG2E; }
}
constexpr int ATT_KOFF = 0, ATT_VOFF = 16384;
struct AttnState { float m_run, l_run; f32x16 o0, o1; };
template <bool FIX>
__device__ __forceinline__ void attn_step(const Ctx& C, AttnState& S, const bf16x8 (&qf)[4], const LAS unsigned char* kb, const LAS unsigned char* vbt, const LAS float* Bx, int jbase) {
    const int lane = C.lane, r32 = lane & 31, hi = lane >> 5;
    typedef float f32x2 __attribute__((ext_vector_type(2)));
    f32x16 p0, p1;
#pragma unroll
    for (int r = 0; r < 16; ++r) { const int kk = (r & 3) + 8 * (r >> 2); p0[r] = Bx[(ATT_BX - 1 - jbase) + kk]; p1[r] = Bx[(ATT_BX - 1 - jbase) + kk + 32]; }
    bf16x8 kf[8];
#pragma unroll
    for (int t = 0; t < 2; ++t)
#pragma unroll
        for (int ks = 0; ks < 4; ++ks) kf[t * 4 + ks] = *(const LAS bf16x8*)(kb + (32 * t + r32) * 128 + 16 * ((2 * ks + hi) ^ (r32 & 7)));
    __builtin_amdgcn_sched_barrier(0);
#pragma unroll
    for (int ks = 0; ks < 4; ++ks) { p0 = __builtin_amdgcn_mfma_f32_32x32x16_bf16(kf[ks], qf[ks], p0, 0, 0, 0); p1 = __builtin_amdgcn_mfma_f32_32x32x16_bf16(kf[4 + ks], qf[ks], p1, 0, 0, 0); }
    __builtin_amdgcn_sched_barrier(0);
    bf16x8 vf[8];
#pragma unroll
    for (int ts = 0; ts < 4; ++ts)
#pragma unroll
        for (int dt = 0; dt < 2; ++dt) { const s16x4 lo = ds_tr(vbt + ((2 * ts) * 2 + dt) * 512), hi4 = ds_tr(vbt + ((2 * ts + 1) * 2 + dt) * 512);
            vf[2 * ts + dt] = (bf16x8){lo[0], lo[1], lo[2], lo[3], hi4[0], hi4[1], hi4[2], hi4[3]}; }
    __builtin_amdgcn_sched_barrier(0);
    if constexpr (FIX) {
        f32x2 ps2 = {0.f, 0.f};
#pragma unroll
        for (int r = 0; r < 16; r += 2) {
            f32x2 x, y; x.x = __builtin_amdgcn_exp2f(p0[r]); x.y = __builtin_amdgcn_exp2f(p0[r + 1]); y.x = __builtin_amdgcn_exp2f(p1[r]); y.y = __builtin_amdgcn_exp2f(p1[r + 1]);
            p0[r] = x.x; p0[r + 1] = x.y; p1[r] = y.x; p1[r + 1] = y.y; ps2 += x + y; }
        S.l_run += ps2.x + ps2.y;
    } else {
    asm volatile("s_nop 15\n\ts_nop 7" : "+v"(p0), "+v"(p1));
    float mx = max3f(p0[0], p1[0], p0[1]), my = max3f(p1[1], p0[2], p1[2]);
#pragma unroll
    for (int r = 3; r < 15; r += 2) { mx = max3f(mx, p0[r], p1[r]); my = max3f(my, p0[r + 1], p1[r + 1]); }
    mx = max3f(mx, p0[15], p1[15]); mx = max3f(mx, my, my);
    { const auto sw = __builtin_amdgcn_permlane32_swap(__float_as_uint(mx), __float_as_uint(mx), false, false); mx = fmaxf(__uint_as_float(sw[0]), __uint_as_float(sw[1])); }
    const float m_new = max3f(S.m_run, mx, mx);
    const float alpha = __builtin_amdgcn_exp2f(S.m_run - m_new);
    S.m_run = m_new;
    const f32x2 m2 = {m_new, m_new}; f32x2 ps2 = {0.f, 0.f};
#pragma unroll
    for (int r = 0; r < 16; r += 2) {
        f32x2 x = (f32x2){p0[r], p0[r + 1]} - m2, y = (f32x2){p1[r], p1[r + 1]} - m2;
        x.x = __builtin_amdgcn_exp2f(x.x); x.y = __builtin_amdgcn_exp2f(x.y); y.x = __builtin_amdgcn_exp2f(y.x); y.y = __builtin_amdgcn_exp2f(y.y);
        p0[r] = x.x; p0[r + 1] = x.y; p1[r] = y.x; p1[r + 1] = y.y; ps2 += x + y; }
    S.l_run = S.l_run * alpha + (ps2.x + ps2.y);
#pragma unroll
    for (int r = 0; r < 16; ++r) { S.o0[r] *= alpha; S.o1[r] *= alpha; }
    }
    bf16x8 pf[4];
#pragma unroll
    for (int s = 0; s < 2; ++s) { u32x4 w0, w1;
        w0.x = pk2c(p0[8 * s], p0[8 * s + 1]); w0.y = pk2c(p0[8 * s + 2], p0[8 * s + 3]); w0.z = pk2c(p0[8 * s + 4], p0[8 * s + 5]); w0.w = pk2c(p0[8 * s + 6], p0[8 * s + 7]);
        w1.x = pk2c(p1[8 * s], p1[8 * s + 1]); w1.y = pk2c(p1[8 * s + 2], p1[8 * s + 3]); w1.z = pk2c(p1[8 * s + 4], p1[8 * s + 5]); w1.w = pk2c(p1[8 * s + 6], p1[8 * s + 7]);
        pf[s] = __builtin_bit_cast(bf16x8, w0); pf[2 + s] = __builtin_bit_cast(bf16x8, w1); }
#pragma unroll
    for (int ts = 0; ts < 4; ++ts) { S.o0 = __builtin_amdgcn_mfma_f32_32x32x16_bf16(vf[2 * ts], pf[ts], S.o0, 0, 0, 0); S.o1 = __builtin_amdgcn_mfma_f32_32x32x16_bf16(vf[2 * ts + 1], pf[ts], S.o1, 0, 0, 0); }
}
template <bool FIX>
__device__ __forceinline__ void attn_block_item(const Ctx& C, int b, int h, int c0) {
    const bf16_t* QH = (const bf16_t*)(C.ws + WS_QH); const bf16_t* KH = (const bf16_t*)(C.ws + WS_KH); const bf16_t* VH = (const bf16_t*)(C.ws + WS_VH);
    bf16_t* O = (bf16_t*)(C.ws + WS_O);
    const int lane = C.lane, r32 = lane & 31, hi = lane >> 5, tid = C.tid, j = C.wave >> 1, half = C.wave & 1, qc = c0 + j;
    const unsigned lds0 = (unsigned)(uintptr_t)C.lds;
    const LAS float* Bx = (const LAS float*)(C.lds + ATT_BX_OFF) + h * ATT_BX;
    const size_t bh = (size_t)(b * NH + h) * SEQ;
    bf16x8 qf[4];
    { const bf16_t* Qp = QH + (bh + qc * 64 + half * 32 + r32) * 64 + 8 * hi;
#pragma unroll
      for (int ks = 0; ks < 4; ++ks) qf[ks] = *(const bf16x8*)(Qp + 16 * ks); }
    const bf16_t* Ksrc = KH + (bh + (tid >> 3)) * 64 + 8 * ((tid & 7) ^ ((tid >> 3) & 7));
    const bf16_t* Vsrc = VH + (bh + 8 * C.wave + ((lane & 31) >> 2)) * 64 + (4 * (lane >> 5) + (lane & 3)) * 8;
    const unsigned kdst = lds0 + ATT_KOFF + C.wave * 1024, vdst = lds0 + ATT_VOFF + C.wave * 1024;
    const int i16 = lane & 15;
    const int trbase = (4 * hi + (i16 >> 2)) * 64 + (16 * ((lane >> 4) & 1) + 4 * (i16 & 3)) * 2;
    const int qi = 32 * half + r32;
    AttnState S; S.m_run = -INFINITY; S.l_run = 0.f;
#pragma unroll
    for (int r = 0; r < 16; ++r) { S.o0[r] = 0.f; S.o1[r] = 0.f; }
    const int s0 = c0 >= 8 ? 0 : 8 - c0;
    { const size_t ko = (size_t)(c0 - 8 + s0) * 64 * 64;
      glds16(Ksrc + ko, (unsigned)__builtin_amdgcn_readfirstlane((int)(kdst + (s0 & 1) * 8192))); glds16(Vsrc + ko, (unsigned)__builtin_amdgcn_readfirstlane((int)(vdst + (s0 & 1) * 8192))); }
    asm volatile("s_waitcnt vmcnt(0) lgkmcnt(0)\n\ts_barrier" ::: "memory");
    asm volatile("" : "+v"(qf[0]), "+v"(qf[1]), "+v"(qf[2]), "+v"(qf[3]));
    for (int s = s0; s < 12; ++s) {
        if (s + 1 < 12) { const size_t ko = (size_t)(c0 - 8 + s + 1) * 64 * 64; const int nb = (s + 1) & 1;
            glds16(Ksrc + ko, (unsigned)__builtin_amdgcn_readfirstlane((int)(kdst + nb * 8192))); glds16(Vsrc + ko, (unsigned)__builtin_amdgcn_readfirstlane((int)(vdst + nb * 8192))); }
        const int jb = s - j;
        if (jb >= 0 && jb < 9) attn_step<FIX>(C, S, qf, C.lds + ATT_KOFF + (s & 1) * 8192, C.lds + ATT_VOFF + (s & 1) * 8192 + trbase, Bx, 512 - 64 * jb + qi + 64 - 4 * hi);
        asm volatile("s_waitcnt vmcnt(0) lgkmcnt(0)\n\ts_barrier" ::: "memory");
    }
    float lt = S.l_run + __shfl_xor(S.l_run, 32);
    const float inv = 1.0f / lt;
    float ss = 0.f;
#pragma unroll
    for (int r = 0; r < 16; ++r) { S.o0[r] *= inv; S.o1[r] *= inv; ss += S.o0[r] * S.o0[r] + S.o1[r] * S.o1[r]; }
    ss += __shfl_xor(ss, 32);
    const float rn = 1.0f / sqrtf(ss * (1.f / 64.f) + EPS);
    bf16_t* op = O + (size_t)(b * SEQ + qc * 64 + half * 32 + r32) * D + 512 + h * 64 + 4 * hi;
#pragma unroll
    for (int g = 0; g < 4; ++g) {
        *(unsigned long long*)(op + 8 * g) = (unsigned long long)pk2(S.o0[4 * g] * rn, S.o0[4 * g + 1] * rn) | ((unsigned long long)pk2(S.o0[4 * g + 2] * rn, S.o0[4 * g + 3] * rn) << 32);
        *(unsigned long long*)(op + 32 + 8 * g) = (unsigned long long)pk2(S.o1[4 * g] * rn, S.o1[4 * g + 1] * rn) | ((unsigned long long)pk2(S.o1[4 * g + 2] * rn, S.o1[4 * g + 3] * rn) << 32);
    }
}
__device__ __forceinline__ void phase_attn(const Ctx& C, int l, int first, int stride, int limit) {
    attn_load_bias(C, l);
    __syncthreads();
    for (int it = first; it < limit; it += stride) { const int qq = it % (SEQ / 256), bh = it / (SEQ / 256), b = bh / NH, h = bh % NH;
        if (__builtin_amdgcn_readfirstlane(__float_as_int(((const LAS float*)(C.lds + ATT_MH_OFF))[NH + h])) != 0) attn_block_item<true>(C, b, h, qq * 4); else attn_block_item<false>(C, b, h, qq * 4); }
    __syncthreads();
}

struct S5C { float x; double y; float fr, fi; };
__device__ __forceinline__ void s5_sincos_d(double ang, float& sn, float& cs) {
    ang -= 6.283185307179586476925 * rint(ang * 0.15915494309189533577);
    const float a = (float)ang; sn = __sinf(a); cs = __cosf(a);
}
__device__ __forceinline__ S5C s5_consts(const Ctx& C, int l, int g, int p) {
    const float lr = gptr(C.in[6])[l * 1024 + g * 64 + p], li = gptr(C.in[7])[l * 1024 + g * 64 + p], dt = __expf(gptr(C.in[8])[l * 16 + g]);
    S5C c; c.x = lr * dt; c.y = (double)li * (double)dt;
    float sn, cs, sh, ch; s5_sincos_d(c.y, sn, cs); s5_sincos_d(0.5 * c.y, sh, ch);
    const float x = c.x;
    const float ex1 = x * (1.f + x * (0.5f + x * (0.16666667f + x * (0.041666668f + x * (0.0083333338f + x * 0.0013888889f))))), er = ex1 + 1.f;
    const float nr = ex1 * cs - 2.f * sh * sh, ni = er * sn, den = lr * lr + li * li;
    c.fr = (nr * lr + ni * li) / den; c.fi = (ni * lr - nr * li) / den;
    return c;
}
__device__ __forceinline__ void s5_cpow(const S5C& c, int n, float& re, float& im) {
    const float e = __expf(c.x * (float)n);
    float sn, cs; s5_sincos_d(c.y * (double)n, sn, cs); re = e * cs; im = e * sn;
}
__device__ __forceinline__ int s5_m2col(int sg) { const int ks = sg >> 5, rem = sg & 31; return 32 * ks + 8 * ((rem >> 2) & 3) + 4 * (rem >> 4) + (rem & 3); }
constexpr int S5_ITEMS_LG = 19, S5_ITEMS = DEPTH * 16 * S5_ITEMS_LG;
constexpr int S5_APS = 19 * 128;
__device__ __forceinline__ void s5_prep_item(const Ctx& C, int it, LAS float* scr) {
    const int lg = it / S5_ITEMS_LG, r = it % S5_ITEMS_LG, l = lg >> 4, g = lg & 15, lane = C.lane;
    unsigned char* base = C.ws + WS_S5 + (size_t)l * S5_LAYER;
    const float* bre = gptr(C.in[9]) + l * 16384 + g * 1024; const float* bim = gptr(C.in[10]) + l * 16384 + g * 1024;
    const float* cre = gptr(C.in[11]) + l * 16384 + g * 1024; const float* cim = gptr(C.in[12]) + l * 16384 + g * 1024;
    if (r < 16) {
        const int delta = r;
        { const int p = lane; const S5C c = s5_consts(C, l, g, p);
#pragma unroll
          for (int ts = 0; ts < 2; ++ts) { float pr = 0.f, pi = 0.f; if (delta - ts >= 0) s5_cpow(c, delta - ts, pr, pi);
              scr[(ts * 64 + p) * 2] = (delta - ts >= 0) ? pr * c.fr - pi * c.fi : 0.f; scr[(ts * 64 + p) * 2 + 1] = (delta - ts >= 0) ? pr * c.fi + pi * c.fr : 0.f; } }
        { LAS f32x4* sb = (LAS f32x4*)(scr + 256);
#pragma unroll
          for (int q = 0; q < 4; ++q) { sb[lane + 64 * q] = ((const f32x4*)bre)[lane + 64 * q]; sb[256 + lane + 64 * q] = ((const f32x4*)bim)[lane + 64 * q]; } }
        asm volatile("s_waitcnt lgkmcnt(0)" ::: "memory");
        const int h = lane & 15, kq = lane >> 4, ts = kq >> 1, tau = delta - ts;
        float acc[8];
#pragma unroll
        for (int j = 0; j < 8; ++j) acc[j] = 0.f;
        const LAS f32x4* sbr = (const LAS f32x4*)(scr + 256) + 2 * (kq & 1); const LAS f32x4* sbi = sbr + 256;
        float cr[64 / 16], ci[64 / 16];
#pragma unroll 1
        for (int p0 = 0; p0 < 64; p0 += 4) {
#pragma unroll
            for (int q = 0; q < 4; ++q) { cr[q] = cre[h * 64 + p0 + q]; ci[q] = cim[h * 64 + p0 + q]; }
#pragma unroll
            for (int q = 0; q < 4; ++q) { const int p = p0 + q;
                const float pr = scr[(ts * 64 + p) * 2], pi = scr[(ts * 64 + p) * 2 + 1];
                const float wr = cr[q] * pr - ci[q] * pi, wi = cr[q] * pi + ci[q] * pr;
                const f32x4 b0 = sbr[4 * p], b1 = sbr[4 * p + 1], c0 = sbi[4 * p], c1 = sbi[4 * p + 1];
                acc[0] += wr * b0.x - wi * c0.x; acc[1] += wr * b0.y - wi * c0.y; acc[2] += wr * b0.z - wi * c0.z; acc[3] += wr * b0.w - wi * c0.w;
                acc[4] += wr * b1.x - wi * c1.x; acc[5] += wr * b1.y - wi * c1.y; acc[6] += wr * b1.z - wi * c1.z; acc[7] += wr * b1.w - wi * c1.w; }
        }
        if (tau == 0) {
#pragma unroll
            for (int j = 0; j < 8; ++j) if (8 * (kq & 1) + j == h) acc[j] += gptr(C.in[13])[l * 256 + g * 16 + h];
        }
        u32x4 o; o.x = pk2(acc[0], acc[1]); o.y = pk2(acc[2], acc[3]); o.z = pk2(acc[4], acc[5]); o.w = pk2(acc[6], acc[7]);
        *(u32x4*)((bf16_t*)(base + S5_TT) + ((size_t)(g * 16 + delta) * 64 + lane) * 8) = o;
        asm volatile("s_waitcnt lgkmcnt(0)" ::: "memory");
    } else if (r == 16) {
        const int p = lane; const S5C c = s5_consts(C, l, g, p);
        float ar, ai; s5_cpow(c, 1, ar, ai);
        const float w1r = ar * c.fr - ai * c.fi, w1i = ar * c.fi + ai * c.fr;
        bf16_t* BB = (bf16_t*)(base + S5_M1) + (size_t)g * 128 * 32;
        unsigned re[16], im[16];
#pragma unroll
        for (int h2 = 0; h2 < 8; ++h2) {
            const float x0 = bre[p * 16 + 2 * h2], y0 = bim[p * 16 + 2 * h2], x1 = bre[p * 16 + 2 * h2 + 1], y1 = bim[p * 16 + 2 * h2 + 1];
            re[h2] = pk2(w1r * x0 - w1i * y0, w1r * x1 - w1i * y1); im[h2] = pk2(w1r * y0 + w1i * x0, w1r * y1 + w1i * x1);
            re[8 + h2] = pk2(c.fr * x0 - c.fi * y0, c.fr * x1 - c.fi * y1); im[8 + h2] = pk2(c.fr * y0 + c.fi * x0, c.fr * y1 + c.fi * x1);
        }
        u32x4* d0 = (u32x4*)(BB + (size_t)p * 32); u32x4* d1 = (u32x4*)(BB + (size_t)(64 + p) * 32);
#pragma unroll
        for (int q = 0; q < 4; ++q) { d0[q] = (u32x4){re[4 * q], re[4 * q + 1], re[4 * q + 2], re[4 * q + 3]}; d1[q] = (u32x4){im[4 * q], im[4 * q + 1], im[4 * q + 2], im[4 * q + 3]}; }
    } else if (r == 17) {
        const int p = lane;
        bf16_t* CMp = (bf16_t*)(base + S5_M2P) + (size_t)g * 16 * 128;
        const int c0 = s5_m2col(p), c1 = s5_m2col(64 + p);
#pragma unroll
        for (int h = 0; h < 16; ++h) { CMp[h * 128 + c0] = f2bf(cre[h * 64 + p]); CMp[h * 128 + c1] = f2bf(-cim[h * 64 + p]); }
    } else {
        const int p = lane; const S5C c = s5_consts(C, l, g, p);
        float* A16 = (float*)(base + S5_AP16) + (size_t)g * S5_APS; float* A256 = (float*)(base + S5_AP256) + (size_t)g * 32 * 128;
        for (int cc = 0; cc <= 18; ++cc) { float pr, pi; s5_cpow(c, cc <= 16 ? 16 * cc : cc - 16, pr, pi); A16[cc * 128 + p] = pr; A16[cc * 128 + 64 + p] = pi; }
        for (int m = 0; m < 32; ++m) { float pr, pi; s5_cpow(c, 256 * m, pr, pi); A256[m * 128 + p] = pr; A256[m * 128 + 64 + p] = pi; }
    }
}

__device__ __forceinline__ float dpp_shr(float v, int d) {
    int r;
    if (d == 1) r = __builtin_amdgcn_update_dpp(0, __float_as_int(v), 0x111, 0xf, 0xf, true);
    else if (d == 2) r = __builtin_amdgcn_update_dpp(0, __float_as_int(v), 0x112, 0xf, 0xf, true);
    else if (d == 4) r = __builtin_amdgcn_update_dpp(0, __float_as_int(v), 0x114, 0xf, 0xf, true);
    else r = __builtin_amdgcn_update_dpp(0, __float_as_int(v), 0x118, 0xf, 0xf, true);
    return __int_as_float(r);
}
struct S5Wave { bf16x8 uf[8]; f32x4 X[8]; f32x4 ar[4], ai[4], wr[4], wi[4]; };
#define S5_CSQR(pr, pi) do { _Pragma("unroll") for (int mt_ = 0; mt_ < 4; ++mt_) { const f32x4 r_ = pr[mt_] * pr[mt_] - pi[mt_] * pi[mt_], i_ = 2.f * (pr[mt_] * pi[mt_]); pr[mt_] = r_; pi[mt_] = i_; } } while (0)
template <bool NEEDW> __device__ __forceinline__ void s5_E_scan(const Ctx& C, int l, int b, int k, int g, S5Wave& W) {
    const int lane = C.lane, cc = lane & 15, kq = lane >> 4;
    const unsigned char* base = C.ws + WS_S5 + (size_t)l * S5_LAYER;
    const bf16_t* ZS = (const bf16_t*)(C.ws + WS_ZS);
    const bf16_t* up = ZS + ((size_t)b * SEQ + 256 * k + 16 * cc + (kq >> 1)) * 256 + 16 * g + 8 * (kq & 1);
#pragma unroll
    for (int ks = 0; ks < 8; ++ks) W.uf[ks] = *(const bf16x8*)(up + (size_t)(2 * ks) * 256);
    const bf16_t* bbp = opaque((const bf16_t*)(base + S5_M1) + (size_t)g * 128 * 32 + (size_t)cc * 32 + 8 * kq);
    bf16x8 bb[8];
#pragma unroll
    for (int mt = 0; mt < 8; ++mt) bb[mt] = *(const bf16x8*)(bbp + (size_t)(16 * mt) * 32);
    const float* A1 = opaque((const float*)(base + S5_AP16) + (size_t)g * S5_APS + 17 * 128 + 4 * kq);
#pragma unroll
    for (int mt = 0; mt < 4; ++mt) { W.ar[mt] = *(const f32x4*)(A1 + 16 * mt); W.ai[mt] = *(const f32x4*)(A1 + 64 + 16 * mt); }
    f32x4 pr[4], pi[4];
#pragma unroll
    for (int mt = 0; mt < 4; ++mt) { pr[mt] = W.ar[mt]; pi[mt] = W.ai[mt]; }
    S5_CSQR(pr, pi);
#pragma unroll
    for (int mt = 0; mt < 8; ++mt) W.X[mt] = (f32x4){0.f, 0.f, 0.f, 0.f};
#pragma unroll
    for (int ks = 0; ks < 8; ++ks) {
        if (ks) {
#pragma unroll
            for (int mt = 0; mt < 4; ++mt) { const f32x4 re = W.X[mt], im = W.X[mt + 4]; W.X[mt] = pr[mt] * re - pi[mt] * im; W.X[mt + 4] = pr[mt] * im + pi[mt] * re; }
        }
#pragma unroll
        for (int mt = 0; mt < 8; ++mt) W.X[mt] = __builtin_amdgcn_mfma_f32_16x16x32_bf16(bb[mt], W.uf[ks], W.X[mt], 0, 0, 0);
    }
    S5_CSQR(pr, pi); S5_CSQR(pr, pi); S5_CSQR(pr, pi);
    if (NEEDW) {
#pragma unroll
        for (int mt = 0; mt < 4; ++mt) { W.wr[mt] = (f32x4){1.f, 1.f, 1.f, 1.f}; W.wi[mt] = (f32x4){0.f, 0.f, 0.f, 0.f}; } }
#pragma unroll
    for (int d = 1; d < 16; d <<= 1) {
#pragma unroll
        for (int mt = 0; mt < 4; ++mt) {
#pragma unroll
            for (int r = 0; r < 4; ++r) { const float sr = dpp_shr(W.X[mt][r], d), si = dpp_shr(W.X[mt + 4][r], d);
                W.X[mt][r] += pr[mt][r] * sr - pi[mt][r] * si; W.X[mt + 4][r] += pr[mt][r] * si + pi[mt][r] * sr; }
        }
        if (NEEDW) { const bool sel = (cc & d) != 0;
#pragma unroll
            for (int mt = 0; mt < 4; ++mt) { const f32x4 nr = W.wr[mt] * pr[mt] - W.wi[mt] * pi[mt], ni = W.wr[mt] * pi[mt] + W.wi[mt] * pr[mt];
#pragma unroll
                for (int r = 0; r < 4; ++r) { W.wr[mt][r] = sel ? nr[r] : W.wr[mt][r]; W.wi[mt][r] = sel ? ni[r] : W.wi[mt][r]; } } }
        if (d < 8) S5_CSQR(pr, pi);
    }
}
__device__ __forceinline__ void s5a_item(const Ctx& C, int l, int it) {
    const int g = it & 15, k = (it >> 4) & 31, b = it >> 9;
    S5Wave W; s5_E_scan<false>(C, l, b, k, g, W);
    if ((C.lane & 15) == 15) { float* F = (float*)(C.ws + WS_S5F) + ((size_t)((b * 32 + k) * 16 + g)) * 128 + 4 * (C.lane >> 4);
#pragma unroll
        for (int mt = 0; mt < 8; ++mt) *(f32x4*)(F + 16 * mt) = W.X[mt]; }
}
constexpr int S5_YSTRIDE = 528;
__device__ __forceinline__ void s5c_group(const Ctx& C0, int l, int b, int k, int g) {
    Ctx C = C0; asm volatile("; S5C_GROUP_BEGIN\n" : "+v"(C.lane));
    const int lane = C.lane, cc = lane & 15, kq = lane >> 4;
    const unsigned char* base = C.ws + WS_S5 + (size_t)l * S5_LAYER;
    f32x4 gr[4], gi[4];
#pragma unroll
    for (int mt = 0; mt < 4; ++mt) { gr[mt] = (f32x4){0.f, 0.f, 0.f, 0.f}; gi[mt] = (f32x4){0.f, 0.f, 0.f, 0.f}; }
    if (k > 0) {
        const float* F = opaque((const float*)(C.ws + WS_S5F) + ((size_t)(b * 32) * 16 + g) * 128 + 4 * kq);
        const float* A256 = opaque((const float*)(base + S5_AP256) + (size_t)g * 32 * 128 + 4 * kq);
#pragma unroll
        for (int rep = 0; rep < 2; ++rep) { const int kp = cc + 16 * rep;
            if (kp < k) { const float* f = opaque(F + (size_t)kp * 16 * 128); const float* w = opaque(A256 + (size_t)(k - 1 - kp) * 128);
#pragma unroll
                for (int mt = 0; mt < 4; ++mt) { const f32x4 fr = *(const f32x4*)(f + 16 * mt), fi = *(const f32x4*)(f + 64 + 16 * mt), wr = *(const f32x4*)(w + 16 * mt), wi = *(const f32x4*)(w + 64 + 16 * mt);
                    gr[mt] += wr * fr - wi * fi; gi[mt] += wr * fi + wi * fr; } } }
#pragma unroll
        for (int mt = 0; mt < 4; ++mt)
#pragma unroll
            for (int r = 0; r < 4; ++r) {
#pragma unroll
                for (int o = 1; o < 16; o <<= 1) { gr[mt][r] += __shfl_xor(gr[mt][r], o); gi[mt][r] += __shfl_xor(gi[mt][r], o); } }
    }
    S5Wave W; s5_E_scan<true>(C, l, b, k, g, W);
#pragma unroll
    for (int mt = 0; mt < 8; ++mt)
#pragma unroll
        for (int r = 0; r < 4; ++r) W.X[mt][r] = dpp_shr(W.X[mt][r], 1);
#pragma unroll
    for (int mt = 0; mt < 4; ++mt) { W.X[mt] += W.wr[mt] * gr[mt] - W.wi[mt] * gi[mt]; W.X[mt + 4] += W.wr[mt] * gi[mt] + W.wi[mt] * gr[mt]; }
    bf16x8 tt[16];
    const bf16_t* ttp = opaque((const bf16_t*)(base + S5_TT) + ((size_t)(g * 16) * 64 + lane) * 8);
#pragma unroll
    for (int d4 = 0; d4 < 4; ++d4) { if (d4) ttp = opaque(ttp + 4 * 64 * 8);
#pragma unroll
        for (int d = 0; d < 4; ++d) tt[4 * d4 + d] = *(const bf16x8*)(ttp + (size_t)d * 64 * 8); }
    bf16x8 cm[4];
    const bf16_t* cmp = opaque((const bf16_t*)(base + S5_M2P) + (size_t)g * 16 * 128 + (size_t)cc * 128 + 8 * kq);
#pragma unroll
    for (int ks = 0; ks < 4; ++ks) cm[ks] = *(const bf16x8*)(cmp + 32 * ks);
    f32x4 a1r[4], a1i[4];
    { const float* A1 = opaque((const float*)(base + S5_AP16) + (size_t)g * S5_APS + 17 * 128 + 4 * kq);
#pragma unroll
      for (int mt = 0; mt < 4; ++mt) { a1r[mt] = *(const f32x4*)(A1 + 16 * mt); a1i[mt] = *(const f32x4*)(A1 + 64 + 16 * mt); } }
    LAS unsigned char* yt = C.lds + (size_t)(16 * cc) * S5_YSTRIDE + (16 * g + 4 * kq) * 2;
#pragma unroll
    for (int jj = 0; jj < 16; jj += 2) {
        bf16x8 sf1[4], sf2[4];
#pragma unroll
        for (int mt = 0; mt < 4; ++mt) { const f32x4 re = W.X[mt], im = W.X[mt + 4]; W.X[mt] = a1r[mt] * re - a1i[mt] * im; W.X[mt + 4] = a1r[mt] * im + a1i[mt] * re; }
#pragma unroll
        for (int ks = 0; ks < 4; ++ks) { u32x4 w; w.x = pk2(W.X[2 * ks][0], W.X[2 * ks][1]); w.y = pk2(W.X[2 * ks][2], W.X[2 * ks][3]); w.z = pk2(W.X[2 * ks + 1][0], W.X[2 * ks + 1][1]); w.w = pk2(W.X[2 * ks + 1][2], W.X[2 * ks + 1][3]); sf1[ks] = __builtin_bit_cast(bf16x8, w); }
#pragma unroll
        for (int mt = 0; mt < 4; ++mt) { const f32x4 re = W.X[mt], im = W.X[mt + 4]; W.X[mt] = a1r[mt] * re - a1i[mt] * im; W.X[mt + 4] = a1r[mt] * im + a1i[mt] * re; }
#pragma unroll
        for (int ks = 0; ks < 4; ++ks) { u32x4 w; w.x = pk2(W.X[2 * ks][0], W.X[2 * ks][1]); w.y = pk2(W.X[2 * ks][2], W.X[2 * ks][3]); w.z = pk2(W.X[2 * ks + 1][0], W.X[2 * ks + 1][1]); w.w = pk2(W.X[2 * ks + 1][2], W.X[2 * ks + 1][3]); sf2[ks] = __builtin_bit_cast(bf16x8, w); }
        f32x4 acc1 = {0.f, 0.f, 0.f, 0.f}, acc2 = {0.f, 0.f, 0.f, 0.f};
#pragma unroll
        for (int ks = 0; ks < 4; ++ks) { acc1 = __builtin_amdgcn_mfma_f32_16x16x32_bf16(cm[ks], sf1[ks], acc1, 0, 0, 0); acc2 = __builtin_amdgcn_mfma_f32_16x16x32_bf16(cm[ks], sf2[ks], acc2, 0, 0, 0); }
#pragma unroll
        for (int ks = 0; ks <= jj / 2; ++ks) { acc1 = __builtin_amdgcn_mfma_f32_16x16x32_bf16(tt[jj - 2 * ks], W.uf[ks], acc1, 0, 0, 0); acc2 = __builtin_amdgcn_mfma_f32_16x16x32_bf16(tt[jj + 1 - 2 * ks], W.uf[ks], acc2, 0, 0, 0); }
        const unsigned long long w1 = (unsigned long long)pk2(gelu_tanh(acc1[0]), gelu_tanh(acc1[1])) | ((unsigned long long)pk2(gelu_tanh(acc1[2]), gelu_tanh(acc1[3])) << 32);
        const unsigned long long w2 = (unsigned long long)pk2(gelu_tanh(acc2[0]), gelu_tanh(acc2[1])) | ((unsigned long long)pk2(gelu_tanh(acc2[2]), gelu_tanh(acc2[3])) << 32);
        *(LAS unsigned long long*)(yt + jj * S5_YSTRIDE) = w1; *(LAS unsigned long long*)(yt + (jj + 1) * S5_YSTRIDE) = w2;
    }
}
__device__ __forceinline__ void s5c_glu(const Ctx& C0, int l, int b, int k) {
    Ctx C = C0; asm volatile("; S5C_GLU_BEGIN\n" : "+v"(C.lane));
    const int lane = C.lane, r32 = lane & 31, hi = lane >> 5, tok = 32 * C.wave + r32;
    const bf16_t* gtp = opaque((const bf16_t*)(C.ws + WS_GLU) + (size_t)l * 65536 + (size_t)lane * 8);
    const float* gb = gptr(C.in[15]) + l * 256;
    const LAS unsigned char* yrow = C.lds + (size_t)tok * S5_YSTRIDE;
    bf16x8 yf[16];
#pragma unroll
    for (int ks = 0; ks < 16; ++ks) yf[ks] = *(const LAS bf16x8*)(yrow + (16 * ks + 8 * hi) * 2);
    bf16_t* op = (bf16_t*)(C.ws + WS_O) + ((size_t)b * SEQ + 256 * k + tok) * D + 256 + 4 * hi;
    bf16x8 wa[16], wb[16];
#pragma unroll
    for (int ks = 0; ks < 16; ++ks) wa[ks] = *(const bf16x8*)(gtp + 512 * ks);
#pragma unroll
    for (int ng = 0; ng < 4; ++ng) {
        f32x16 z[2];
#pragma unroll
        for (int r = 0; r < 16; ++r) { z[0][r] = 0.f; z[1][r] = 0.f; }
        gtp = opaque(gtp + 16 * 512);
#pragma unroll
        for (int ks = 0; ks < 16; ++ks) wb[ks] = *(const bf16x8*)(gtp + 512 * ks);
#pragma unroll
        for (int ks = 0; ks < 16; ++ks) z[0] = __builtin_amdgcn_mfma_f32_32x32x16_bf16(wa[ks], yf[ks], z[0], 0, 0, 0);
        if (ng < 3) { gtp = opaque(gtp + 16 * 512);
#pragma unroll
            for (int ks = 0; ks < 16; ++ks) wa[ks] = *(const bf16x8*)(gtp + 512 * ks); }
#pragma unroll
        for (int ks = 0; ks < 16; ++ks) z[1] = __builtin_amdgcn_mfma_f32_32x32x16_bf16(wb[ks], yf[ks], z[1], 0, 0, 0);
        float ob[2][16]; float ss = 0.f;
#pragma unroll
        for (int m2 = 0; m2 < 2; ++m2)
#pragma unroll
            for (int q4 = 0; q4 < 4; ++q4) { const int ch = 32 * (2 * ng + m2) + 8 * q4 + 4 * hi;
                const unsigned long long yw = *(const LAS unsigned long long*)(yrow + ch * 2); const f32x4 bb = *(const f32x4*)(gb + ch);
                const float y0 = __uint_as_float((unsigned)yw << 16), y1 = __uint_as_float((unsigned)yw & 0xffff0000u), y2 = __uint_as_float((unsigned)(yw >> 32) << 16), y3 = __uint_as_float((unsigned)(yw >> 32) & 0xffff0000u);
                const float o0 = fast_sigmoid_mul(y0, z[m2][4 * q4] + bb[0]), o1 = fast_sigmoid_mul(y1, z[m2][4 * q4 + 1] + bb[1]), o2 = fast_sigmoid_mul(y2, z[m2][4 * q4 + 2] + bb[2]), o3 = fast_sigmoid_mul(y3, z[m2][4 * q4 + 3] + bb[3]);
                ob[m2][4 * q4] = o0; ob[m2][4 * q4 + 1] = o1; ob[m2][4 * q4 + 2] = o2; ob[m2][4 * q4 + 3] = o3; ss += (o0 * o0 + o1 * o1) + (o2 * o2 + o3 * o3); }
        ss += __shfl_xor(ss, 32);
        const float rn = 1.0f / sqrtf(ss * (1.f / 64.f) + EPS);
#pragma unroll
        for (int m2 = 0; m2 < 2; ++m2)
#pragma unroll
            for (int q4 = 0; q4 < 4; ++q4)
                *(unsigned long long*)(op + 64 * ng + 32 * m2 + 8 * q4) = (unsigned long long)pk2(ob[m2][4 * q4] * rn, ob[m2][4 * q4 + 1] * rn) | ((unsigned long long)pk2(ob[m2][4 * q4 + 2] * rn, ob[m2][4 * q4 + 3] * rn) << 32);
    }
}
__device__ __forceinline__ void s5c_item(const Ctx& C, int l, int it) {
    const int b = it >> 5, k = it & 31;
    REPEAT(22, s5c_group(C, l, b, k, 2 * C.wave); s5c_group(C, l, b, k, 2 * C.wave + 1));
    __syncthreads();
    REPEAT(23, s5c_glu(C, l, b, k));
    __syncthreads();
}

constexpr int SGU_VS = 576;
__device__ __forceinline__ void sgu_item(const Ctx& C, int l, int it) {
    const bf16_t* U = (const bf16_t*)(C.ws + WS_U); const bf16_t* V = (const bf16_t*)(C.ws + WS_V); bf16_t* O = (bf16_t*)(C.ws + WS_O);
    const float* gain = gptr(C.in[3]) + l * 256; const float* sgu_b = gptr(C.in[5]) + l * 512;
    const bf16_t* Wb = (const bf16_t*)(C.ws + WS_SGUW) + (size_t)l * 65536;
    const int tid = C.tid, lane = C.lane, r32 = lane & 31, hi = lane >> 5;
    const size_t t0 = (size_t)it * 128;
    {
        const int row = tid >> 2, qt = tid & 3;
        const u32x4* src = (const u32x4*)(V + (t0 + row) * 256 + qt * 64);
        u32x4 w[8]; float ss = 0.f;
#pragma unroll
        for (int i = 0; i < 8; ++i) { w[i] = src[i];
#pragma unroll
            for (int e = 0; e < 4; ++e) { const float a = __uint_as_float(w[i][e] << 16), b = __uint_as_float(w[i][e] & 0xffff0000u); ss += a * a + b * b; } }
        ss += __shfl_xor(ss, 1); ss += __shfl_xor(ss, 2);
        const float rs = 1.0f / sqrtf(ss * (1.f / 256.f) + EPS);
        LAS unsigned char* dst = C.lds + row * SGU_VS + qt * 128;
#pragma unroll
        for (int i = 0; i < 8; ++i) { const f32x4 g0 = *(const f32x4*)(gain + qt * 64 + 8 * i), g1 = *(const f32x4*)(gain + qt * 64 + 8 * i + 4);
            u32x4 o;
            o.x = pk2(__uint_as_float(w[i].x << 16) * rs * g0.x, __uint_as_float(w[i].x & 0xffff0000u) * rs * g0.y); o.y = pk2(__uint_as_float(w[i].y << 16) * rs * g0.z, __uint_as_float(w[i].y & 0xffff0000u) * rs * g0.w);
            o.z = pk2(__uint_as_float(w[i].z << 16) * rs * g1.x, __uint_as_float(w[i].z & 0xffff0000u) * rs * g1.y); o.w = pk2(__uint_as_float(w[i].w << 16) * rs * g1.z, __uint_as_float(w[i].w & 0xffff0000u) * rs * g1.w);
            *(LAS u32x4*)(dst + 16 * i) = o; }
    }
    __syncthreads();
    const int h = C.wave >> 1, ih = C.wave & 1;
    const int nks = ih ? 8 : 4;
    f32x16 acc[2][2];
#pragma unroll
    for (int mt = 0; mt < 2; ++mt)
#pragma unroll
        for (int nt = 0; nt < 2; ++nt)
#pragma unroll
            for (int r = 0; r < 16; ++r) acc[mt][nt][r] = 0.f;
    const int i16 = lane & 15;
    const LAS unsigned char* vb = C.lds + (8 * hi + (i16 >> 2)) * SGU_VS + (64 * h + 16 * ((lane >> 4) & 1) + 4 * (i16 & 3)) * 2;
    const bf16_t* wp = Wb + ((size_t)h * 128 + 64 * ih + r32) * 128 + 8 * hi;
    for (int ks = 0; ks < nks; ++ks) {
        bf16x8 af[2], bfr[2];
#pragma unroll
        for (int mt = 0; mt < 2; ++mt) { const s16x4 lo = ds_tr(vb + (16 * ks) * SGU_VS + 64 * mt), hi4 = ds_tr(vb + (16 * ks + 4) * SGU_VS + 64 * mt);
            af[mt] = (bf16x8){lo[0], lo[1], lo[2], lo[3], hi4[0], hi4[1], hi4[2], hi4[3]}; }
#pragma unroll
        for (int nt = 0; nt < 2; ++nt) bfr[nt] = *(const bf16x8*)(wp + (size_t)(32 * nt) * 128 + 16 * ks);
#pragma unroll
        for (int mt = 0; mt < 2; ++mt)
#pragma unroll
            for (int nt = 0; nt < 2; ++nt) acc[mt][nt] = __builtin_amdgcn_mfma_f32_32x32x16_bf16(af[mt], bfr[nt], acc[mt][nt], 0, 0, 0);
    }
#pragma unroll
    for (int nt = 0; nt < 2; ++nt) {
        const int i = 64 * ih + 32 * nt + r32; const float bias = sgu_b[h * 128 + i];
        const bf16_t* up = U + (t0 + i) * 256 + 64 * h + 4 * hi; bf16_t* op = O + (t0 + i) * D + 64 * h + 4 * hi;
        float ov[2][16]; float ss = 0.f;
#pragma unroll
        for (int mt = 0; mt < 2; ++mt)
#pragma unroll
            for (int q4 = 0; q4 < 4; ++q4) { const unsigned long long uw = *(const unsigned long long*)(up + 32 * mt + 8 * q4);
                const float u0 = __uint_as_float((unsigned)uw << 16), u1 = __uint_as_float((unsigned)uw & 0xffff0000u), u2 = __uint_as_float((unsigned)(uw >> 32) << 16), u3 = __uint_as_float((unsigned)(uw >> 32) & 0xffff0000u);
                const float o0 = u0 * (acc[mt][nt][4 * q4] + bias), o1 = u1 * (acc[mt][nt][4 * q4 + 1] + bias), o2 = u2 * (acc[mt][nt][4 * q4 + 2] + bias), o3 = u3 * (acc[mt][nt][4 * q4 + 3] + bias);
                ov[mt][4 * q4] = o0; ov[mt][4 * q4 + 1] = o1; ov[mt][4 * q4 + 2] = o2; ov[mt][4 * q4 + 3] = o3; ss += (o0 * o0 + o1 * o1) + (o2 * o2 + o3 * o3); }
        ss += __shfl_xor(ss, 32);
        const float rn = 1.0f / sqrtf(ss * (1.f / 64.f) + EPS);
#pragma unroll
        for (int mt = 0; mt < 2; ++mt)
#pragma unroll
            for (int q4 = 0; q4 < 4; ++q4)
                *(unsigned long long*)(op + 32 * mt + 8 * q4) = (unsigned long long)pk2(ov[mt][4 * q4] * rn, ov[mt][4 * q4 + 1] * rn) | ((unsigned long long)pk2(ov[mt][4 * q4 + 2] * rn, ov[mt][4 * q4 + 3] * rn) << 32);
    }
    __syncthreads();
}

__device__ __forceinline__ void route_block(const Ctx& C, int l, int it) {
    const float* bg = gptr(C.in[23]) + l * 4; const float* be = gptr(C.in[25]) + l * 16;
    unsigned* cnt = (unsigned*)(C.ws + WS_CTL) + (C.dry ? 2048 : CW_CNT + l * 32);
    int* m_bucket = (int*)(C.ws + WS_META + MT_BUCKET); int* m_pos = (int*)(C.ws + WS_META + MT_POS);
    float* m_gw0 = (float*)(C.ws + WS_META + MT_GW0); float* m_gw1 = (float*)(C.ws + WS_META + MT_GW1); float* m_rs = (float*)(C.ws + WS_META + MT_RS2);
    bf16_t* XB = (bf16_t*)(C.ws + WS_XB);
    LAS unsigned* hist = (LAS unsigned*)C.lds; LAS unsigned* hbase = hist + 32;
    const int lane = C.lane, r32 = lane & 31, hi = lane >> 5;
    if (C.tid < 32) hist[C.tid] = 0u;
    __syncthreads();
    int bk = 0, rank = 0; float glo = 0.f, ghi = 0.f, rs = 0.f; const int t = it * 128 + C.wave * 32 + r32;
    if (C.wave < 4) {
        const bf16_t* xbr = XB + (size_t)t * D + 8 * hi;
        const bf16_t* whp = opaque((const bf16_t*)(C.ws + WS_ROUTEW) + (size_t)l * 65536 + (size_t)lane * 8);
        f32x16 acc;
#pragma unroll
        for (int r = 0; r < 16; ++r) acc[r] = 0.f;
        for (int kb = 0; kb < 8; ++kb) {
            bf16x8 xh[8], wh[8], wl[8];
#pragma unroll
            for (int i = 0; i < 8; ++i) { const int ks = 8 * kb + i; xh[i] = *(const bf16x8*)(xbr + 16 * ks); wh[i] = *(const bf16x8*)(whp + 512 * ks); wl[i] = *(const bf16x8*)(whp + 32768 + 512 * ks); }
#pragma unroll
            for (int i = 0; i < 8; ++i) { acc = __builtin_amdgcn_mfma_f32_32x32x16_bf16(wh[i], xh[i], acc, 0, 0, 0); acc = __builtin_amdgcn_mfma_f32_32x32x16_bf16(wl[i], xh[i], acc, 0, 0, 0); }
        }
        rs = row_rstd((const float*)(C.ws + WS_SSQB), t);
        float mine[12], oth[12];
#pragma unroll
        for (int r = 0; r < 12; ++r) { mine[r] = acc[r]; oth[r] = __shfl_xor(acc[r], 32); }
        float lg[20];
#pragma unroll
        for (int q = 0; q < 5; ++q)
#pragma unroll
            for (int e = 0; e < 4; ++e) { const int n = 4 * q + e;
                const float v0 = ((q & 1) == 0) ? mine[4 * (q >> 1) + e] : oth[4 * (q >> 1) + e], v1 = ((q & 1) == 0) ? oth[4 * (q >> 1) + e] : mine[4 * (q >> 1) + e];
                lg[n] = (hi == 0 ? v0 : v1) * rs; }
        float gl[4]; int gt = 0;
#pragma unroll
        for (int i = 0; i < 4; ++i) gl[i] = lg[i] + bg[i];
        float gm = gl[0];
#pragma unroll
        for (int i = 1; i < 4; ++i) if (gl[i] > gm) { gm = gl[i]; gt = i; }
        float gs = 0.f;
#pragma unroll
        for (int i = 0; i < 4; ++i) gs += __expf(gl[i] - gm);
        const float pg = 1.f / gs;
        float el[4];
#pragma unroll
        for (int i = 0; i < 4; ++i) { float v = 0.f;
#pragma unroll
            for (int gi = 0; gi < 4; ++gi) v = (gi == gt) ? lg[4 + 4 * gi + i] + be[gi * 4 + i] : v;
            el[i] = v; }
        int i1 = 0; float m1 = el[0];
#pragma unroll
        for (int i = 1; i < 4; ++i) if (el[i] > m1) { m1 = el[i]; i1 = i; }
        int i2 = -1; float m2 = -3.0e38f;
#pragma unroll
        for (int i = 0; i < 4; ++i) if (i != i1 && el[i] > m2) { m2 = el[i]; i2 = i; }
        const float e2 = __expf(m2 - m1); const float w1 = 1.f / (1.f + e2), w2 = e2 / (1.f + e2);
        const int lo = i1 < i2 ? i1 : i2, hi2 = i1 < i2 ? i2 : i1;
        const int pi = (lo == 0) ? (hi2 - 1) : (lo == 1 ? hi2 + 1 : 5);
        bk = gt * 6 + pi;
        glo = pg * (i1 < i2 ? w1 : w2); ghi = pg * (i1 < i2 ? w2 : w1);
        if (hi == 0) rank = (int)atomicAdd((unsigned*)(hist + bk), 1u);
    }
    __syncthreads();
    if (C.tid < NBUCKET) { const unsigned n = hist[C.tid]; hbase[C.tid] = n ? atomicAdd(cnt + C.tid, n) : 0u; }
    __syncthreads();
    if (C.wave < 4 && hi == 0) { const size_t li = C.dry ? (size_t)(T * 24) + (size_t)(t & 1023) : (size_t)bk * T + hbase[bk] + rank;
        ((int*)(C.ws + WS_BLIST))[li] = t; ((float*)(C.ws + WS_BGW0))[li] = glo; ((float*)(C.ws + WS_BGW1))[li] = ghi; ((float*)(C.ws + WS_BRS))[li] = rs; }
    __syncthreads();
}
__device__ __forceinline__ void phase_perm(const Ctx& C, int l) {
    const unsigned* cnt = (const unsigned*)(C.ws + WS_CTL) + CW_CNT + l * 32; unsigned* tileb = (unsigned*)(C.ws + WS_CTL) + CW_TILEB + l * 160;
    const int* m_bucket = (const int*)(C.ws + WS_META + MT_BUCKET); const int* m_pos = (const int*)(C.ws + WS_META + MT_POS);
    const float* m_gw0 = (const float*)(C.ws + WS_META + MT_GW0); const float* m_gw1 = (const float*)(C.ws + WS_META + MT_GW1); const float* m_rs = (const float*)(C.ws + WS_META + MT_RS2);
    const bf16_t* XB = (const bf16_t*)(C.ws + WS_XB); bf16_t* XS = (bf16_t*)(C.ws + WS_XS); int* stok = (int*)(C.ws + WS_META + MT_STOK) + l * MAXROWS;
    float* sgw0 = (float*)(C.ws + WS_META + MT_SGW0); float* sgw1 = (float*)(C.ws + WS_META + MT_SGW1); float* srs = (float*)(C.ws + WS_META + MT_SRS);
    const int lane = C.lane;
    int nt = (lane < NBUCKET) ? (((int)cnt[lane] + 255) >> 8) : 0, incl = nt;
#pragma unroll
    for (int o = 1; o < 32; o <<= 1) { const int v = __shfl_up(incl, o); if (lane >= o) incl += v; }
    const int excl = incl - nt;
    if (C.gw == 0) { if (lane < NBUCKET) for (int i = 0; i < nt; ++i) tileb[excl + i] = (unsigned)lane; if (lane == NBUCKET - 1) tileb[159] = (unsigned)incl; }
    for (int t = C.gw * 4; t < T; t += C.ngw * 4) {
        int dst[4]; u32x4 v[4][2];
#pragma unroll
        for (int j = 0; j < 4; ++j) { const int bk = m_bucket[t + j]; dst[j] = __shfl(excl, bk) * 256 + m_pos[t + j];
            const u32x4* src = (const u32x4*)(XB + (size_t)(t + j) * D) + lane; v[j][0] = src[0]; v[j][1] = src[64]; }
#pragma unroll
        for (int j = 0; j < 4; ++j) { u32x4* d = (u32x4*)(XS + (size_t)dst[j] * D) + lane; d[0] = v[j][0]; d[64] = v[j][1];
            if (lane == 0) { stok[dst[j]] = t + j; sgw0[dst[j]] = m_gw0[t + j]; sgw1[dst[j]] = m_gw1[t + j]; srs[dst[j]] = m_rs[t + j]; } }
    }
}

__device__ __forceinline__ void phase_prologue(const Ctx& C) {
    LAS float* scr = (LAS float*)(C.lds + C.wave * 16896);
    { const int l = 0; REPEAT(101, phase_prep_weights(C, scr)); }
    { const int l = 0; REPEAT(102, for (int it = C.gw; it < S5_ITEMS; it += C.ngw) s5_prep_item(C, it, scr)); }
    { bf16_t* rw = (bf16_t*)(C.ws + WS_ROUTEW);
      for (int i = C.gw * 64 + C.lane; i < DEPTH * 32 * D; i += C.ngw * 64) { const int l = i / (32 * D), n = (i / D) & 31, k = i & (D - 1);
          float v = 0.f;
          if (n < 4) v = gptr(C.in[22])[((size_t)l * D + k) * 4 + n]; else if (n < 20) v = gptr(C.in[24])[(((size_t)l * 4 + ((n - 4) >> 2)) * D + k) * 4 + ((n - 4) & 3)];
          v *= gptr(C.in[21])[l * D + k];
          const bf16_t h = f2bf(v); const size_t fo = (size_t)l * 65536 + (size_t)(((k >> 4) * 64 + ((k >> 3) & 1) * 32 + n) * 8 + (k & 7));
          rw[fo] = h; rw[fo + 32768] = f2bf(v - bf2f(h)); } }
    { const float* sw = gptr(C.in[4]); bf16_t* dw = (bf16_t*)(C.ws + WS_SGUW);
      for (int i = C.gw * 64 + C.lane; i < DEPTH * 65536 / 2; i += C.ngw * 64) ((unsigned*)dw)[i] = pk2(sw[2 * i], sw[2 * i + 1]); }
    { const int l = 0; REPEAT(103, phase_conv(C, gptr(C.in[0]))); }
}


#define XB_TMO      128
#define XB_XCNT(j)  (256  + 64 * (j))
#define XB_XSUB(j)  (1280 + 64 * (j))
#define XB_XGEN(j)  (2304 + 64 * (j))
#define XB_TOP      3328
#define XB_TOPGEN   3392
#define XCD_BAR_WORDS 3456
#define XB_SPIN_CAP (1u << 18)

__device__ __forceinline__ unsigned xb_ld(unsigned* p)              { return __hip_atomic_load(p, __ATOMIC_RELAXED, __HIP_MEMORY_SCOPE_AGENT); }
__device__ __forceinline__ unsigned xb_add(unsigned* p, unsigned v) { return __hip_atomic_fetch_add(p, v, __ATOMIC_RELAXED, __HIP_MEMORY_SCOPE_AGENT); }
__device__ __forceinline__ unsigned xb_xcc_id() { return (unsigned)__builtin_amdgcn_s_getreg((3 << 11) | 20) & 0xFu; }
#define XB_SPIN(cond, bar) do { unsigned _sp = 0; while (cond) { __builtin_amdgcn_s_sleep(1); \
    if ((++_sp & 255u) == 0u) { if (xb_ld(&(bar)[XB_TMO])) break; if (_sp > XB_SPIN_CAP) { atomicAdd(&(bar)[XB_TMO], 1u); break; } } } } while (0)

struct XcdBarrier {
    unsigned* bar; unsigned x;
    volatile LAS unsigned* st;
};

__device__ __forceinline__ XcdBarrier xcd_barrier_post(unsigned* bar, volatile LAS unsigned* st) {
    XcdBarrier b; b.bar = bar; b.x = xb_xcc_id(); b.st = st;
    if (threadIdx.x == 0) (void)xb_add(&bar[XB_XCNT(b.x)], 1u);
    return b;
}
__device__ __forceinline__ void xcd_barrier_complete(unsigned* bar, unsigned x, unsigned& nloc, unsigned& nx) {
    const unsigned G = gridDim.x * gridDim.y * gridDim.z;
    unsigned sum, cnt, mine, sp = 0u;
    for (;;) {
        sum = 0u; cnt = 0u; mine = 0u;
#pragma unroll
        for (unsigned j = 0; j < 16; ++j) { const unsigned c = xb_ld(&bar[XB_XCNT(j)]); sum += c; cnt += (c > 0u) ? 1u : 0u; mine = (j == x) ? c : mine; }
        if (sum == G) break;
        __builtin_amdgcn_s_sleep(1);
        if ((++sp & 255u) == 0u) { if (xb_ld(&bar[XB_TMO])) break; if (sp > XB_SPIN_CAP) { atomicAdd(&bar[XB_TMO], 1u); break; } }
    }
    nloc = mine > 0u ? mine : 1u; nx = cnt > 0u ? cnt : 1u;
}

__device__ __forceinline__ void xcd_barrier(const XcdBarrier& b) {
    asm volatile("s_waitcnt vmcnt(0)" ::: "memory");
    __syncthreads();
    if (threadIdx.x == 0) {
        unsigned* bar = b.bar;
        __builtin_amdgcn_s_waitcnt(0);
        unsigned nloc = b.st[0], nx = b.st[1];
        if (nloc == 0u) { xcd_barrier_complete(bar, b.x, nloc, nx); b.st[0] = nloc; b.st[1] = nx; }
        const unsigned old = xb_add(&bar[XB_XSUB(b.x)], 1u);
        const unsigned gen = old / nloc;
        if (old + 1u == (gen + 1u) * nloc) {
            __builtin_amdgcn_fence(__ATOMIC_RELEASE, "agent");
            asm volatile("s_waitcnt vmcnt(0)" ::: "memory");
            const unsigned og = xb_add(&bar[XB_TOP], 1u);
            const unsigned tg = og / nx;
            if (og + 1u == (tg + 1u) * nx) xb_add(&bar[XB_TOPGEN], 1u);
            else XB_SPIN(xb_ld(&bar[XB_TOPGEN]) == tg, bar);
            __builtin_amdgcn_fence(__ATOMIC_ACQUIRE, "agent");
            xb_add(&bar[XB_XGEN(b.x)], 1u);
            asm volatile("s_waitcnt vmcnt(0)" ::: "memory");
        } else {
            XB_SPIN(xb_ld(&bar[XB_XGEN(b.x)]) == gen, bar);
            __builtin_amdgcn_fence(__ATOMIC_ACQUIRE, "agent");
            asm volatile("s_waitcnt vmcnt(0)" ::: "memory");
        }
    }
    __syncthreads();
}

constexpr int PH_PER_LAYER = 6, N_PHASES = 1 + DEPTH * PH_PER_LAYER;
__global__ void __launch_bounds__(NTHREADS, 2) mk_fwd(KArgs args) {
    extern __shared__ __attribute__((aligned(16))) unsigned char lds_raw[];
    const int lo = args.ph_lo, hi = args.ph_hi;
    const int wave_s = __builtin_amdgcn_readfirstlane(threadIdx.x >> 6);
    if (threadIdx.x < 16) ((LAS unsigned*)(lds_raw + LDS_BARW))[threadIdx.x] = 0u;
    __syncthreads();
    cg::this_grid().sync();
    XcdBarrier bar = xcd_barrier_post((unsigned*)(args.ws + WS_CTL) + CW_BAR, (volatile LAS unsigned*)((LAS unsigned char*)lds_raw + LDS_BARW));
    int reps_left = REP_N - 1;
    for (int ph = lo; ph < hi; ++ph) {
        unsigned ones = ~0u; asm volatile("" : "+s"(ones));
        int tid = wave_s * 64 + (int)__builtin_amdgcn_mbcnt_hi(ones, __builtin_amdgcn_mbcnt_lo(ones, 0u)); asm volatile("" : "+v"(tid));
        GAS unsigned char* wsg = (GAS unsigned char*)args.ws; asm volatile("" : "+s"(wsg)); unsigned char* ws = (unsigned char*)wsg;
        Ctx C;
        C.lds = (LAS unsigned char*)lds_raw;
        C.in = args.in; { GAS float* og = (GAS float*)args.out; asm volatile("" : "+s"(og)); C.out = (float*)og; } C.ws = ws;
        C.tid = tid; C.lane = tid & 63; C.wave = __builtin_amdgcn_readfirstlane(tid >> 6);
        C.G = gridDim.x; C.gw = blockIdx.x * NWAVES + C.wave; C.ngw = C.G * NWAVES; C.dry = (ph == REP_PH && reps_left > 0);
        if (ph == 0) { const int l = 0; REPEAT(100, phase_prologue(C)); }
        else {
            const int l = (ph - 1) / PH_PER_LAYER, k = (ph - 1) % PH_PER_LAYER;
            const float* xres = (l == 0) ? gptr(args.in[0]) : (const float*)C.out;
            const unsigned* tileb = (const unsigned*)(ws + WS_CTL) + CW_TILEB + l * 160;
            if (k == 0) {
                if (l > 0) {
                    const float* ssqp = (const float*)(ws + WS_SSQP); float* rstd = (float*)(ws + WS_META + MT_RSTD);
                    for (int r0 = C.gw * 4; r0 < T; r0 += C.ngw * 4) { const int row = r0 + (C.lane >> 4); float v = ssqp[(size_t)row * 16 + (C.lane & 15)];
#pragma unroll
                        for (int o = 1; o < 16; o <<= 1) v += __shfl_xor(v, o);
                        if ((C.lane & 15) == 0) rstd[row] = 1.0f / sqrtf(v * (1.f / D) + EPS); }
                    xcd_barrier(bar);
                }
                DenseSched S; S.init(ws + WS_XB, (const bf16_t*)(ws + WS_WIN) + (size_t)l * NIN * D, T, NIN, D, C.G, (int)blockIdx.x);
                EpiIn E{(const float*)(ws + WS_META + MT_RSTD), (bf16_t*)(ws + WS_U), (bf16_t*)(ws + WS_QH), gptr(args.in[16]) + l * 64, gptr(args.in[17]) + l * 64};
                REPEAT(0, (pg8::gemm_phase<EpiIn, DenseSched, true, true>(C.lds, D, S, E, C.tid)));
            } else if (k == 1) {
                for (int it = C.gw; it < BATCH * 32 * 16; it += C.ngw) s5a_item(C, l, it);
                unsigned* s5cnt = (unsigned*)(ws + WS_CTL) + CW_S5A + l;
                asm volatile("s_waitcnt vmcnt(0)" ::: "memory");
                __syncthreads();
                if (threadIdx.x == 0) { __builtin_amdgcn_fence(__ATOMIC_RELEASE, "agent"); asm volatile("s_waitcnt vmcnt(0)" ::: "memory"); (void)xb_add(s5cnt, 1u); }
                const int half = C.G >> 1, nit = BATCH * NH * (SEQ / 256), nA = (nit * 5) >> 3;
                const bool sblk = (int)blockIdx.x < half; const int bx = sblk ? (int)blockIdx.x : (int)blockIdx.x - half;
                if (!sblk) { for (int it = bx; it < T / 128; it += half) sgu_item(C, l, it); }
                const int bxv = ((half & 7) == 0) ? (bx & 7) * (half >> 3) + (bx >> 3) : bx;
                phase_attn(C, l, sblk ? nA + bxv : bxv, half, sblk ? nit : nA);
                if (sblk) {
                    if (threadIdx.x == 0) { XB_SPIN(xb_ld(s5cnt) < (unsigned)C.G, (unsigned*)(ws + WS_CTL) + CW_BAR); __builtin_amdgcn_fence(__ATOMIC_ACQUIRE, "agent"); asm volatile("s_waitcnt vmcnt(0)" ::: "memory"); }
                    __syncthreads();
                    for (int it = blockIdx.x; it < BATCH * 32; it += half) s5c_item(C, l, it); }
            } else if (k == 2) {
                DenseSched S; S.init(ws + WS_O, (const bf16_t*)(ws + WS_WOUT) + (size_t)l * D * D, T, D, D, C.G, (int)blockIdx.x);
                EpiOut E{(bf16_t*)(ws + WS_XB), (float*)(ws + WS_SSQB), C.dry ? (size_t)((WS_XS - WS_XB) / 2) : (size_t)0};
                REPEAT(3, (pg8::gemm_phase<EpiOut, DenseSched, true, true>(C.lds, D, S, E, C.tid)));
            } else if (k == 3) {
                for (int it = blockIdx.x; it < T / 128; it += C.G) route_block(C, l, it);
            } else if (k == 4) {
                build_tile_table(C, l);
                TileTab tt{(const LAS int*)(C.lds + TB_OFF)};
                GroupSched S{(const char*)(ws + WS_XB), (const char*)((const bf16_t*)(ws + WS_WGU) + (size_t)l * 16 * 512 * D), tt, (const int*)(ws + WS_BLIST), tt.ntiles(), C.G, (int)blockIdx.x, 1, (size_t)0};
                EpiG1 E{tt, (const float*)(ws + WS_BGW0), (const float*)(ws + WS_BGW1), (const float*)(ws + WS_BRS), (bf16_t*)(ws + WS_H)};
                REPEAT(6, (pg8::gemm_phase<EpiG1, GroupSched, true, true, true>(C.lds, D, S, E, C.tid)));
            } else {
                build_tile_table(C, l);
                TileTab tt{(const LAS int*)(C.lds + TB_OFF)};
                GroupSched S{(const char*)(ws + WS_H), (const char*)((const bf16_t*)(ws + WS_WDN) + (size_t)l * NBUCKET * D * 512), tt, (const int*)(ws + WS_BLIST), tt.ntiles(), C.G, (int)blockIdx.x, 2, (size_t)256 * 512 * 2};
                if (l + 1 < DEPTH) { EpiG2<true> E{tt, (const int*)(ws + WS_BLIST), C.out, (bf16_t*)(ws + WS_XB), (float*)(ws + WS_SSQP), C.dry ? (size_t)((WS_XS - WS_XB) / 2) : (size_t)0};
                    pg8::gemm_phase<EpiG2<true>, GroupSched, true, true>(C.lds, 512, S, E, C.tid); }
                else { EpiG2<false> E{tt, (const int*)(ws + WS_BLIST), C.out, (bf16_t*)(ws + WS_XB), nullptr, (size_t)0};
                    pg8::gemm_phase<EpiG2<false>, GroupSched, true, true>(C.lds, 512, S, E, C.tid); }
            }
        }
        if (ph == REP_PH && reps_left > 0) { --reps_left; --ph; }
        if (ph + 1 < hi) xcd_barrier(bar);
    }
}

extern "C" void kernel_launch(void* const* d_in, const int* in_sizes, int n_in, void* d_out, int out_size, void* d_ws, size_t ws_size, hipStream_t stream) {
    static int grid = 0;
    if (grid == 0) {
        if (n_in != 29 || ws_size < WS_END) { fprintf(stderr, "kernel_launch: unexpected inputs (n_in %d, ws %zu)\n", n_in, ws_size); grid = -1; return; }
        int dev = 0, cus = 0, per_cu = 0;
        (void)hipGetDevice(&dev); (void)hipDeviceGetAttribute(&cus, hipDeviceAttributeMultiprocessorCount, dev);
        if (hipFuncSetAttribute((const void*)mk_fwd, hipFuncAttributeMaxDynamicSharedMemorySize, LDS_BYTES) != hipSuccess) { fprintf(stderr, "kernel_launch: hipFuncSetAttribute failed\n"); grid = -1; return; }
        if (hipOccupancyMaxActiveBlocksPerMultiprocessor(&per_cu, (const void*)mk_fwd, NTHREADS, LDS_BYTES) != hipSuccess || per_cu < 1) { fprintf(stderr, "kernel_launch: occupancy query says %d blocks/CU\n", per_cu); per_cu = 1; }
        (void)hipGetLastError();
        grid = cus * (per_cu > 1 ? 1 : per_cu);
        fprintf(stderr, "kernel_launch: grid %d (cus %d, per_cu %d)\n", grid, cus, per_cu);
    }
    if (grid < 0) return;
    (void)hipMemsetAsync((char*)d_ws + WS_CTL, 0, 1 * MiB, stream);
    KArgs a{};
    for (int i = 0; i < 29; ++i) a.in[i] = (const float*)d_in[i];
    a.out = (float*)d_out; a.ws = (unsigned char*)d_ws;
#if MK_ONE_LAUNCH
    a.ph_lo = 0; a.ph_hi = N_PHASES;
    void* kargs[] = {&a};
    hipError_t e = hipLaunchCooperativeKernel((const void*)mk_fwd, dim3(grid), dim3(NTHREADS), kargs, LDS_BYTES, stream);
    if (e != hipSuccess) fprintf(stderr, "cooperative launch failed: %s (grid %d)\n", hipGetErrorString(e), grid);
#else
    for (int p = 0; p < N_PHASES - 1; ++p) { a.ph_lo = p; a.ph_hi = p + 1; hipLaunchKernelGGL(mk_fwd, dim3(grid), dim3(NTHREADS), LDS_BYTES, stream, a); }
#endif
}
```
